# Optimizing an MI355X kernel written in HIP

```python
import math
import jax, jax.numpy as jnp
from jax import lax
import numpy as np

D_MODEL = 2048
BATCH = 1
SEQ = 16384
DEPTH = 4

N_MEM = 256
NSA_HEADS = 16
NSA_GROUPS = 4
NSA_HPG = NSA_HEADS // NSA_GROUPS
HEAD_DIM = 64
NSA_WIDTH = NSA_HEADS * HEAD_DIM
KV_WIDTH = NSA_GROUPS * HEAD_DIM
CMP_LEN = 32
CMP_STRIDE = 16
CMP_HID = 2 * HEAD_DIM
SEL_BLK = 64
SEL_TOPN = 16
WIN = 512
Q_BLK = 128
FORCE_SCORE = 1e4
POOL_WINDOWS = (2, 4, 8, 16)
POOL_GROUPS = 4
POOL_WIDTH = D_MODEL // 2
POOL_GW = POOL_WIDTH // POOL_GROUPS
REL_BUCKETS = 32
REL_MAX_DIST = 2048
X_HEADS = 4
X_HEAD_DIM = 128
X_WIDTH = X_HEADS * X_HEAD_DIM
D_FF = -(-8 * D_MODEL // (3 * 256)) * 256
IN_WIDTH = NSA_WIDTH + 6 * KV_WIDTH + 3 * NSA_HEADS + POOL_WIDTH + 2 * D_MODEL

kernel_name = "nsa_pool_hybrid_block"


def rms_norm(x, g, eps=1e-6):
    xf = x.astype(jnp.float32)
    y = xf * lax.rsqrt(jnp.mean(xf * xf, axis=-1, keepdims=True) + eps)
    return (y * g.astype(jnp.float32)).astype(x.dtype)


def rel_bucket(dist):
    n = jnp.maximum(dist, 0)
    exact = REL_BUCKETS // 2
    nf = jnp.maximum(n, 1).astype(jnp.float32)
    large = exact + (jnp.log(nf / exact) / math.log(REL_MAX_DIST / exact)
                     * (REL_BUCKETS - exact)).astype(jnp.int32)
    return jnp.where(n < exact, n, jnp.minimum(large, REL_BUCKETS - 1))


def masked_softmax(s, mask):
    s = jnp.where(mask, s.astype(jnp.float32), -1e30)
    m = jnp.max(s, axis=-1, keepdims=True)
    e = jnp.where(mask, jnp.exp(s - m), 0.0)
    return e / jnp.maximum(jnp.sum(e, axis=-1, keepdims=True), 1.0)


def compress_kv(raw, pe, w1, w2):
    b, s = raw.shape[0], raw.shape[1]
    n_cmp = (s - CMP_LEN) // CMP_STRIDE + 1
    idx = jnp.arange(n_cmp)[:, None] * CMP_STRIDE + jnp.arange(CMP_LEN)[None, :]
    blk = raw[:, idx] + pe[:, None, :]
    flat = jnp.transpose(blk, (0, 1, 3, 2, 4)).reshape(b, n_cmp, NSA_GROUPS, CMP_LEN * HEAD_DIM)
    return jax.nn.gelu(flat @ w1) @ w2


def cmp_to_sel_overlap(n_cmp, n_sel):
    i = jnp.arange(n_cmp)[:, None]
    j = jnp.arange(n_sel)[None, :]
    lo = jnp.maximum(i * CMP_STRIDE, j * SEL_BLK)
    hi = jnp.minimum(i * CMP_STRIDE + CMP_LEN, (j + 1) * SEL_BLK)
    return jnp.maximum(hi - lo, 0).astype(jnp.float32) / CMP_LEN


def nsa_attention(q, k_cmp_raw, v_cmp_raw, k_sel, v_sel, k_win, v_win, gate_logits,
                  cmp_pe, cmp_w1, cmp_w2, rel_bias):
    b, s = q.shape[0], q.shape[1]
    scale = HEAD_DIM ** -0.5
    kc = compress_kv(k_cmp_raw, cmp_pe[0], cmp_w1[0], cmp_w2[0])
    vc = compress_kv(v_cmp_raw, cmp_pe[1], cmp_w1[1], cmp_w2[1])
    n_cmp = kc.shape[1]
    n_sel = s // SEL_BLK
    topn = min(SEL_TOPN, n_sel)
    overlap = cmp_to_sel_overlap(n_cmp, n_sel)
    cmp_end = jnp.arange(n_cmp) * CMP_STRIDE + CMP_LEN - 1
    kb = k_sel.reshape(b, n_sel, SEL_BLK, NSA_GROUPS, HEAD_DIM).transpose(0, 3, 1, 2, 4)
    vb = v_sel.reshape(b, n_sel, SEL_BLK, NSA_GROUPS, HEAD_DIM).transpose(0, 3, 1, 2, 4)
    kw_pad = jnp.pad(k_win, ((0, 0), (WIN, 0), (0, 0), (0, 0)))
    vw_pad = jnp.pad(v_win, ((0, 0), (WIN, 0), (0, 0), (0, 0)))
    gates = jax.nn.sigmoid(gate_logits.astype(jnp.float32)).astype(q.dtype).reshape(b, s, NSA_HEADS, 3)
    tab_g = rel_bias.reshape(NSA_GROUPS, NSA_HPG, REL_BUCKETS)
    gather_blocks = jax.vmap(jax.vmap(lambda blocks, idx: blocks[idx]))
    group_bias = jax.vmap(jax.vmap(lambda tab, bk: tab[:, bk]), in_axes=(None, 0))

    def head_bias(dist):
        return tab_g[:, :, rel_bucket(dist)]

    def block(qi):
        q0 = qi * Q_BLK
        t = q0 + jnp.arange(Q_BLK)
        qg = lax.dynamic_slice_in_dim(q, q0, Q_BLK, 1).reshape(b, Q_BLK, NSA_GROUPS, NSA_HPG, HEAD_DIM)
        gq = lax.dynamic_slice_in_dim(gates, q0, Q_BLK, 1)
        d_c = t[:, None] - cmp_end[None, :]
        s_c = jnp.einsum('bqghd,bngd->bghqn', qg, kc).astype(jnp.float32) * scale + head_bias(d_c)
        p_c = masked_softmax(s_c, d_c >= 0)
        o_c = jnp.einsum('bghqn,bngd->bqghd', p_c.astype(vc.dtype), vc)
        imp = jnp.einsum('bghqn,nj->bgqj', p_c, overlap)
        cur = t // SEL_BLK
        j = jnp.arange(n_sel)[None, :]
        forced = (j == 0) | (j == cur[:, None]) | (j == cur[:, None] - 1)
        imp = jnp.where(forced, FORCE_SCORE, imp)
        imp = jnp.where(j > cur[:, None], -1.0, imp)
        top_val, top_idx = lax.top_k(imp, topn)
        ks = gather_blocks(kb, top_idx)
        vs = gather_blocks(vb, top_idx)
        pos = top_idx[..., None] * SEL_BLK + jnp.arange(SEL_BLK)
        d_s = t[:, None, None] - pos
        mask_s = (top_val >= 0)[..., None] & (d_s >= 0)
        bias_s = group_bias(tab_g, rel_bucket(d_s))
        s_s = jnp.einsum('bqghd,bgqnkd->bghqnk', qg, ks).astype(jnp.float32) * scale + bias_s
        m_len = topn * SEL_BLK
        p_s = masked_softmax(s_s.reshape(b, NSA_GROUPS, NSA_HPG, Q_BLK, m_len),
                             mask_s.reshape(b, NSA_GROUPS, 1, Q_BLK, m_len))
        o_s = jnp.einsum('bghqm,bgqmd->bqghd', p_s.astype(vs.dtype),
                         vs.reshape(b, NSA_GROUPS, Q_BLK, m_len, HEAD_DIM))
        kw = lax.dynamic_slice_in_dim(kw_pad, q0, WIN + Q_BLK, 1)
        vw = lax.dynamic_slice_in_dim(vw_pad, q0, WIN + Q_BLK, 1)
        s_pos = q0 - WIN + jnp.arange(WIN + Q_BLK)
        d_w = t[:, None] - s_pos[None, :]
        mask_w = (d_w >= 0) & (d_w < WIN) & (s_pos[None, :] >= 0)
        s_w = jnp.einsum('bqghd,bkgd->bghqk', qg, kw).astype(jnp.float32) * scale + head_bias(d_w)
        p_w = masked_softmax(s_w, mask_w)
        o_w = jnp.einsum('bghqk,bkgd->bqghd', p_w.astype(vw.dtype), vw)
        o = jnp.stack([o_c, o_s, o_w], axis=-1).reshape(b, Q_BLK, NSA_HEADS, HEAD_DIM, 3)
        return jnp.einsum('bqhdc,bqhc->bqhd', o, gq)

    out = lax.map(block, jnp.arange(s // Q_BLK))
    return jnp.transpose(out, (1, 0, 2, 3, 4)).reshape(b, s, NSA_WIDTH)


def pool_mixer(u, w_pool, pool_scale):
    b, s, _ = u.shape
    uf = u.astype(jnp.float32)
    cnt_base = jnp.arange(s) + 1
    outs = []
    for gi, w in enumerate(POOL_WINDOWS):
        ug = uf[..., gi * POOL_GW:(gi + 1) * POOL_GW]
        c = jnp.concatenate([jnp.zeros((b, 1, POOL_GW), jnp.float32), jnp.cumsum(ug, axis=1)], axis=1)
        hi = c[:, 1:]
        lo = jnp.pad(c[:, :s + 1 - w], ((0, 0), (w - 1, 0), (0, 0)))
        cnt = jnp.minimum(cnt_base, w).astype(jnp.float32)[None, :, None]
        outs.append((hi - lo) / cnt - ug)
    y = jnp.stack(outs, axis=2).astype(u.dtype)
    y = jnp.einsum('bsgc,gcd->bsgd', y, w_pool)
    return y.reshape(b, s, POOL_WIDTH) * pool_scale


def memory_cross_attention(h, mem_n, wq, wkv, wo):
    b, s, _ = h.shape
    q = (h @ wq).reshape(b, s, X_HEADS, X_HEAD_DIM)
    k, v = jnp.split(mem_n @ wkv, 2, axis=-1)
    k = k.reshape(b, -1, X_HEADS, X_HEAD_DIM)
    v = v.reshape(b, -1, X_HEADS, X_HEAD_DIM)
    sc = jnp.einsum('bshd,bmhd->bhsm', q, k).astype(jnp.float32) * (X_HEAD_DIM ** -0.5)
    p = jax.nn.softmax(sc, axis=-1).astype(v.dtype)
    o = jnp.einsum('bhsm,bmhd->bshd', p, v).reshape(b, s, X_WIDTH)
    return o @ wo


def setup_inputs(seed: int = 0) -> dict:
    key = jax.random.key(seed)
    ks = jax.random.split(key, 32)
    f32 = jnp.float32

    def w(k, shape, fan_in):
        return jax.random.normal(k, shape, f32) * (fan_in ** -0.5)

    def gain(k, shape):
        return 1.0 + 0.05 * jax.random.normal(k, shape, f32)

    L = DEPTH
    return {
        "x": jax.random.normal(ks[0], (BATCH, SEQ, D_MODEL), f32),
        "mem": jax.random.normal(ks[1], (BATCH, N_MEM, D_MODEL), f32),
        "rel_bias": 0.5 * jax.random.normal(ks[2], (NSA_HEADS, REL_BUCKETS), f32),
        "ln_mix_pre": gain(ks[3], (L, D_MODEL)),
        "ln_mix_post": gain(ks[4], (L, D_MODEL)),
        "ln_x_pre": gain(ks[5], (L, D_MODEL)),
        "ln_x_post": gain(ks[6], (L, D_MODEL)),
        "ln_mem": gain(ks[7], (L, D_MODEL)),
        "ln_ffn_pre": gain(ks[8], (L, D_MODEL)),
        "ln_ffn_post": gain(ks[9], (L, D_MODEL)),
        "w_in": w(ks[10], (L, D_MODEL, IN_WIDTH), D_MODEL),
        "cmp_pe": 0.1 * jax.random.normal(ks[11], (L, 2, CMP_LEN, HEAD_DIM), f32),
        "cmp_w1": w(ks[12], (L, 2, CMP_LEN * HEAD_DIM, CMP_HID), CMP_LEN * HEAD_DIM),
        "cmp_w2": w(ks[13], (L, 2, CMP_HID, HEAD_DIM), CMP_HID),
        "w_pool": w(ks[14], (L, POOL_GROUPS, POOL_GW, POOL_GW), POOL_GW),
        "pool_scale": gain(ks[15], (L, POOL_WIDTH)),
        "w_br_attn": w(ks[16], (L, NSA_WIDTH, D_MODEL), NSA_WIDTH),
        "w_br_pool": w(ks[17], (L, POOL_WIDTH, D_MODEL), POOL_WIDTH),
        "w_mix_out": w(ks[18], (L, D_MODEL, D_MODEL), D_MODEL),
        "w_xq": w(ks[19], (L, D_MODEL, X_WIDTH), D_MODEL),
        "w_xkv": w(ks[20], (L, D_MODEL, 2 * X_WIDTH), D_MODEL),
        "w_xo": w(ks[21], (L, X_WIDTH, D_MODEL), X_WIDTH),
        "w_gate": w(ks[22], (L, D_MODEL, D_FF), D_MODEL),
        "w_up": w(ks[23], (L, D_MODEL, D_FF), D_MODEL),
        "w_down": w(ks[24], (L, D_FF, D_MODEL), D_FF),
    }


def reference(x, mem, rel_bias, ln_mix_pre, ln_mix_post, ln_x_pre, ln_x_post, ln_mem,
              ln_ffn_pre, ln_ffn_post, w_in, cmp_pe, cmp_w1, cmp_w2, w_pool, pool_scale,
              w_br_attn, w_br_pool, w_mix_out, w_xq, w_xkv, w_xo, w_gate, w_up, w_down):
    b, s, _ = x.shape
    splits = [NSA_WIDTH,
              NSA_WIDTH + 6 * KV_WIDTH,
              NSA_WIDTH + 6 * KV_WIDTH + 3 * NSA_HEADS,
              NSA_WIDTH + 6 * KV_WIDTH + 3 * NSA_HEADS + POOL_WIDTH]
    for l in range(DEPTH):
        h = rms_norm(x, ln_mix_pre[l])
        z = h @ w_in[l]
        q, kv, nsa_gl, u, merge_logits = jnp.split(z, splits, axis=-1)
        q = q.reshape(b, s, NSA_HEADS, HEAD_DIM)
        kv = kv.reshape(b, s, 6, NSA_GROUPS, HEAD_DIM)
        a = nsa_attention(q, kv[:, :, 0], kv[:, :, 1], kv[:, :, 2], kv[:, :, 3],
                          kv[:, :, 4], kv[:, :, 5], nsa_gl,
                          cmp_pe[l], cmp_w1[l], cmp_w2[l], rel_bias)
        p = pool_mixer(u, w_pool[l], pool_scale[l])
        g_a, g_p = jnp.split(jax.nn.sigmoid(merge_logits.astype(jnp.float32)).astype(x.dtype), 2, axis=-1)
        y = (g_a * (a @ w_br_attn[l]) + g_p * (p @ w_br_pool[l])) @ w_mix_out[l]
        x = x + rms_norm(y, ln_mix_post[l])
        h = rms_norm(x, ln_x_pre[l])
        mem_n = rms_norm(mem, ln_mem[l])
        y = memory_cross_attention(h, mem_n, w_xq[l], w_xkv[l], w_xo[l])
        x = x + rms_norm(y, ln_x_post[l])
        h = rms_norm(x, ln_ffn_pre[l])
        y = (jax.nn.silu(h @ w_gate[l]) * (h @ w_up[l])) @ w_down[l]
        x = x + rms_norm(y, ln_ffn_post[l])
    return x
```

```cpp
#include <hip/hip_runtime.h>
#include <cstdio>
#include <cstdint>
namespace pg8 {
#define PG8_LAS __attribute__((address_space(3)))
#define PG8_GAS __attribute__((address_space(1)))
typedef unsigned short bf16_t;
typedef short bf16x8 __attribute__((ext_vector_type(8)));
typedef float f32x4 __attribute__((ext_vector_type(4)));
typedef float f32x2 __attribute__((ext_vector_type(2)));
typedef unsigned u32x4 __attribute__((ext_vector_type(4)));
typedef unsigned u32x2 __attribute__((ext_vector_type(2)));
constexpr int BM = 256, BK = 64, HALF = 128, HTB = HALF * BK * 2  , STAGE_BYTES = 8 * HTB, NXCD = 8, WGM = 8;

__host__ __device__ __forceinline__ int lds_byte(int r, int c) { const int st = (r >> 4) * 2 + (c >> 5), rr = r & 15, cc = c & 31, ob = rr * 64 + cc * 2; return st * 1024 + (ob ^ (((ob >> 9) & 1) << 5)); }
__host__ __device__ __forceinline__ void stage_rc(int b, int& R, int& C) { const int st = b / 1024, sb = b % 1024, swz = sb ^ (((sb >> 9) & 1) << 5); R = (st >> 1) * 16 + swz / 64; C = (st & 1) * 32 + (swz % 64) / 2; }
__host__ __device__ __forceinline__ int perm32(int rho) { const int n = rho >> 4, i = rho & 15; return 8 * (i >> 2) + 4 * n + (i & 3); }

struct Unit { int pm, pn, sel; };


template <int NM, int NN, int NSEL, bool INNER>
struct Sched {
    int G, c;
    __device__ __forceinline__ void init(int G_, int c_) { G = G_; c = c_; }
    __device__ __forceinline__ bool next(int i, Unit& u) const {
        constexpr int nwg = NM * NN;
        long L; int sel;
        if (INNER) { L = (long)(i / NSEL) * G + c; sel = i % NSEL; if (L >= nwg) return false; }
        else { const long LL = (long)i * G + c; if (LL >= (long)nwg * NSEL) return false; sel = (int)(LL / nwg); L = LL % nwg; }
        int wgid = (int)L; { constexpr int q = nwg / NXCD, r = nwg % NXCD; const int xcd = wgid % NXCD, off = wgid / NXCD; wgid = (xcd < r ? xcd * (q + 1) : r * (q + 1) + (xcd - r) * q) + off; }
        constexpr int nig = WGM * NN; const int gid = wgid / nig, fm = gid * WGM, gsz = (NM - fm) < WGM ? (NM - fm) : WGM;
        u.pm = fm + ((wgid % nig) % gsz); u.pn = (wgid % nig) / gsz; u.sel = sel; return true;
    }
};

typedef __bf16 bf16x2_t __attribute__((ext_vector_type(2)));
__device__ __forceinline__ unsigned cvt_pk_bf16(float lo, float hi) { const f32x2 v = {lo, hi}; const bf16x2_t b = __builtin_convertvector(v, bf16x2_t); return __builtin_bit_cast(unsigned, b); }

template <int LDA, int LDB, int K, long ASEL, long BSEL, class Epi, class SchedT>
__device__ __forceinline__ void gemm_phase(PG8_LAS unsigned char* lds, int tid, const PG8_GAS bf16_t* gA, const PG8_GAS bf16_t* gBt, const SchedT& S, const Epi& E) {
    const int wid = __builtin_amdgcn_readfirstlane(tid >> 6), lane = tid & 63, wr = wid >> 2, wc = wid & 3, fr = lane & 15, fq = lane >> 4;
    constexpr int nt = K / BK;
    unsigned voffA[2], voffB[2];
#pragma unroll
    for (int i = 0; i < 2; ++i) { int R, C; stage_rc(tid * 16 + i * 8192, R, C); const int Rb = Epi::PERM ? ((R & ~31) + perm32(R & 31)) : R;
        voffA[i] = (unsigned)(R * LDA + C) * 2u; voffB[i] = (unsigned)(Rb * LDB + C) * 2u; }
    constexpr size_t kstep = (size_t)(BK * 2);
    constexpr size_t hstepA = (size_t)HALF * LDA * 2, hstepB = (size_t)HALF * LDB * 2;
    constexpr size_t tstepA = 2 * hstepA, tstepB = 2 * hstepB;
    const unsigned ldsw = (unsigned)wid * 1024u;
    const int aoff = lds_byte(wr * 64 + fr, fq * 8), boff = lds_byte(wc * 32 + fr, fq * 8);
#define PG8_SA(b, h) (((b) * 2 + (h)) * HTB)
#define PG8_SB(b, h) ((4 + (b) * 2 + (h)) * HTB)
#define PG8_STAGE(bufoff, gbase, voff) do { _Pragma("unroll") for (int _i = 0; _i < 2; ++_i) \
        __builtin_amdgcn_global_load_lds((const PG8_GAS unsigned*)((const PG8_GAS char*)(gbase) + (voff)[_i]), (PG8_LAS unsigned*)(lds + (bufoff) + ldsw + _i * 8192), 16, 0, 0); } while (0)
#define PG8_LDA(dst, b, h) do { _Pragma("unroll") for (int m = 0; m < 4; ++m) _Pragma("unroll") for (int k = 0; k < 2; ++k) dst[m][k] = *(const PG8_LAS bf16x8*)(lds + PG8_SA(b, h) + aoff + m * 2048 + k * 1024); } while (0)
#define PG8_LDB(dst, b, h) do { _Pragma("unroll") for (int n = 0; n < 2; ++n) _Pragma("unroll") for (int k = 0; k < 2; ++k) dst[n][k] = *(const PG8_LAS bf16x8*)(lds + PG8_SB(b, h) + boff + n * 2048 + k * 1024); } while (0)
#define PG8_MMA(ai, bj, At, Bt) do { __builtin_amdgcn_s_setprio(1); _Pragma("unroll") for (int m = 0; m < 4; ++m) _Pragma("unroll") for (int n = 0; n < 2; ++n) _Pragma("unroll") for (int k = 0; k < 2; ++k) \
        acc[ai][bj][m][n] = __builtin_amdgcn_mfma_f32_16x16x32_bf16(Bt[n][k], At[m][k], acc[ai][bj][m][n], 0, 0, 0); __builtin_amdgcn_s_setprio(0); } while (0)
#define PG8_WAIT_V(n) asm volatile("s_waitcnt vmcnt(" #n ")" ::: "memory")
#define PG8_WAIT_L(n) asm volatile("s_waitcnt lgkmcnt(" #n ")" ::: "memory")
#define PG8_BAR __builtin_amdgcn_s_barrier()
#define PG8_SCHED __builtin_amdgcn_sched_barrier(0)
    Unit cur, nxt; int ui = 0;
    if (!S.next(0, cur)) return;
    f32x4 acc[2][2][4][2];
#pragma unroll
    for (int a = 0; a < 2; ++a)
#pragma unroll
        for (int b = 0; b < 2; ++b)
#pragma unroll
            for (int m = 0; m < 4; ++m)
#pragma unroll
                for (int n = 0; n < 2; ++n) acc[a][b][m][n] = (f32x4){0.f, 0.f, 0.f, 0.f};
    bf16x8 At[4][2], B0[2][2], B1[2][2];
    const PG8_GAS char* cA = (const PG8_GAS char*)(gA + (size_t)cur.sel * ASEL) + (size_t)cur.pm * tstepA; const PG8_GAS char* cB = (const PG8_GAS char*)(gBt + (size_t)cur.sel * BSEL) + (size_t)cur.pn * tstepB;
    PG8_STAGE(PG8_SB(0, 0), cB, voffB); PG8_STAGE(PG8_SB(0, 1), cB + hstepB, voffB); PG8_STAGE(PG8_SA(0, 0), cA, voffA); PG8_STAGE(PG8_SA(0, 1), cA + hstepA, voffA);
    if (wr == 1) PG8_BAR;
    PG8_WAIT_V(2); PG8_BAR;
    PG8_STAGE(PG8_SB(1, 0), cB + kstep, voffB); PG8_STAGE(PG8_SA(1, 0), cA + kstep, voffA); PG8_STAGE(PG8_SB(1, 1), cB + hstepB + kstep, voffB);
    PG8_WAIT_V(6); PG8_BAR;
    for (;;) {
        const bool has_next = S.next(ui + 1, nxt);
        const PG8_GAS char* nA = has_next ? (const PG8_GAS char*)(gA + (size_t)nxt.sel * ASEL) + (size_t)nxt.pm * tstepA : cA; const PG8_GAS char* nB = has_next ? (const PG8_GAS char*)(gBt + (size_t)nxt.sel * BSEL) + (size_t)nxt.pn * tstepB : cB;
#pragma unroll 1
        for (int t = 0; t < nt; t += 2) {
            const bool last = (t == nt - 2);
            const PG8_GAS char* a1 = cA + (size_t)(t + 1) * kstep;
            const PG8_GAS char* a2 = last ? nA : cA + (size_t)(t + 2) * kstep; const PG8_GAS char* b2 = last ? nB : cB + (size_t)(t + 2) * kstep;
            const PG8_GAS char* a3 = a2 + kstep; const PG8_GAS char* b3 = b2 + kstep;
            PG8_LDB(B0, 0, 0); PG8_LDB(B1, 0, 1); PG8_SCHED; PG8_LDA(At, 0, 0); PG8_STAGE(PG8_SA(1, 1), a1 + hstepA, voffA);
            PG8_WAIT_V(8); PG8_WAIT_L(0); PG8_BAR; PG8_MMA(0, 0, At, B0); PG8_MMA(0, 1, At, B1); PG8_BAR; PG8_SCHED;
            PG8_LDA(At, 0, 1); PG8_STAGE(PG8_SB(0, 0), b2, voffB); PG8_STAGE(PG8_SB(0, 1), b2 + hstepB, voffB); PG8_STAGE(PG8_SA(0, 0), a2, voffA);
            PG8_WAIT_V(8); PG8_WAIT_L(0); PG8_BAR; PG8_MMA(1, 0, At, B0); PG8_MMA(1, 1, At, B1); PG8_BAR; PG8_SCHED;
            PG8_LDB(B0, 1, 0); PG8_LDB(B1, 1, 1); PG8_SCHED; PG8_LDA(At, 1, 0); PG8_STAGE(PG8_SA(0, 1), a2 + hstepA, voffA);
            PG8_WAIT_V(8); PG8_WAIT_L(0); PG8_BAR; PG8_MMA(0, 0, At, B0); PG8_MMA(0, 1, At, B1); PG8_BAR; PG8_SCHED;
            PG8_LDA(At, 1, 1); PG8_STAGE(PG8_SB(1, 0), b3, voffB); PG8_STAGE(PG8_SB(1, 1), b3 + hstepB, voffB); PG8_STAGE(PG8_SA(1, 0), a3, voffA);
            PG8_WAIT_V(8); PG8_WAIT_L(0); PG8_BAR; PG8_MMA(1, 0, At, B0); PG8_MMA(1, 1, At, B1); PG8_BAR; PG8_SCHED;
        }
        if (wr == 0) PG8_BAR;
        E(acc, cur, wr, wc, fr, fq);
        if (!has_next) break;
#pragma unroll
        for (int a = 0; a < 2; ++a)
#pragma unroll
            for (int b = 0; b < 2; ++b)
#pragma unroll
                for (int m = 0; m < 4; ++m)
#pragma unroll
                    for (int n = 0; n < 2; ++n) acc[a][b][m][n] = (f32x4){0.f, 0.f, 0.f, 0.f};
        cur = nxt; cA = nA; cB = nB; ++ui;
        if (wr == 1) PG8_BAR;
    }
    PG8_WAIT_V(0);
    PG8_BAR;
#undef PG8_SA
#undef PG8_SB
#undef PG8_STAGE
#undef PG8_LDA
#undef PG8_LDB
#undef PG8_MMA
#undef PG8_WAIT_V
#undef PG8_WAIT_L
#undef PG8_BAR
#undef PG8_SCHED
}
}
constexpr int S_ = 16384, DM = 2048, NL = 4, NMEM = 256;
constexpr int NSAW = 1024, KVW = 256, HD = 64, NHEAD = 16, NGRP = 4;
constexpr int POOLW = 1024, DFF = 5632, XW = 512, XHD = 128;
constexpr int INW = 7728, ZN = 7936;
constexpr int NCMP = 1023;
constexpr float RMS_EPS = 1e-6f;
constexpr float LOG2E = 1.4426950408889634f;
constexpr float QSCALE = 0.125f * LOG2E;
constexpr float XSCALE = 0.08838834764831845f * LOG2E;

typedef unsigned short bf16;
typedef short bf16x8 __attribute__((ext_vector_type(8)));
typedef float f32x4 __attribute__((ext_vector_type(4)));
typedef float f32x2 __attribute__((ext_vector_type(2)));
typedef unsigned u32x4 __attribute__((ext_vector_type(4)));
typedef unsigned u32x2 __attribute__((ext_vector_type(2)));
#define GAS __attribute__((address_space(1)))
#define LAS __attribute__((address_space(3)))
typedef GAS unsigned short gbf;
typedef GAS float gfl;
typedef GAS unsigned char gby;

__device__ __forceinline__ unsigned f2bf(float f) { unsigned u = __builtin_bit_cast(unsigned, f); return (u + 0x7fffu + ((u >> 16) & 1u)) >> 16; }
__device__ __forceinline__ unsigned pk2(float lo, float hi) { return pg8::cvt_pk_bf16(lo, hi); }
__device__ __forceinline__ float bf2f(unsigned short b) { return __builtin_bit_cast(float, (unsigned)b << 16); }
__device__ __forceinline__ float bflo(unsigned w) { return __builtin_bit_cast(float, w << 16); }
__device__ __forceinline__ float bfhi(unsigned w) { return __builtin_bit_cast(float, w & 0xffff0000u); }
__device__ __forceinline__ float sigmoidf_(float x) { return __builtin_amdgcn_rcpf(1.f + __builtin_amdgcn_exp2f(-x * LOG2E)); }

constexpr size_t MiB = 1u << 20;
constexpr size_t WS_CTL = 0, CTL_ZERO_BYTES = 1 * MiB;
constexpr size_t WS_WIN = 1 * MiB;
constexpr size_t WS_WBRA = WS_WIN + 31 * MiB;
constexpr size_t WS_WBRP = WS_WBRA + 4 * MiB;
constexpr size_t WS_WMIX = WS_WBRP + 4 * MiB;
constexpr size_t WS_WXQ = WS_WMIX + 8 * MiB;
constexpr size_t WS_WXO = WS_WXQ + 2 * MiB;
constexpr size_t WS_WGU = WS_WXO + 2 * MiB;
constexpr size_t WS_WDN = WS_WGU + 44 * MiB;
constexpr size_t WS_WC1 = WS_WDN + 22 * MiB;
constexpr size_t WS_WPOOL = WS_WC1 + 1 * MiB;
constexpr size_t WS_PEB = WS_WPOOL + MiB / 2;
constexpr size_t WS_ACT = WS_PEB + MiB / 2;
constexpr size_t WS_H = WS_ACT;
constexpr size_t WS_Q = WS_H + 64 * MiB;
constexpr size_t WS_KCR = WS_Q + 32 * MiB;
constexpr size_t WS_VCR = WS_KCR + 8 * MiB;
constexpr size_t WS_KSEL = WS_VCR + 8 * MiB;
constexpr size_t WS_VSELT = WS_KSEL + 8 * MiB;
constexpr size_t WS_KWIN = WS_VSELT + 8 * MiB;
constexpr size_t WS_VWINT = WS_KWIN + 8 * MiB;
constexpr size_t WS_GL = WS_VWINT + 8 * MiB;
constexpr size_t WS_PQ = WS_GL + 3 * MiB;
constexpr size_t WS_KC = WS_PQ + 8 * MiB;
constexpr size_t WS_VCT = WS_KC + MiB / 2;
constexpr size_t WS_KM = WS_VCT + MiB / 2;
constexpr size_t WS_VMT = WS_KM + 1 * MiB;
constexpr size_t WS_Y1 = WS_VMT + 1 * MiB;
constexpr size_t WS_Y2 = WS_Y1 + 64 * MiB;
constexpr size_t WS_Q2 = WS_Y2 + 64 * MiB;
constexpr size_t WS_O2 = WS_Q2 + 16 * MiB;
constexpr size_t WS_BIG = WS_O2 + 16 * MiB;
constexpr size_t WS_MG = WS_BIG;
constexpr size_t WS_U = WS_MG + 128 * MiB;
constexpr size_t WS_A = WS_U + 32 * MiB;
constexpr size_t WS_P = WS_A + 32 * MiB;
constexpr size_t WS_YP = WS_P + 32 * MiB;
constexpr size_t WS_HID = WS_BIG;
constexpr size_t WS_WXKV = WS_BIG;
constexpr size_t WS_MEMN = WS_BIG + 16 * MiB;
constexpr size_t WS_END = WS_BIG + 256 * MiB;
static_assert(WS_HID + (size_t)S_ * DFF * 2 <= WS_P, "HID overlays MG | U | A only");

constexpr int CW_BAR = 4096;

using pg8::Unit; using pg8::HALF; using pg8::BM;
typedef pg8::f32x4 acc_t[2][2][4][2];

struct EpiBf16 {
    static constexpr bool PERM = true;
    gbf* O; int ldc; int selcol; float scale;
    __device__ __forceinline__ void operator()(const acc_t& acc, const Unit& u, int wr, int wc, int fr, int fq) const {
        const int row0 = u.pm * BM + wr * 64 + fr; const int col0 = u.sel * selcol + u.pn * BM + wc * 32 + 8 * fq;
#pragma unroll
        for (int ai = 0; ai < 2; ++ai)
#pragma unroll
            for (int m = 0; m < 4; ++m) { gbf* rowp = O + (size_t)(row0 + ai * HALF + m * 16) * ldc + col0;
#pragma unroll
                for (int bj = 0; bj < 2; ++bj) { const f32x4 v0 = acc[ai][bj][m][0] * scale, v1 = acc[ai][bj][m][1] * scale;
                    u32x4 w; w.x = pk2(v0[0], v0[1]); w.y = pk2(v0[2], v0[3]); w.z = pk2(v1[0], v1[1]); w.w = pk2(v1[2], v1[3]);
                    *(GAS u32x4*)(rowp + bj * HALF) = w; } }
    }
};
struct EpiF32 {
    static constexpr bool PERM = false;
    gfl* O; int ldc; size_t selstride;
    __device__ __forceinline__ void operator()(const acc_t& acc, const Unit& u, int wr, int wc, int fr, int fq) const {
        const int row0 = u.pm * BM + wr * 64 + fr; const int col0 = u.pn * BM + wc * 32 + 4 * fq; gfl* base = O + (size_t)u.sel * selstride;
#pragma unroll
        for (int ai = 0; ai < 2; ++ai)
#pragma unroll
            for (int m = 0; m < 4; ++m) { gfl* rowp = base + (size_t)(row0 + ai * HALF + m * 16) * ldc + col0;
#pragma unroll
                for (int bj = 0; bj < 2; ++bj)
#pragma unroll
                    for (int n = 0; n < 2; ++n) *(GAS f32x4*)(rowp + bj * HALF + n * 16) = acc[ai][bj][m][n]; }
    }
};
struct EpiZ {
    static constexpr bool PERM = true;
    gby* ws;
    __device__ __forceinline__ void operator()(const acc_t& acc, const Unit& u, int wr, int wc, int fr, int fq) const {
        const int row0 = u.pm * BM + wr * 64 + fr; const int pn = u.pn;
        gbf* const Q = (gbf*)(ws + WS_Q); gbf* const U = (gbf*)(ws + WS_U); gbf* const MG = (gbf*)(ws + WS_MG); gfl* const GL = (gfl*)(ws + WS_GL);
        if (pn < 4 || (pn >= 10 && pn < 14)) {
            const bool isq = pn < 4; gbf* base = isq ? Q : U; const float sc = isq ? QSCALE : 1.f; const int col0 = (isq ? pn : pn - 10) * BM + wc * 32 + 8 * fq;
#pragma unroll
            for (int ai = 0; ai < 2; ++ai)
#pragma unroll
                for (int m = 0; m < 4; ++m) { gbf* rowp = base + (size_t)(row0 + ai * HALF + m * 16) * 1024 + col0;
#pragma unroll
                    for (int bj = 0; bj < 2; ++bj) { const f32x4 v0 = acc[ai][bj][m][0] * sc, v1 = acc[ai][bj][m][1] * sc;
                        u32x4 w; w.x = pk2(v0[0], v0[1]); w.y = pk2(v0[2], v0[3]); w.z = pk2(v1[0], v1[1]); w.w = pk2(v1[2], v1[3]);
                        *(GAS u32x4*)(rowp + bj * HALF) = w; } }
        } else if (pn == 4 || pn == 5 || pn == 6 || pn == 8) {
            gbf* base = (gbf*)(ws + (pn == 4 ? WS_KCR : pn == 5 ? WS_VCR : pn == 6 ? WS_KSEL : WS_KWIN));
            const int d0 = 32 * (wc & 1) + 8 * fq;
#pragma unroll
            for (int ai = 0; ai < 2; ++ai)
#pragma unroll
                for (int m = 0; m < 4; ++m) { const int row = row0 + ai * HALF + m * 16;
#pragma unroll
                    for (int bj = 0; bj < 2; ++bj) { const int g = 2 * bj + (wc >> 1); const f32x4 v0 = acc[ai][bj][m][0], v1 = acc[ai][bj][m][1];
                        u32x4 w; w.x = pk2(v0[0], v0[1]); w.y = pk2(v0[2], v0[3]); w.z = pk2(v1[0], v1[1]); w.w = pk2(v1[2], v1[3]);
                        *(GAS u32x4*)(base + ((size_t)g * S_ + row) * 64 + d0) = w; } }
        } else if (pn == 7 || pn == 9) {
            gbf* base = (gbf*)(ws + (pn == 7 ? WS_VSELT : WS_VWINT));
            const int d0 = 32 * (wc & 1) + 8 * fq;
#pragma unroll
            for (int ai = 0; ai < 2; ++ai)
#pragma unroll
                for (int m = 0; m < 4; ++m) { const int row = row0 + ai * HALF + m * 16;
#pragma unroll
                    for (int bj = 0; bj < 2; ++bj) { const int g = 2 * bj + (wc >> 1); gbf* p = base + ((size_t)g * 64 + d0) * S_ + row;
#pragma unroll
                        for (int n = 0; n < 2; ++n)
#pragma unroll
                            for (int e = 0; e < 4; ++e) p[(size_t)(4 * n + e) * S_] = (bf16)f2bf(acc[ai][bj][m][n][e]); } }
        } else if (pn < 30) {
            const int col0 = (pn - 14) * BM + wc * 32 + 8 * fq;
#pragma unroll
            for (int ai = 0; ai < 2; ++ai)
#pragma unroll
                for (int m = 0; m < 4; ++m) { gbf* rowp = MG + (size_t)(row0 + ai * HALF + m * 16) * 4096 + col0;
#pragma unroll
                    for (int bj = 0; bj < 2; ++bj) { const f32x4 a0 = acc[ai][bj][m][0], a1 = acc[ai][bj][m][1];
                        u32x4 w; w.x = pk2(sigmoidf_(a0[0]), sigmoidf_(a0[1])); w.y = pk2(sigmoidf_(a0[2]), sigmoidf_(a0[3])); w.z = pk2(sigmoidf_(a1[0]), sigmoidf_(a1[1])); w.w = pk2(sigmoidf_(a1[2]), sigmoidf_(a1[3]));
                        *(GAS u32x4*)(rowp + bj * HALF) = w; } }
        } else {
            const int col0 = wc * 32 + 8 * fq;
            if (col0 < 48) {
#pragma unroll
                for (int ai = 0; ai < 2; ++ai)
#pragma unroll
                    for (int m = 0; m < 4; ++m) { gfl* rowp = GL + (size_t)(row0 + ai * HALF + m * 16) * 48 + col0;
                        const f32x4 a0 = acc[ai][0][m][0], a1 = acc[ai][0][m][1];
                        *(GAS f32x4*)rowp = (f32x4){sigmoidf_(a0[0]), sigmoidf_(a0[1]), sigmoidf_(a0[2]), sigmoidf_(a0[3])};
                        *(GAS f32x4*)(rowp + 4) = (f32x4){sigmoidf_(a1[0]), sigmoidf_(a1[1]), sigmoidf_(a1[2]), sigmoidf_(a1[3])}; }
            }
        }
    }
};
struct EpiMerge {
    static constexpr bool PERM = true;
    gbf* Y1; const gbf* MG;
    __device__ __forceinline__ void operator()(const acc_t& acc, const Unit& u, int wr, int wc, int fr, int fq) const {
        const int row0 = u.pm * BM + wr * 64 + fr; const int col0 = u.pn * BM + wc * 32 + 8 * fq;
#pragma unroll
        for (int ai = 0; ai < 2; ++ai)
#pragma unroll
            for (int m = 0; m < 4; ++m) { const int row = row0 + ai * HALF + m * 16; gbf* yp = Y1 + (size_t)row * DM + col0; const gbf* gp = MG + (size_t)row * 4096 + u.sel * 2048 + col0;
#pragma unroll
                for (int bj = 0; bj < 2; ++bj) { const u32x4 gw = *(const GAS u32x4*)(gp + bj * HALF); const f32x4 a0 = acc[ai][bj][m][0], a1 = acc[ai][bj][m][1];
                    float v[8] = {a0[0] * bflo(gw.x), a0[1] * bfhi(gw.x), a0[2] * bflo(gw.y), a0[3] * bfhi(gw.y), a1[0] * bflo(gw.z), a1[1] * bfhi(gw.z), a1[2] * bflo(gw.w), a1[3] * bfhi(gw.w)};
                    if (u.sel) { const u32x4 yw = *(const GAS u32x4*)(yp + bj * HALF);
                        v[0] += bflo(yw.x); v[1] += bfhi(yw.x); v[2] += bflo(yw.y); v[3] += bfhi(yw.y); v[4] += bflo(yw.z); v[5] += bfhi(yw.z); v[6] += bflo(yw.w); v[7] += bfhi(yw.w); }
                    u32x4 w; w.x = pk2(v[0], v[1]); w.y = pk2(v[2], v[3]); w.z = pk2(v[4], v[5]); w.w = pk2(v[6], v[7]);
                    *(GAS u32x4*)(yp + bj * HALF) = w; } }
    }
};
struct EpiSwiGLU {
    static constexpr bool PERM = true;
    gbf* Hd;
    __device__ __forceinline__ void operator()(const acc_t& acc, const Unit& u, int wr, int wc, int fr, int fq) const {
        const int row0 = u.pm * BM + wr * 64 + fr; const int col0 = u.pn * 128 + wc * 32 + 8 * fq;
#pragma unroll
        for (int ai = 0; ai < 2; ++ai)
#pragma unroll
            for (int m = 0; m < 4; ++m) { gbf* rowp = Hd + (size_t)(row0 + ai * HALF + m * 16) * DFF + col0; float v[8];
#pragma unroll
                for (int n = 0; n < 2; ++n)
#pragma unroll
                    for (int e = 0; e < 4; ++e) { const float gx = acc[ai][0][m][n][e], ux = acc[ai][1][m][n][e]; v[4 * n + e] = gx * sigmoidf_(gx) * ux; }
                u32x4 w; w.x = pk2(v[0], v[1]); w.y = pk2(v[2], v[3]); w.z = pk2(v[4], v[5]); w.w = pk2(v[6], v[7]);
                *(GAS u32x4*)rowp = w; }
    }
};
struct EpiKVmem {
    static constexpr bool PERM = true;
    gbf *KM, *VMT;
    __device__ __forceinline__ void operator()(const acc_t& acc, const Unit& u, int wr, int wc, int fr, int fq) const {
        const int row0 = wr * 64 + fr; const int l = u.sel;
        if (u.pn < 2) {
            const int col0 = u.pn * BM + wc * 32 + 8 * fq;
#pragma unroll
            for (int ai = 0; ai < 2; ++ai)
#pragma unroll
                for (int m = 0; m < 4; ++m) { gbf* rowp = KM + ((size_t)l * NMEM + row0 + ai * HALF + m * 16) * XW + col0;
#pragma unroll
                    for (int bj = 0; bj < 2; ++bj) { const f32x4 v0 = acc[ai][bj][m][0] * XSCALE, v1 = acc[ai][bj][m][1] * XSCALE;
                        u32x4 w; w.x = pk2(v0[0], v0[1]); w.y = pk2(v0[2], v0[3]); w.z = pk2(v1[0], v1[1]); w.w = pk2(v1[2], v1[3]);
                        *(GAS u32x4*)(rowp + bj * HALF) = w; } }
        } else {
            const int col0 = (u.pn - 2) * BM + wc * 32 + 8 * fq;
#pragma unroll
            for (int ai = 0; ai < 2; ++ai)
#pragma unroll
                for (int m = 0; m < 4; ++m) { const int row = row0 + ai * HALF + m * 16;
#pragma unroll
                    for (int bj = 0; bj < 2; ++bj) { gbf* p = VMT + ((size_t)l * XW + col0 + bj * HALF) * NMEM + row;
#pragma unroll
                        for (int n = 0; n < 2; ++n)
#pragma unroll
                            for (int e = 0; e < 4; ++e) p[(size_t)(4 * n + e) * NMEM] = (bf16)f2bf(acc[ai][bj][m][n][e]); } }
        }
    }
};
constexpr int RING_BYTES = 131072;
constexpr int LDSCTL_OFF = RING_BYTES, MISC_OFF = LDSCTL_OFF + 320;
constexpr int LDS_BYTES = 147456;
constexpr int NWAVES = 8;

typedef GAS unsigned gu32;
#define RLX_AGENT __ATOMIC_RELAXED, __HIP_MEMORY_SCOPE_AGENT
#define LDS_WAIT() asm volatile("s_waitcnt lgkmcnt(0)" ::: "memory")
#define VM_WAIT() asm volatile("s_waitcnt vmcnt(0)" ::: "memory")

#define XB_TMO      128
#define XB_XCNT(j)  (256  + 64 * (j))
#define XB_XSUB(j)  (1280 + 64 * (j))
#define XB_XGEN(j)  (2304 + 64 * (j))
#define XB_TOP      3328
#define XB_TOPGEN   3392
#define XCD_BAR_WORDS 3456
#define XB_SPIN_CAP (1u << 22)

__device__ __forceinline__ unsigned xb_ld(GAS unsigned* p)              { return __hip_atomic_load(p, __ATOMIC_RELAXED, __HIP_MEMORY_SCOPE_AGENT); }
__device__ __forceinline__ unsigned xb_add(GAS unsigned* p, unsigned v) { return __hip_atomic_fetch_add(p, v, __ATOMIC_RELAXED, __HIP_MEMORY_SCOPE_AGENT); }
__device__ __forceinline__ unsigned xb_xcc_id() { return (unsigned)__builtin_amdgcn_s_getreg((3 << 11) | 20) & 0xFu; }
#define XB_SPIN(cond, bar) do { unsigned _sp = 0; while (cond) { __builtin_amdgcn_s_sleep(1); \
    if ((++_sp & 255u) == 0u) { if (xb_ld(&(bar)[XB_TMO])) break; if (_sp > XB_SPIN_CAP) { (void)xb_add(&(bar)[XB_TMO], 1u); break; } } } } while (0)

struct XcdBarrier { GAS unsigned* bar; unsigned x; volatile LAS unsigned* st; };

__device__ __forceinline__ XcdBarrier xcd_barrier_post(GAS unsigned* bar, volatile LAS unsigned* st) {
    XcdBarrier b; b.bar = bar; b.x = xb_xcc_id(); b.st = st;
    if (threadIdx.x == 0) (void)xb_add(&bar[XB_XCNT(b.x)], 1u);
    return b;
}
__device__ __forceinline__ void xcd_barrier_complete(GAS unsigned* bar, unsigned x, unsigned& nloc, unsigned& nx) {
    const unsigned G = gridDim.x * gridDim.y * gridDim.z;
    unsigned sum, cnt, mine, sp = 0u;
    for (;;) {
        sum = 0u; cnt = 0u; mine = 0u;
#pragma unroll 1
        for (unsigned j = 0; j < 16; ++j) { const unsigned c = xb_ld(&bar[XB_XCNT(j)]); sum += c; cnt += (c > 0u) ? 1u : 0u; mine = (j == x) ? c : mine; }
        if (sum == G) break;
        __builtin_amdgcn_s_sleep(1);
        if ((++sp & 255u) == 0u) { if (xb_ld(&bar[XB_TMO])) break; if (sp > XB_SPIN_CAP) { (void)xb_add(&bar[XB_TMO], 1u); break; } }
    }
    nloc = mine > 0u ? mine : 1u; nx = cnt > 0u ? cnt : 1u;
}
__device__ __forceinline__ void xcd_barrier(const XcdBarrier& b) {
    asm volatile("s_waitcnt vmcnt(0)" ::: "memory");
    __syncthreads();
    if (threadIdx.x == 0) {
        GAS unsigned* bar = b.bar; unsigned bx = b.x;
        asm volatile("" : "+s"(bar), "+s"(bx));
        __builtin_amdgcn_s_waitcnt(0);
        unsigned nloc = b.st[0], nx = b.st[1];
        if (nloc == 0u) { xcd_barrier_complete(bar, bx, nloc, nx); b.st[0] = nloc; b.st[1] = nx; }
        const unsigned old = xb_add(&bar[XB_XSUB(bx)], 1u);
        const unsigned gen = old / nloc;
        if (old + 1u == (gen + 1u) * nloc) {
            __builtin_amdgcn_fence(__ATOMIC_RELEASE, "agent");
            asm volatile("s_waitcnt vmcnt(0)" ::: "memory");
            const unsigned og = xb_add(&bar[XB_TOP], 1u);
            const unsigned tg = og / nx;
            if (og + 1u == (tg + 1u) * nx) xb_add(&bar[XB_TOPGEN], 1u);
            else XB_SPIN(xb_ld(&bar[XB_TOPGEN]) == tg, bar);
            __builtin_amdgcn_fence(__ATOMIC_ACQUIRE, "agent");
            xb_add(&bar[XB_XGEN(bx)], 1u);
            asm volatile("s_waitcnt vmcnt(0)" ::: "memory");
        } else {
            XB_SPIN(xb_ld(&bar[XB_XGEN(bx)]) == gen, bar);
            __builtin_amdgcn_fence(__ATOMIC_ACQUIRE, "agent");
            asm volatile("s_waitcnt vmcnt(0)" ::: "memory");
        }
    }
    __syncthreads();
}

struct Frame {
    LAS unsigned char* lds;
    int tid, lane, wave, vcu, G, gw, NGW;
    gby* ws;
};

__device__ __forceinline__ float wave_sum(float v) {
#pragma unroll
    for (int o = 1; o < 64; o <<= 1) v += __shfl_xor(v, o);
    return v;
}

__device__ __forceinline__ int tr_map(int code, int moff, int n) {
    if (code == 0) return n + moff;
    if (code == 1) return n < 2560 ? n : (n < 2608 ? 7680 + (n - 2560) : (n < 3632 ? 2560 + (n - 2608) : 3584 + (n - 3632)));
    return (n >> 7) * 256 + moff + (n & 127);
}
struct TrDesc { const gfl* W; gbf* WT; const gfl* cs; int K, N, ldk, code, moff, start; };
__device__ __forceinline__ void tr_item(const gfl* W, int N, gbf* WT, int ldk, LAS float* scr, int item, int lane, int code, int moff, const gfl* colscale) {
    const int nblk = (N + 31) / 32, kb = item / nblk, nb = item % nblk, k0 = 64 * kb, n0 = 32 * nb;
    const int nl = n0 + (lane & 31); const bool nok = nl < N; const float cs = (colscale && nok) ? colscale[nl] : 1.f;
#pragma unroll 8
    for (int i = 0; i < 32; ++i) { const int kk = 2 * i + (lane >> 5); scr[kk * 33 + (lane & 31)] = nok ? W[(size_t)(k0 + kk) * N + nl] * cs : 0.f; }
    LDS_WAIT(); asm volatile("" ::: "memory");
    const int c = lane & 7;
#pragma unroll
    for (int j = 0; j < 4; ++j) { const int n = (lane >> 3) + 8 * j; const LAS float* s = scr + (8 * c) * 33 + n;
        u32x4 o; o.x = pk2(s[0 * 33], s[1 * 33]); o.y = pk2(s[2 * 33], s[3 * 33]); o.z = pk2(s[4 * 33], s[5 * 33]); o.w = pk2(s[6 * 33], s[7 * 33]);
        if (n0 + n < N) *(GAS u32x4*)(WT + (size_t)tr_map(code, moff, n0 + n) * ldk + k0 + 8 * c) = o; }
    LDS_WAIT(); asm volatile("" ::: "memory");
}

__device__ __forceinline__ void rms_row_to_bf16(const gfl* xrow, const gfl* gain, gbf* orow, int lane) {
    f32x4 v[4][2]; float ss = 0.f;
#pragma unroll
    for (int j = 0; j < 4; ++j) { const int c = lane + 64 * j; v[j][0] = *(const GAS f32x4*)(xrow + 8 * c); v[j][1] = *(const GAS f32x4*)(xrow + 8 * c + 4);
        ss += (v[j][0].x * v[j][0].x + v[j][0].y * v[j][0].y) + (v[j][0].z * v[j][0].z + v[j][0].w * v[j][0].w) + (v[j][1].x * v[j][1].x + v[j][1].y * v[j][1].y) + (v[j][1].z * v[j][1].z + v[j][1].w * v[j][1].w); }
    const float r = 1.0f / sqrtf(wave_sum(ss) * (1.f / DM) + RMS_EPS);
#pragma unroll
    for (int j = 0; j < 4; ++j) { const int c = lane + 64 * j; const f32x4 g0 = *(const GAS f32x4*)(gain + 8 * c), g1 = *(const GAS f32x4*)(gain + 8 * c + 4);
        const f32x4 a = v[j][0] * r * g0, b = v[j][1] * r * g1;
        u32x4 w; w.x = pk2(a.x, a.y); w.y = pk2(a.z, a.w); w.z = pk2(b.x, b.y); w.w = pk2(b.z, b.w);
        *(GAS u32x4*)(orow + 8 * c) = w; }
}
__device__ __forceinline__ void resid_row(const gfl* xin, gfl* xout, const gbf* yrow, const gfl* gpost, const gfl* gpre, gbf* hrow, int lane) {
    f32x4 y[4][2]; float ss = 0.f;
#pragma unroll
    for (int j = 0; j < 4; ++j) { const int c = lane + 64 * j; const u32x4 w = *(const GAS u32x4*)(yrow + 8 * c);
        y[j][0] = (f32x4){bflo(w.x), bfhi(w.x), bflo(w.y), bfhi(w.y)}; y[j][1] = (f32x4){bflo(w.z), bfhi(w.z), bflo(w.w), bfhi(w.w)};
        ss += (y[j][0].x * y[j][0].x + y[j][0].y * y[j][0].y) + (y[j][0].z * y[j][0].z + y[j][0].w * y[j][0].w) + (y[j][1].x * y[j][1].x + y[j][1].y * y[j][1].y) + (y[j][1].z * y[j][1].z + y[j][1].w * y[j][1].w); }
    const float r = 1.0f / sqrtf(wave_sum(ss) * (1.f / DM) + RMS_EPS);
    float s2 = 0.f;
#pragma unroll
    for (int j = 0; j < 4; ++j) { const int c = lane + 64 * j; const f32x4 g0 = *(const GAS f32x4*)(gpost + 8 * c), g1 = *(const GAS f32x4*)(gpost + 8 * c + 4);
        const f32x4 x0 = *(const GAS f32x4*)(xin + 8 * c), x1 = *(const GAS f32x4*)(xin + 8 * c + 4);
        y[j][0] = x0 + y[j][0] * r * g0; y[j][1] = x1 + y[j][1] * r * g1;
        *(GAS f32x4*)(xout + 8 * c) = y[j][0]; *(GAS f32x4*)(xout + 8 * c + 4) = y[j][1];
        s2 += (y[j][0].x * y[j][0].x + y[j][0].y * y[j][0].y) + (y[j][0].z * y[j][0].z + y[j][0].w * y[j][0].w) + (y[j][1].x * y[j][1].x + y[j][1].y * y[j][1].y) + (y[j][1].z * y[j][1].z + y[j][1].w * y[j][1].w); }
    if (gpre) {
        const float r2 = 1.0f / sqrtf(wave_sum(s2) * (1.f / DM) + RMS_EPS);
#pragma unroll
        for (int j = 0; j < 4; ++j) { const int c = lane + 64 * j; const f32x4 g0 = *(const GAS f32x4*)(gpre + 8 * c), g1 = *(const GAS f32x4*)(gpre + 8 * c + 4);
            const f32x4 a = y[j][0] * r2 * g0, b = y[j][1] * r2 * g1;
            u32x4 w; w.x = pk2(a.x, a.y); w.y = pk2(a.z, a.w); w.z = pk2(b.x, b.y); w.w = pk2(b.z, b.w);
            *(GAS u32x4*)(hrow + 8 * c) = w; }
    }
}
__device__ __forceinline__ float gelu_tanh(float x) {
    const float z = 0.7978845608028654f * (x + 0.044715f * x * x * x);
    const float e = __builtin_amdgcn_exp2f(2.f * z * LOG2E);
    const float th = 1.f - 2.f * __builtin_amdgcn_rcpf(1.f + e);
    return 0.5f * x * (1.f + th);
}
constexpr float NEGBIG = -1e30f;
constexpr int ATT_BKT_OFF = 0;
constexpr int ATT_TAB_OFF = 2048;
constexpr int ATT_WAVE_OFF = 4096;
constexpr int ATT_IMP_STRIDE = 264;
constexpr int ATT_WAVE_BYTES = 2 * 4 * ATT_IMP_STRIDE * 4 + 128;
static_assert(ATT_WAVE_OFF + NWAVES * ATT_WAVE_BYTES <= RING_BYTES, "attention LDS");

__device__ __forceinline__ int t5_bucket(int n) {
    if (n < 16) return n;
    int b = 16;
    b += (n >= 22); b += (n >= 30); b += (n >= 40); b += (n >= 54); b += (n >= 73); b += (n >= 99); b += (n >= 134); b += (n >= 182);
    b += (n >= 246); b += (n >= 332); b += (n >= 450); b += (n >= 609); b += (n >= 825); b += (n >= 1117); b += (n >= 1513);
    return b;
}
struct AttSt { f32x4 o[4]; float m, l; };
__device__ __forceinline__ void att_reset(AttSt& st) {
#pragma unroll
    for (int i = 0; i < 4; ++i) st.o[i] = (f32x4){0.f, 0.f, 0.f, 0.f};
    st.m = NEGBIG; st.l = 0.f;
}
template <int MODE>
__device__ __forceinline__ void att_scores(float (&sv)[8], const bf16x8 (&qf)[2], const gbf* Kg, int kb, int t, int head, bool rowsel, int lane, const LAS unsigned char* bkt, const LAS float* tab) {
    const int i16 = lane & 15, gq = lane >> 4;
    f32x4 s[2];
#pragma unroll
    for (int tau = 0; tau < 2; ++tau) {
        const int ko = 8 * (i16 >> 2) + 4 * tau + (i16 & 3);
        const gbf* kp = Kg + (size_t)(kb + ko) * 64 + 8 * gq;
        const bf16x8 k0 = *(const GAS bf16x8*)kp, k1 = *(const GAS bf16x8*)(kp + 32);
        s[tau] = __builtin_amdgcn_mfma_f32_16x16x32_bf16(k0, qf[0], (f32x4){0.f, 0.f, 0.f, 0.f}, 0, 0, 0);
        s[tau] = __builtin_amdgcn_mfma_f32_16x16x32_bf16(k1, qf[1], s[tau], 0, 0, 0);
    }
#pragma unroll
    for (int tau = 0; tau < 2; ++tau)
#pragma unroll
        for (int r = 0; r < 4; ++r) {
            const int idx = kb + 8 * gq + 4 * tau + r;
            int dist; bool valid;
            if (MODE == 0) { dist = t - (16 * idx + 31); valid = dist >= 0; }
            else if (MODE == 1) { dist = t - idx; valid = rowsel && dist >= 0; }
            else { dist = t - idx; valid = (unsigned)dist < 512u; }
            const int dc = dist < 0 ? 0 : (dist > 2047 ? 2047 : dist);
            const float b = tab[head * 32 + bkt[dc]];
            sv[4 * tau + r] = valid ? s[tau][r] + b : NEGBIG;
        }
}
template <int MODE>
__device__ __forceinline__ void att_step(AttSt& st, const bf16x8 (&qf)[2], const gbf* Kg, const gbf* VTg, int vpitch, int kb, int t, int head, bool rowsel, int lane, const LAS unsigned char* bkt, const LAS float* tab) {
    const int i16 = lane & 15, gq = lane >> 4;
    float sv[8];
    att_scores<MODE>(sv, qf, Kg, kb, t, head, rowsel, lane, bkt, tab);
    float mx = fmaxf(fmaxf(fmaxf(sv[0], sv[1]), fmaxf(sv[2], sv[3])), fmaxf(fmaxf(sv[4], sv[5]), fmaxf(sv[6], sv[7])));
    mx = fmaxf(mx, __shfl_xor(mx, 16)); mx = fmaxf(mx, __shfl_xor(mx, 32));
    const float mn = fmaxf(st.m, mx);
    const float alpha = __builtin_amdgcn_exp2f(st.m - mn);
    st.m = mn;
    float p[8]; float ps = 0.f;
#pragma unroll
    for (int e = 0; e < 8; ++e) { p[e] = __builtin_amdgcn_exp2f(sv[e] - mn); ps += p[e]; }
    st.l = st.l * alpha + ps;
    u32x4 pw; pw.x = pk2(p[0], p[1]); pw.y = pk2(p[2], p[3]); pw.z = pk2(p[4], p[5]); pw.w = pk2(p[6], p[7]);
    const bf16x8 pb = __builtin_bit_cast(bf16x8, pw);
#pragma unroll
    for (int dt = 0; dt < 4; ++dt) {
        const bf16x8 vf = *(const GAS bf16x8*)(VTg + (size_t)(16 * dt + i16) * vpitch + kb + 8 * gq);
        st.o[dt] = st.o[dt] * alpha;
        st.o[dt] = __builtin_amdgcn_mfma_f32_16x16x32_bf16(vf, pb, st.o[dt], 0, 0, 0);
    }
}
__device__ __forceinline__ void att_finish(const AttSt& st, f32x4 (&acc)[4], float gate) {
    float l = st.l; l += __shfl_xor(l, 16); l += __shfl_xor(l, 32);
    const float sc = (st.m > -1e29f) ? gate / l : 0.f;
#pragma unroll
    for (int dt = 0; dt < 4; ++dt) acc[dt] += st.o[dt] * sc;
}
__device__ __forceinline__ unsigned wave_max_u32(unsigned v) {
#pragma unroll
    for (int o = 1; o < 64; o <<= 1) { const unsigned w = (unsigned)__shfl_xor((int)v, o); v = v > w ? v : w; }
    return v;
}

struct AttnPtrs { const gbf *Q, *KC, *VCT, *KSEL, *VSELT, *KWIN, *VWINT; const gfl* GL; gbf* A; };

__device__ __forceinline__ void attn_setup_tables(Frame& F, const gfl* rel_bias) {
    LAS unsigned char* bkt = F.lds + ATT_BKT_OFF; LAS float* tab = (LAS float*)(F.lds + ATT_TAB_OFF);
    for (int i = F.tid; i < 2048; i += NWAVES * 64) bkt[i] = (unsigned char)t5_bucket(i);
    for (int i = F.tid; i < 512; i += NWAVES * 64) tab[i] = rel_bias[i] * LOG2E;
    LDS_WAIT(); __syncthreads();
}

__device__ __forceinline__ void nsa_unit_v1(Frame& F, const AttnPtrs& P, int qt, int g) {
    const int lane = F.lane, i16 = lane & 15, gq = lane >> 4, ql = i16 >> 2, hl = i16 & 3;
    const LAS unsigned char* bkt = F.lds + ATT_BKT_OFF; const LAS float* tab = (const LAS float*)(F.lds + ATT_TAB_OFF);
    LAS float* impA = (LAS float*)(F.lds + ATT_WAVE_OFF + F.wave * ATT_WAVE_BYTES); LAS float* impB = impA + 4 * ATT_IMP_STRIDE;
    LAS unsigned* selm = (LAS unsigned*)(impB + 4 * ATT_IMP_STRIDE);
    const int t0 = 4 * qt, t = t0 + ql, head = 4 * g + hl;
    bf16x8 qf[2];
    { const gbf* qp = P.Q + (size_t)t * NSAW + head * 64 + 8 * gq; qf[0] = *(const GAS bf16x8*)qp; qf[1] = *(const GAS bf16x8*)(qp + 32); }
    const float g_c = P.GL[(size_t)t * 48 + head * 3 + 0], g_s = P.GL[(size_t)t * 48 + head * 3 + 1], g_w = P.GL[(size_t)t * 48 + head * 3 + 2];
    f32x4 acc[4];
#pragma unroll
    for (int i = 0; i < 4; ++i) acc[i] = (f32x4){0.f, 0.f, 0.f, 0.f};
    AttSt st;
    const gbf* KCg = P.KC + (size_t)g * 1024 * 64; const gbf* VCTg = P.VCT + (size_t)g * 64 * 1024;
    const int nlast = (t0 + 3 >= 31) ? (t0 + 3 - 31) / 16 : -1;
    att_reset(st);
    for (int kb = 0; kb <= nlast; kb += 32) att_step<0>(st, qf, KCg, VCTg, 1024, kb, t, head, true, lane, bkt, tab);
    att_finish(st, acc, g_c);
    const int cur_max = (t0 + 3) >> 6;
    if (cur_max >= 16) {
        float lt = st.l; lt += __shfl_xor(lt, 16); lt += __shfl_xor(lt, 32);
        const float inv_l = (st.m > -1e29f) ? 1.f / lt : 0.f; const float mfin = st.m;
        for (int kb = 0; kb <= nlast; kb += 32) {
            float sv[8];
            att_scores<0>(sv, qf, KCg, kb, t, head, true, lane, bkt, tab);
            float ps[8];
#pragma unroll
            for (int e = 0; e < 8; ++e) { float p = (sv[e] > -1e29f) ? __builtin_amdgcn_exp2f(sv[e] - mfin) * inv_l : 0.f; p += __shfl_xor(p, 1); p += __shfl_xor(p, 2); ps[e] = p; }
            const float a0 = ps[0] + ps[1] + ps[2] + 0.5f * ps[3], c0 = 0.5f * ps[3];
            const float a1 = ps[4] + ps[5] + ps[6] + 0.5f * ps[7] + c0, c1 = 0.5f * ps[7];
            const int j0 = (kb + 8 * gq) >> 2;
            if (hl == 0) { impA[ql * ATT_IMP_STRIDE + j0] = a0; impA[ql * ATT_IMP_STRIDE + j0 + 1] = a1; impB[ql * ATT_IMP_STRIDE + j0 + 2] = c1; }
        }
    }
    LDS_WAIT();
#pragma unroll 1
    for (int q = 0; q < 4; ++q) {
        const int tq = t0 + q, cur = tq >> 6;
        unsigned mword = 0u;
        if (cur <= 15) { if (lane == 0) mword = (2u << cur) - 1u; }
        else {
            unsigned key[4];
#pragma unroll
            for (int e = 0; e < 4; ++e) { const int j = 4 * lane + e; float v = impA[q * ATT_IMP_STRIDE + j]; if ((j & 1) == 0 && j > 0) v += impB[q * ATT_IMP_STRIDE + j];
                const bool cand = (j >= 1) && (j <= cur - 2);
                key[e] = cand ? ((__builtin_bit_cast(unsigned, v) & 0xffffff00u) | (unsigned)(255 - j)) : 0u; }
#pragma unroll 1
            for (int round = 0; round < 13; ++round) {
                unsigned best = key[0] > key[1] ? key[0] : key[1]; const unsigned b2 = key[2] > key[3] ? key[2] : key[3]; best = best > b2 ? best : b2;
                const unsigned wk = (unsigned)__builtin_amdgcn_readfirstlane((int)wave_max_u32(best));
                const int js = 255 - (int)(wk & 255u);
                if (lane == (js >> 2)) {
#pragma unroll
                    for (int e = 0; e < 4; ++e) if ((js & 3) == e) key[e] = 0u;
                }
                if (lane == (js >> 5)) mword |= 1u << (js & 31);
            }
            if (lane == 0) mword |= 1u;
            if (lane == (cur >> 5)) mword |= 1u << (cur & 31);
            if (lane == ((cur - 1) >> 5)) mword |= 1u << ((cur - 1) & 31);
        }
        if (lane < 8) selm[q * 8 + lane] = mword;
    }
    LDS_WAIT();
    const gbf* KSg = P.KSEL + (size_t)g * S_ * 64; const gbf* VSTg = P.VSELT + (size_t)g * 64 * S_;
    att_reset(st);
#pragma unroll 1
    for (int w = 0; w < 8; ++w) {
        unsigned U = selm[w] | selm[8 + w] | selm[16 + w] | selm[24 + w];
        U = (unsigned)__builtin_amdgcn_readfirstlane((int)U);
        const unsigned myw = selm[ql * 8 + w];
        while (U) {
            const int b = __builtin_ctz(U); U &= U - 1u;
            const int blk = 32 * w + b; const bool rs = (myw >> b) & 1u;
            att_step<1>(st, qf, KSg, VSTg, S_, blk * 64, t, head, rs, lane, bkt, tab);
            att_step<1>(st, qf, KSg, VSTg, S_, blk * 64 + 32, t, head, rs, lane, bkt, tab);
        }
    }
    att_finish(st, acc, g_s);
    const gbf* KWg = P.KWIN + (size_t)g * S_ * 64; const gbf* VWTg = P.VWINT + (size_t)g * 64 * S_;
    att_reset(st);
    { int kb0 = t0 - 511; kb0 = kb0 < 0 ? 0 : (kb0 & ~31);
      for (int kb = kb0; kb <= t0 + 3; kb += 32) att_step<2>(st, qf, KWg, VWTg, S_, kb, t, head, true, lane, bkt, tab); }
    att_finish(st, acc, g_w);
    gbf* ap = P.A + (size_t)t * NSAW + head * 64 + 4 * gq;
#pragma unroll
    for (int dt = 0; dt < 4; ++dt) { u32x2 w; w.x = pk2(acc[dt][0], acc[dt][1]); w.y = pk2(acc[dt][2], acc[dt][3]); *(GAS u32x2*)(ap + 16 * dt) = w; }
}

__device__ __forceinline__ void xattn_unit_v1(Frame& F, const gbf* Q2, const gbf* KM, const gbf* VMT, gbf* O2, int qt, int h) {
    const int lane = F.lane, i16 = lane & 15, gq = lane >> 4;
    const int t = 16 * qt + i16;
    bf16x8 qf[4];
#pragma unroll
    for (int s = 0; s < 4; ++s) qf[s] = *(const GAS bf16x8*)(Q2 + (size_t)t * XW + h * XHD + 32 * s + 8 * gq);
    f32x4 o[8];
#pragma unroll
    for (int i = 0; i < 8; ++i) o[i] = (f32x4){0.f, 0.f, 0.f, 0.f};
    float m = NEGBIG, l = 0.f;
#pragma unroll 1
    for (int kb = 0; kb < NMEM; kb += 32) {
        f32x4 s[2];
#pragma unroll
        for (int tau = 0; tau < 2; ++tau) {
            const int ko = 8 * (i16 >> 2) + 4 * tau + (i16 & 3);
            const gbf* kp = KM + (size_t)(kb + ko) * XW + h * XHD + 8 * gq;
            s[tau] = (f32x4){0.f, 0.f, 0.f, 0.f};
#pragma unroll
            for (int ks = 0; ks < 4; ++ks) s[tau] = __builtin_amdgcn_mfma_f32_16x16x32_bf16(*(const GAS bf16x8*)(kp + 32 * ks), qf[ks], s[tau], 0, 0, 0);
        }
        float mx = fmaxf(fmaxf(fmaxf(s[0][0], s[0][1]), fmaxf(s[0][2], s[0][3])), fmaxf(fmaxf(s[1][0], s[1][1]), fmaxf(s[1][2], s[1][3])));
        mx = fmaxf(mx, __shfl_xor(mx, 16)); mx = fmaxf(mx, __shfl_xor(mx, 32));
        const float mn = fmaxf(m, mx); const float alpha = __builtin_amdgcn_exp2f(m - mn); m = mn;
        float p[8]; float ps = 0.f;
#pragma unroll
        for (int e = 0; e < 8; ++e) { p[e] = __builtin_amdgcn_exp2f(s[e >> 2][e & 3] - mn); ps += p[e]; }
        l = l * alpha + ps;
        u32x4 pw; pw.x = pk2(p[0], p[1]); pw.y = pk2(p[2], p[3]); pw.z = pk2(p[4], p[5]); pw.w = pk2(p[6], p[7]);
        const bf16x8 pb = __builtin_bit_cast(bf16x8, pw);
#pragma unroll
        for (int dt = 0; dt < 8; ++dt) {
            const bf16x8 vf = *(const GAS bf16x8*)(VMT + (size_t)(h * XHD + 16 * dt + i16) * NMEM + kb + 8 * gq);
            o[dt] = o[dt] * alpha;
            o[dt] = __builtin_amdgcn_mfma_f32_16x16x32_bf16(vf, pb, o[dt], 0, 0, 0);
        }
    }
    l += __shfl_xor(l, 16); l += __shfl_xor(l, 32);
    const float inv = 1.f / l;
    gbf* op = O2 + (size_t)t * XW + h * XHD + 4 * gq;
#pragma unroll
    for (int dt = 0; dt < 8; ++dt) { u32x2 w; w.x = pk2(o[dt][0] * inv, o[dt][1] * inv); w.y = pk2(o[dt][2] * inv, o[dt][3] * inv); *(GAS u32x2*)(op + 16 * dt) = w; }
}
__device__ __forceinline__ void pool_item(const gbf* U, gbf* YP, int item, int lane) {
    const int t = item >> 1, half = item & 1, gi = half * 2 + (lane >> 5), w = 2 << gi, col = half * 512 + lane * 8;
    const int cnt = (t + 1) < w ? (t + 1) : w;
    float s[8];
#pragma unroll
    for (int e = 0; e < 8; ++e) s[e] = 0.f;
    float u0[8];
    for (int i = 0; i < cnt; ++i) {
        const u32x4 v = *(const GAS u32x4*)(U + (size_t)(t - i) * POOLW + col);
        const float f[8] = {bflo(v.x), bfhi(v.x), bflo(v.y), bfhi(v.y), bflo(v.z), bfhi(v.z), bflo(v.w), bfhi(v.w)};
#pragma unroll
        for (int e = 0; e < 8; ++e) { s[e] += f[e]; if (i == 0) u0[e] = f[e]; }
    }
    const float inv = 1.f / (float)cnt;
    u32x4 o; o.x = pk2(s[0] * inv - u0[0], s[1] * inv - u0[1]); o.y = pk2(s[2] * inv - u0[2], s[3] * inv - u0[3]); o.z = pk2(s[4] * inv - u0[4], s[5] * inv - u0[5]); o.w = pk2(s[6] * inv - u0[6], s[7] * inv - u0[7]);
    *(GAS u32x4*)(YP + (size_t)t * POOLW + col) = o;
}
__device__ __forceinline__ void cmp_final_item(const gfl* PQ, const gfl* PEB, const gfl* w2  , gbf* KC, gbf* VCT, LAS float* hid, int item, int lane) {
    const int kv = item >> 12, g = (item >> 10) & 3, n = item & 1023;
    float out = 0.f;
    if (n < NCMP) {
        const gfl* p1 = PQ + ((size_t)kv * 4096 + g * 1024 + n) * 256; const gfl* p2 = p1 + 256 + 128;
#pragma unroll
        for (int hh = 0; hh < 2; ++hh) { const int j = lane + 64 * hh; float pe = 0.f;
#pragma unroll
            for (int p = 0; p < 8; ++p) pe += PEB[p * 256 + kv * 128 + j];
            hid[j] = gelu_tanh(p1[j] + p2[j] + pe); }
        LDS_WAIT(); asm volatile("" ::: "memory");
        const gfl* wp = w2 + (size_t)kv * 128 * 64 + lane;
#pragma unroll 8
        for (int j = 0; j < 128; ++j) out += hid[j] * wp[j * 64];
        LDS_WAIT(); asm volatile("" ::: "memory");
    }
    if (kv == 0) KC[((size_t)g * 1024 + n) * 64 + lane] = (bf16)f2bf(out);
    else VCT[((size_t)g * 64 + lane) * 1024 + n] = (bf16)f2bf(out);
}

struct Args { const float* in[25]; float* out; unsigned char* ws; int l_lo, l_hi, ph_lo, ph_hi, use_bar, pad; };
enum { I_X = 0, I_MEM, I_RELB, I_LN_MIX_PRE, I_LN_MIX_POST, I_LN_X_PRE, I_LN_X_POST, I_LN_MEM, I_LN_FFN_PRE, I_LN_FFN_POST, I_W_IN, I_CMP_PE, I_CMP_W1, I_CMP_W2, I_W_POOL, I_POOL_SCALE,
       I_W_BR_ATTN, I_W_BR_POOL, I_W_MIX_OUT, I_W_XQ, I_W_XKV, I_W_XO, I_W_GATE, I_W_UP, I_W_DOWN };
constexpr int NPHASE = 17;
constexpr int TR_SCR_STRIDE = 12288, TR_TAB_OFF = 8 * TR_SCR_STRIDE;
__device__ __forceinline__ gby* launder_ptr(gby* p) { asm volatile("" : "+s"(p)); return p; }
__device__ __forceinline__ int launder_int(int v) { asm volatile("" : "+s"(v)); return v; }
template <class T> __device__ __forceinline__ T* uniform_ptr(T* p) { const unsigned long long v = (unsigned long long)p; const unsigned lo = (unsigned)__builtin_amdgcn_readfirstlane((int)(unsigned)v), hi = (unsigned)__builtin_amdgcn_readfirstlane((int)(unsigned)(v >> 32)); return (T*)(((unsigned long long)hi << 32) | lo); }

__device__ __forceinline__ void tr_run(Frame& F, int nd, int total) {
    const LAS TrDesc* tab = (const LAS TrDesc*)(F.lds + TR_TAB_OFF); LAS float* scr = (LAS float*)(F.lds + F.wave * TR_SCR_STRIDE);
#pragma unroll 1
    for (int it = F.gw; it < total; it += F.NGW) {
        int d = 0;
#pragma unroll 1
        for (int e = 1; e < nd; ++e) if (tab[e].start <= it) d = e;
        d = __builtin_amdgcn_readfirstlane(d);
        const gfl* W = uniform_ptr(tab[d].W); gbf* WT = uniform_ptr(tab[d].WT); const gfl* cs = uniform_ptr(tab[d].cs);
        const int N = __builtin_amdgcn_readfirstlane(tab[d].N), ldk = __builtin_amdgcn_readfirstlane(tab[d].ldk), code = __builtin_amdgcn_readfirstlane(tab[d].code), moff = __builtin_amdgcn_readfirstlane(tab[d].moff), st = __builtin_amdgcn_readfirstlane(tab[d].start);
        tr_item(W, N, WT, ldk, scr, it - st, F.lane, code, moff, cs);
    }
}
#define TR_PUT(W_, K_, N_, WT_, ldk_, code_, moff_, cs_) do { tab[nd].W = (W_); tab[nd].WT = (WT_); tab[nd].cs = (cs_); tab[nd].K = (K_); tab[nd].N = (N_); tab[nd].ldk = (ldk_); tab[nd].code = (code_); tab[nd].moff = (moff_); \
    tab[nd].start = total; total += ((K_) / 64) * (((N_) + 31) / 32); ++nd; } while (0)

#define PHASE_BEGIN() gby* const w_ = launder_ptr(ws_k); const int b_ = launder_int(bid_k); Frame F = F0; \
    { int t_ = F0.tid; asm volatile("" : "+v"(t_)); const int v_ = launder_int(F0.vcu); F.tid = t_; F.lane = t_ & 63; F.wave = __builtin_amdgcn_readfirstlane(t_ >> 6); F.vcu = v_; F.gw = v_ * NWAVES + F.wave; F.ws = w_; }
__global__ void __launch_bounds__(NWAVES * 64, 2) mega_fwd(Args args) {
    extern __shared__ __attribute__((aligned(16))) unsigned char lds_raw[];
    Frame F;
    F.lds = (LAS unsigned char*)lds_raw;
    F.tid = threadIdx.x; F.lane = F.tid & 63; F.wave = __builtin_amdgcn_readfirstlane(F.tid >> 6);
    F.G = gridDim.x; { const int bx = blockIdx.x; F.vcu = (F.G % 8 == 0) ? (bx % 8) * (F.G / 8) + bx / 8 : bx; }
    F.gw = F.vcu * NWAVES + F.wave; F.NGW = F.G * NWAVES; F.ws = (gby*)args.ws;
    gby* const ws = (gby*)args.ws; gby* const ws_k = ws;
#define INP(i) ((const gfl*)args.in[i])
    volatile LAS unsigned* MISC = (volatile LAS unsigned*)(F.lds + MISC_OFF);
    for (int u = F.tid; u < (LDS_BYTES - LDSCTL_OFF) / 4; u += NWAVES * 64) ((LAS unsigned*)(F.lds + LDSCTL_OFF))[u] = 0u;
    __syncthreads();
    XcdBarrier bar; bar.bar = (GAS unsigned*)(ws + WS_CTL) + CW_BAR; bar.x = 0; bar.st = nullptr;
    const bool use_bar = args.use_bar != 0;
    if (use_bar) bar = xcd_barrier_post((GAS unsigned*)(ws + WS_CTL) + CW_BAR, MISC + 8);
#define SEAM() do { if (use_bar) xcd_barrier(bar); } while (0)
    const int phmask = (int)(((1u << args.ph_hi) - 1u) & ~((1u << args.ph_lo) - 1u));
#ifndef PHMASK
#define PHMASK 0x1ffff
#endif
#define IN(k) (((PHMASK >> (k)) & 1) && ((launder_int(phmask) >> (k)) & 1))
    gfl* const X = (gfl*)args.out;
    gbf* const H = (gbf*)(ws + WS_H);
    const int bid = (int)blockIdx.x; const int bid_k = bid;
    LAS int* const trn = (LAS int*)(F.lds + TR_TAB_OFF + 32 * 48);

    if (args.l_lo == 0 && IN(0)) {
        if (F.tid == 0) { LAS TrDesc* tab = (LAS TrDesc*)(F.lds + TR_TAB_OFF); int nd = launder_int(0), total = launder_int(0);
            for (int l = 0; l < NL; ++l) TR_PUT(INP(I_W_XKV) + (size_t)l * DM * 1024, DM, 1024, (gbf*)(ws + WS_WXKV) + (size_t)l * 1024 * DM, DM, 0, 0, (const gfl*)nullptr);
            trn[0] = nd; trn[1] = total; }
        LDS_WAIT(); __syncthreads();
        tr_run(F, trn[0], trn[1]);
        for (int it = F.gw; it < 4 * NMEM; it += F.NGW) { const int l = it >> 8, r = it & 255;
            rms_row_to_bf16(INP(I_MEM) + (size_t)r * DM, INP(I_LN_MEM) + (size_t)l * DM, (gbf*)(ws + WS_MEMN) + ((size_t)l * NMEM + r) * DM, F.lane); }
        for (int m = F.gw; m < S_; m += F.NGW) {
            const gfl* xr = INP(I_X) + (size_t)m * DM; gfl* xo = X + (size_t)m * DM;
#pragma unroll
            for (int j = 0; j < 8; ++j) *(GAS f32x4*)(xo + 4 * (F.lane + 64 * j)) = *(const GAS f32x4*)(xr + 4 * (F.lane + 64 * j));
            rms_row_to_bf16(xr, INP(I_LN_MIX_PRE), H + (size_t)m * DM, F.lane);
        }
        __syncthreads();
        SEAM();
    }
    if (args.l_lo == 0 && IN(1)) {
        pg8::Sched<1, 4, 4, false> S; S.init(F.G, bid);
        EpiKVmem E{(gbf*)(ws + WS_KM), (gbf*)(ws + WS_VMT)};
        pg8::gemm_phase<DM, DM, DM, (long)NMEM * DM, (long)1024 * DM>(F.lds, F.tid, (const gbf*)(ws + WS_MEMN), (const gbf*)(ws + WS_WXKV), S, E);
        SEAM();
    }

    const Frame F0 = F;
    const int l_lo = args.l_lo, l_hi = args.l_hi;

    if (launder_int(l_lo) <= 0 && 0 < launder_int(l_hi)) { constexpr int l = 0;
        if (IN(2)) { PHASE_BEGIN();
            if (F.tid == 0) { LAS TrDesc* tab = (LAS TrDesc*)(F.lds + TR_TAB_OFF); int nd = launder_int(0), total = launder_int(0); const gfl* nul = nullptr;
                TR_PUT(INP(I_W_IN) + (size_t)l * DM * INW, DM, INW, (gbf*)(w_ + WS_WIN), DM, 1, 0, nul);
                TR_PUT(INP(I_W_BR_ATTN) + (size_t)l * NSAW * DM, NSAW, DM, (gbf*)(w_ + WS_WBRA), NSAW, 0, 0, nul);
                TR_PUT(INP(I_W_BR_POOL) + (size_t)l * POOLW * DM, POOLW, DM, (gbf*)(w_ + WS_WBRP), POOLW, 0, 0, nul);
                TR_PUT(INP(I_W_MIX_OUT) + (size_t)l * DM * DM, DM, DM, (gbf*)(w_ + WS_WMIX), DM, 0, 0, nul);
                TR_PUT(INP(I_W_XQ) + (size_t)l * DM * XW, DM, XW, (gbf*)(w_ + WS_WXQ), DM, 0, 0, nul);
                TR_PUT(INP(I_W_XO) + (size_t)l * XW * DM, XW, DM, (gbf*)(w_ + WS_WXO), XW, 0, 0, nul);
                TR_PUT(INP(I_W_GATE) + (size_t)l * DM * DFF, DM, DFF, (gbf*)(w_ + WS_WGU), DM, 2, 0, nul);
                TR_PUT(INP(I_W_UP) + (size_t)l * DM * DFF, DM, DFF, (gbf*)(w_ + WS_WGU), DM, 2, 128, nul);
                TR_PUT(INP(I_W_DOWN) + (size_t)l * DFF * DM, DFF, DM, (gbf*)(w_ + WS_WDN), DFF, 0, 0, nul);
                for (int q = 0; q < 4; ++q) { const int kv = q >> 1, half = q & 1;
                    TR_PUT(INP(I_CMP_W1) + (((size_t)l * 2 + kv) * 2048 + half * 1024) * 128, 1024, 128, (gbf*)(w_ + WS_WC1) + (size_t)kv * 256 * 1024, 1024, 0, half * 128, nul); }
                for (int gi = 0; gi < 4; ++gi)
                    TR_PUT(INP(I_W_POOL) + ((size_t)l * 4 + gi) * 65536, 256, 256, (gbf*)(w_ + WS_WPOOL) + (size_t)gi * 65536, 256, 0, 0, INP(I_POOL_SCALE) + (size_t)l * POOLW + gi * 256);
                trn[0] = nd; trn[1] = total; }
            LDS_WAIT(); __syncthreads();
            if (F.gw < 32) {
                const int p = F.gw >> 2, kv = (F.gw >> 1) & 1, j = (F.gw & 1) * 64 + F.lane;
                const gfl* pe = INP(I_CMP_PE) + ((size_t)l * 2 + kv) * 2048 + p * 256; const gfl* w1 = INP(I_CMP_W1) + (((size_t)l * 2 + kv) * 2048 + p * 256) * 128 + j;
                float a = 0.f;
#pragma unroll 8
                for (int k = 0; k < 256; ++k) a += pe[k] * w1[(size_t)k * 128];
                ((gfl*)(w_ + WS_PEB))[p * 256 + kv * 128 + j] = a;
            }
            tr_run(F, trn[0], trn[1]);
            __syncthreads();
            SEAM();
        }
        if (IN(3)) { PHASE_BEGIN();
            pg8::Sched<S_ / 256, ZN / 256, 1, false> S; S.init(F.G, b_);
            EpiZ E{w_};
            pg8::gemm_phase<DM, DM, DM, 0, 0>(F.lds, F.tid, H, (const gbf*)(w_ + WS_WIN), S, E);
            SEAM();
        }
        if (IN(4)) { PHASE_BEGIN();
#pragma unroll 1
            for (int it = F.gw; it < 2 * S_; it += F.NGW) pool_item((const gbf*)(w_ + WS_U), (gbf*)(w_ + WS_YP), it, F.lane);
            __syncthreads();
            pg8::Sched<16, 1, 2, false> S; S.init(F.G, b_);
            EpiF32 E{(gfl*)(w_ + WS_PQ), 256, (size_t)4096 * 256};
            pg8::gemm_phase<1024, 1024, 1024, (long)(WS_VCR - WS_KCR) / 2, (long)256 * 1024>(F.lds, F.tid, (const gbf*)(w_ + WS_KCR), (const gbf*)(w_ + WS_WC1), S, E);
            SEAM();
        }
        if (IN(5)) { PHASE_BEGIN();
            LAS float* hid = (LAS float*)(F.lds + F.wave * 1024);
#pragma unroll 1
            for (int it = F.gw; it < 8192; it += F.NGW) cmp_final_item((const gfl*)(w_ + WS_PQ), (const gfl*)(w_ + WS_PEB), INP(I_CMP_W2) + (size_t)l * 2 * 128 * 64, (gbf*)(w_ + WS_KC), (gbf*)(w_ + WS_VCT), hid, it, F.lane);
            __syncthreads();
            pg8::Sched<S_ / 256, 1, 4, false> S; S.init(F.G, b_);
            EpiBf16 E{(gbf*)(w_ + WS_P), POOLW, 256, 1.f};
            pg8::gemm_phase<POOLW, 256, 256, 256, 65536>(F.lds, F.tid, (const gbf*)(w_ + WS_YP), (const gbf*)(w_ + WS_WPOOL), S, E);
            SEAM();
        }
        if (IN(6)) { PHASE_BEGIN();
            attn_setup_tables(F, INP(I_RELB));
            const AttnPtrs P{(const gbf*)(w_ + WS_Q), (const gbf*)(w_ + WS_KC), (const gbf*)(w_ + WS_VCT), (const gbf*)(w_ + WS_KSEL), (const gbf*)(w_ + WS_VSELT), (const gbf*)(w_ + WS_KWIN), (const gbf*)(w_ + WS_VWINT),
                             (const gfl*)(w_ + WS_GL), (gbf*)(w_ + WS_A)};
#pragma unroll 1
            for (int it = F.gw; it < (S_ / 4) * NGRP; it += F.NGW) nsa_unit_v1(F, P, it >> 2, it & 3);
            __syncthreads();
            SEAM();
        }
        if (IN(7)) { PHASE_BEGIN();
            pg8::Sched<S_ / 256, DM / 256, 2, true> S; S.init(F.G, b_);
            EpiMerge E{(gbf*)(w_ + WS_Y1), (const gbf*)(w_ + WS_MG)};
            pg8::gemm_phase<NSAW, NSAW, NSAW, (long)(WS_P - WS_A) / 2, (long)(WS_WBRP - WS_WBRA) / 2>(F.lds, F.tid, (const gbf*)(w_ + WS_A), (const gbf*)(w_ + WS_WBRA), S, E);
            SEAM();
        }
        if (IN(8)) { PHASE_BEGIN();
            pg8::Sched<S_ / 256, DM / 256, 1, false> S; S.init(F.G, b_);
            EpiBf16 E{(gbf*)(w_ + WS_Y2), DM, 0, 1.f};
            pg8::gemm_phase<DM, DM, DM, 0, 0>(F.lds, F.tid, (const gbf*)(w_ + WS_Y1), (const gbf*)(w_ + WS_WMIX), S, E);
            SEAM();
        }
        if (IN(9)) { PHASE_BEGIN();
#pragma unroll 1
            for (int m = F.gw; m < S_; m += F.NGW) resid_row(X + (size_t)m * DM, X + (size_t)m * DM, (const gbf*)(w_ + WS_Y2) + (size_t)m * DM, INP(I_LN_MIX_POST) + (size_t)l * DM, INP(I_LN_X_PRE) + (size_t)l * DM, H + (size_t)m * DM, F.lane);
            SEAM();
        }
        if (IN(10)) { PHASE_BEGIN();
            pg8::Sched<S_ / 256, XW / 256, 1, false> S; S.init(F.G, b_);
            EpiBf16 E{(gbf*)(w_ + WS_Q2), XW, 0, 1.f};
            pg8::gemm_phase<DM, DM, DM, 0, 0>(F.lds, F.tid, H, (const gbf*)(w_ + WS_WXQ), S, E);
            SEAM();
        }
        if (IN(11)) { PHASE_BEGIN();
#pragma unroll 1
            for (int it = F.gw; it < (S_ / 16) * 4; it += F.NGW) xattn_unit_v1(F, (const gbf*)(w_ + WS_Q2), (const gbf*)(w_ + WS_KM) + (size_t)l * NMEM * XW, (const gbf*)(w_ + WS_VMT) + (size_t)l * XW * NMEM, (gbf*)(w_ + WS_O2), it >> 2, it & 3);
            SEAM();
        }
        if (IN(12)) { PHASE_BEGIN();
            pg8::Sched<S_ / 256, DM / 256, 1, false> S; S.init(F.G, b_);
            EpiBf16 E{(gbf*)(w_ + WS_Y2), DM, 0, 1.f};
            pg8::gemm_phase<XW, XW, XW, 0, 0>(F.lds, F.tid, (const gbf*)(w_ + WS_O2), (const gbf*)(w_ + WS_WXO), S, E);
            SEAM();
        }
        if (IN(13)) { PHASE_BEGIN();
#pragma unroll 1
            for (int m = F.gw; m < S_; m += F.NGW) resid_row(X + (size_t)m * DM, X + (size_t)m * DM, (const gbf*)(w_ + WS_Y2) + (size_t)m * DM, INP(I_LN_X_POST) + (size_t)l * DM, INP(I_LN_FFN_PRE) + (size_t)l * DM, H + (size_t)m * DM, F.lane);
            SEAM();
        }
        if (IN(14)) { PHASE_BEGIN();
            pg8::Sched<S_ / 256, 2 * DFF / 256, 1, false> S; S.init(F.G, b_);
            EpiSwiGLU E{(gbf*)(w_ + WS_HID)};
            pg8::gemm_phase<DM, DM, DM, 0, 0>(F.lds, F.tid, H, (const gbf*)(w_ + WS_WGU), S, E);
            SEAM();
        }
        if (IN(15)) { PHASE_BEGIN();
            pg8::Sched<S_ / 256, DM / 256, 1, false> S; S.init(F.G, b_);
            EpiBf16 E{(gbf*)(w_ + WS_Y2), DM, 0, 1.f};
            pg8::gemm_phase<DFF, DFF, DFF, 0, 0>(F.lds, F.tid, (const gbf*)(w_ + WS_HID), (const gbf*)(w_ + WS_WDN), S, E);
            SEAM();
        }
        if (IN(16)) { PHASE_BEGIN();
            const gfl* gpre = (l + 1 < NL) ? INP(I_LN_MIX_PRE) + (size_t)(l + 1) * DM : (const gfl*)nullptr;
#pragma unroll 1
            for (int m = F.gw; m < S_; m += F.NGW) resid_row(X + (size_t)m * DM, X + (size_t)m * DM, (const gbf*)(w_ + WS_Y2) + (size_t)m * DM, INP(I_LN_FFN_POST) + (size_t)l * DM, gpre, H + (size_t)m * DM, F.lane);
            if (l + 1 < launder_int(l_hi)) SEAM();
        }
    }

    if (launder_int(l_lo) <= 1 && 1 < launder_int(l_hi)) { constexpr int l = 1;
        if (IN(2)) { PHASE_BEGIN();
            if (F.tid == 0) { LAS TrDesc* tab = (LAS TrDesc*)(F.lds + TR_TAB_OFF); int nd = launder_int(0), total = launder_int(0); const gfl* nul = nullptr;
                TR_PUT(INP(I_W_IN) + (size_t)l * DM * INW, DM, INW, (gbf*)(w_ + WS_WIN), DM, 1, 0, nul);
                TR_PUT(INP(I_W_BR_ATTN) + (size_t)l * NSAW * DM, NSAW, DM, (gbf*)(w_ + WS_WBRA), NSAW, 0, 0, nul);
                TR_PUT(INP(I_W_BR_POOL) + (size_t)l * POOLW * DM, POOLW, DM, (gbf*)(w_ + WS_WBRP), POOLW, 0, 0, nul);
                TR_PUT(INP(I_W_MIX_OUT) + (size_t)l * DM * DM, DM, DM, (gbf*)(w_ + WS_WMIX), DM, 0, 0, nul);
                TR_PUT(INP(I_W_XQ) + (size_t)l * DM * XW, DM, XW, (gbf*)(w_ + WS_WXQ), DM, 0, 0, nul);
                TR_PUT(INP(I_W_XO) + (size_t)l * XW * DM, XW, DM, (gbf*)(w_ + WS_WXO), XW, 0, 0, nul);
                TR_PUT(INP(I_W_GATE) + (size_t)l * DM * DFF, DM, DFF, (gbf*)(w_ + WS_WGU), DM, 2, 0, nul);
                TR_PUT(INP(I_W_UP) + (size_t)l * DM * DFF, DM, DFF, (gbf*)(w_ + WS_WGU), DM, 2, 128, nul);
                TR_PUT(INP(I_W_DOWN) + (size_t)l * DFF * DM, DFF, DM, (gbf*)(w_ + WS_WDN), DFF, 0, 0, nul);
                for (int q = 0; q < 4; ++q) { const int kv = q >> 1, half = q & 1;
                    TR_PUT(INP(I_CMP_W1) + (((size_t)l * 2 + kv) * 2048 + half * 1024) * 128, 1024, 128, (gbf*)(w_ + WS_WC1) + (size_t)kv * 256 * 1024, 1024, 0, half * 128, nul); }
                for (int gi = 0; gi < 4; ++gi)
                    TR_PUT(INP(I_W_POOL) + ((size_t)l * 4 + gi) * 65536, 256, 256, (gbf*)(w_ + WS_WPOOL) + (size_t)gi * 65536, 256, 0, 0, INP(I_POOL_SCALE) + (size_t)l * POOLW + gi * 256);
                trn[0] = nd; trn[1] = total; }
            LDS_WAIT(); __syncthreads();
            if (F.gw < 32) {
                const int p = F.gw >> 2, kv = (F.gw >> 1) & 1, j = (F.gw & 1) * 64 + F.lane;
                const gfl* pe = INP(I_CMP_PE) + ((size_t)l * 2 + kv) * 2048 + p * 256; const gfl* w1 = INP(I_CMP_W1) + (((size_t)l * 2 + kv) * 2048 + p * 256) * 128 + j;
                float a = 0.f;
#pragma unroll 8
                for (int k = 0; k < 256; ++k) a += pe[k] * w1[(size_t)k * 128];
                ((gfl*)(w_ + WS_PEB))[p * 256 + kv * 128 + j] = a;
            }
            tr_run(F, trn[0], trn[1]);
            __syncthreads();
            SEAM();
        }
        if (IN(3)) { PHASE_BEGIN();
            pg8::Sched<S_ / 256, ZN / 256, 1, false> S; S.init(F.G, b_);
            EpiZ E{w_};
            pg8::gemm_phase<DM, DM, DM, 0, 0>(F.lds, F.tid, H, (const gbf*)(w_ + WS_WIN), S, E);
            SEAM();
        }
        if (IN(4)) { PHASE_BEGIN();
#pragma unroll 1
            for (int it = F.gw; it < 2 * S_; it += F.NGW) pool_item((const gbf*)(w_ + WS_U), (gbf*)(w_ + WS_YP), it, F.lane);
            __syncthreads();
            pg8::Sched<16, 1, 2, false> S; S.init(F.G, b_);
            EpiF32 E{(gfl*)(w_ + WS_PQ), 256, (size_t)4096 * 256};
            pg8::gemm_phase<1024, 1024, 1024, (long)(WS_VCR - WS_KCR) / 2, (long)256 * 1024>(F.lds, F.tid, (const gbf*)(w_ + WS_KCR), (const gbf*)(w_ + WS_WC1), S, E);
            SEAM();
        }
        if (IN(5)) { PHASE_BEGIN();
            LAS float* hid = (LAS float*)(F.lds + F.wave * 1024);
#pragma unroll 1
            for (int it = F.gw; it < 8192; it += F.NGW) cmp_final_item((const gfl*)(w_ + WS_PQ), (const gfl*)(w_ + WS_PEB), INP(I_CMP_W2) + (size_t)l * 2 * 128 * 64, (gbf*)(w_ + WS_KC), (gbf*)(w_ + WS_VCT), hid, it, F.lane);
            __syncthreads();
            pg8::Sched<S_ / 256, 1, 4, false> S; S.init(F.G, b_);
            EpiBf16 E{(gbf*)(w_ + WS_P), POOLW, 256, 1.f};
            pg8::gemm_phase<POOLW, 256, 256, 256, 65536>(F.lds, F.tid, (const gbf*)(w_ + WS_YP), (const gbf*)(w_ + WS_WPOOL), S, E);
            SEAM();
        }
        if (IN(6)) { PHASE_BEGIN();
            attn_setup_tables(F, INP(I_RELB));
            const AttnPtrs P{(const gbf*)(w_ + WS_Q), (const gbf*)(w_ + WS_KC), (const gbf*)(w_ + WS_VCT), (const gbf*)(w_ + WS_KSEL), (const gbf*)(w_ + WS_VSELT), (const gbf*)(w_ + WS_KWIN), (const gbf*)(w_ + WS_VWINT),
                             (const gfl*)(w_ + WS_GL), (gbf*)(w_ + WS_A)};
#pragma unroll 1
            for (int it = F.gw; it < (S_ / 4) * NGRP; it += F.NGW) nsa_unit_v1(F, P, it >> 2, it & 3);
            __syncthreads();
            SEAM();
        }
        if (IN(7)) { PHASE_BEGIN();
            pg8::Sched<S_ / 256, DM / 256, 2, true> S; S.init(F.G, b_);
            EpiMerge E{(gbf*)(w_ + WS_Y1), (const gbf*)(w_ + WS_MG)};
            pg8::gemm_phase<NSAW, NSAW, NSAW, (long)(WS_P - WS_A) / 2, (long)(WS_WBRP - WS_WBRA) / 2>(F.lds, F.tid, (const gbf*)(w_ + WS_A), (const gbf*)(w_ + WS_WBRA), S, E);
            SEAM();
        }
        if (IN(8)) { PHASE_BEGIN();
            pg8::Sched<S_ / 256, DM / 256, 1, false> S; S.init(F.G, b_);
            EpiBf16 E{(gbf*)(w_ + WS_Y2), DM, 0, 1.f};
            pg8::gemm_phase<DM, DM, DM, 0, 0>(F.lds, F.tid, (const gbf*)(w_ + WS_Y1), (const gbf*)(w_ + WS_WMIX), S, E);
            SEAM();
        }
        if (IN(9)) { PHASE_BEGIN();
#pragma unroll 1
            for (int m = F.gw; m < S_; m += F.NGW) resid_row(X + (size_t)m * DM, X + (size_t)m * DM, (const gbf*)(w_ + WS_Y2) + (size_t)m * DM, INP(I_LN_MIX_POST) + (size_t)l * DM, INP(I_LN_X_PRE) + (size_t)l * DM, H + (size_t)m * DM, F.lane);
            SEAM();
        }
        if (IN(10)) { PHASE_BEGIN();
            pg8::Sched<S_ / 256, XW / 256, 1, false> S; S.init(F.G, b_);
            EpiBf16 E{(gbf*)(w_ + WS_Q2), XW, 0, 1.f};
            pg8::gemm_phase<DM, DM, DM, 0, 0>(F.lds, F.tid, H, (const gbf*)(w_ + WS_WXQ), S, E);
            SEAM();
        }
        if (IN(11)) { PHASE_BEGIN();
#pragma unroll 1
            for (int it = F.gw; it < (S_ / 16) * 4; it += F.NGW) xattn_unit_v1(F, (const gbf*)(w_ + WS_Q2), (const gbf*)(w_ + WS_KM) + (size_t)l * NMEM * XW, (const gbf*)(w_ + WS_VMT) + (size_t)l * XW * NMEM, (gbf*)(w_ + WS_O2), it >> 2, it & 3);
            SEAM();
        }
        if (IN(12)) { PHASE_BEGIN();
            pg8::Sched<S_ / 256, DM / 256, 1, false> S; S.init(F.G, b_);
            EpiBf16 E{(gbf*)(w_ + WS_Y2), DM, 0, 1.f};
            pg8::gemm_phase<XW, XW, XW, 0, 0>(F.lds, F.tid, (const gbf*)(w_ + WS_O2), (const gbf*)(w_ + WS_WXO), S, E);
            SEAM();
        }
        if (IN(13)) { PHASE_BEGIN();
#pragma unroll 1
            for (int m = F.gw; m < S_; m += F.NGW) resid_row(X + (size_t)m * DM, X + (size_t)m * DM, (const gbf*)(w_ + WS_Y2) + (size_t)m * DM, INP(I_LN_X_POST) + (size_t)l * DM, INP(I_LN_FFN_PRE) + (size_t)l * DM, H + (size_t)m * DM, F.lane);
            SEAM();
        }
        if (IN(14)) { PHASE_BEGIN();
            pg8::Sched<S_ / 256, 2 * DFF / 256, 1, false> S; S.init(F.G, b_);
            EpiSwiGLU E{(gbf*)(w_ + WS_HID)};
            pg8::gemm_phase<DM, DM, DM, 0, 0>(F.lds, F.tid, H, (const gbf*)(w_ + WS_WGU), S, E);
            SEAM();
        }
        if (IN(15)) { PHASE_BEGIN();
            pg8::Sched<S_ / 256, DM / 256, 1, false> S; S.init(F.G, b_);
            EpiBf16 E{(gbf*)(w_ + WS_Y2), DM, 0, 1.f};
            pg8::gemm_phase<DFF, DFF, DFF, 0, 0>(F.lds, F.tid, (const gbf*)(w_ + WS_HID), (const gbf*)(w_ + WS_WDN), S, E);
            SEAM();
        }
        if (IN(16)) { PHASE_BEGIN();
            const gfl* gpre = (l + 1 < NL) ? INP(I_LN_MIX_PRE) + (size_t)(l + 1) * DM : (const gfl*)nullptr;
#pragma unroll 1
            for (int m = F.gw; m < S_; m += F.NGW) resid_row(X + (size_t)m * DM, X + (size_t)m * DM, (const gbf*)(w_ + WS_Y2) + (size_t)m * DM, INP(I_LN_FFN_POST) + (size_t)l * DM, gpre, H + (size_t)m * DM, F.lane);
            if (l + 1 < launder_int(l_hi)) SEAM();
        }
    }

    if (launder_int(l_lo) <= 2 && 2 < launder_int(l_hi)) { constexpr int l = 2;
        if (IN(2)) { PHASE_BEGIN();
            if (F.tid == 0) { LAS TrDesc* tab = (LAS TrDesc*)(F.lds + TR_TAB_OFF); int nd = launder_int(0), total = launder_int(0); const gfl* nul = nullptr;
                TR_PUT(INP(I_W_IN) + (size_t)l * DM * INW, DM, INW, (gbf*)(w_ + WS_WIN), DM, 1, 0, nul);
                TR_PUT(INP(I_W_BR_ATTN) + (size_t)l * NSAW * DM, NSAW, DM, (gbf*)(w_ + WS_WBRA), NSAW, 0, 0, nul);
                TR_PUT(INP(I_W_BR_POOL) + (size_t)l * POOLW * DM, POOLW, DM, (gbf*)(w_ + WS_WBRP), POOLW, 0, 0, nul);
                TR_PUT(INP(I_W_MIX_OUT) + (size_t)l * DM * DM, DM, DM, (gbf*)(w_ + WS_WMIX), DM, 0, 0, nul);
                TR_PUT(INP(I_W_XQ) + (size_t)l * DM * XW, DM, XW, (gbf*)(w_ + WS_WXQ), DM, 0, 0, nul);
                TR_PUT(INP(I_W_XO) + (size_t)l * XW * DM, XW, DM, (gbf*)(w_ + WS_WXO), XW, 0, 0, nul);
                TR_PUT(INP(I_W_GATE) + (size_t)l * DM * DFF, DM, DFF, (gbf*)(w_ + WS_WGU), DM, 2, 0, nul);
                TR_PUT(INP(I_W_UP) + (size_t)l * DM * DFF, DM, DFF, (gbf*)(w_ + WS_WGU), DM, 2, 128, nul);
                TR_PUT(INP(I_W_DOWN) + (size_t)l * DFF * DM, DFF, DM, (gbf*)(w_ + WS_WDN), DFF, 0, 0, nul);
                for (int q = 0; q < 4; ++q) { const int kv = q >> 1, half = q & 1;
                    TR_PUT(INP(I_CMP_W1) + (((size_t)l * 2 + kv) * 2048 + half * 1024) * 128, 1024, 128, (gbf*)(w_ + WS_WC1) + (size_t)kv * 256 * 1024, 1024, 0, half * 128, nul); }
                for (int gi = 0; gi < 4; ++gi)
                    TR_PUT(INP(I_W_POOL) + ((size_t)l * 4 + gi) * 65536, 256, 256, (gbf*)(w_ + WS_WPOOL) + (size_t)gi * 65536, 256, 0, 0, INP(I_POOL_SCALE) + (size_t)l * POOLW + gi * 256);
                trn[0] = nd; trn[1] = total; }
            LDS_WAIT(); __syncthreads();
            if (F.gw < 32) {
                const int p = F.gw >> 2, kv = (F.gw >> 1) & 1, j = (F.gw & 1) * 64 + F.lane;
                const gfl* pe = INP(I_CMP_PE) + ((size_t)l * 2 + kv) * 2048 + p * 256; const gfl* w1 = INP(I_CMP_W1) + (((size_t)l * 2 + kv) * 2048 + p * 256) * 128 + j;
                float a = 0.f;
#pragma unroll 8
                for (int k = 0; k < 256; ++k) a += pe[k] * w1[(size_t)k * 128];
                ((gfl*)(w_ + WS_PEB))[p * 256 + kv * 128 + j] = a;
            }
            tr_run(F, trn[0], trn[1]);
            __syncthreads();
            SEAM();
        }
        if (IN(3)) { PHASE_BEGIN();
            pg8::Sched<S_ / 256, ZN / 256, 1, false> S; S.init(F.G, b_);
            EpiZ E{w_};
            pg8::gemm_phase<DM, DM, DM, 0, 0>(F.lds, F.tid, H, (const gbf*)(w_ + WS_WIN), S, E);
            SEAM();
        }
        if (IN(4)) { PHASE_BEGIN();
#pragma unroll 1
            for (int it = F.gw; it < 2 * S_; it += F.NGW) pool_item((const gbf*)(w_ + WS_U), (gbf*)(w_ + WS_YP), it, F.lane);
            __syncthreads();
            pg8::Sched<16, 1, 2, false> S; S.init(F.G, b_);
            EpiF32 E{(gfl*)(w_ + WS_PQ), 256, (size_t)4096 * 256};
            pg8::gemm_phase<1024, 1024, 1024, (long)(WS_VCR - WS_KCR) / 2, (long)256 * 1024>(F.lds, F.tid, (const gbf*)(w_ + WS_KCR), (const gbf*)(w_ + WS_WC1), S, E);
            SEAM();
        }
        if (IN(5)) { PHASE_BEGIN();
            LAS float* hid = (LAS float*)(F.lds + F.wave * 1024);
#pragma unroll 1
            for (int it = F.gw; it < 8192; it += F.NGW) cmp_final_item((const gfl*)(w_ + WS_PQ), (const gfl*)(w_ + WS_PEB), INP(I_CMP_W2) + (size_t)l * 2 * 128 * 64, (gbf*)(w_ + WS_KC), (gbf*)(w_ + WS_VCT), hid, it, F.lane);
            __syncthreads();
            pg8::Sched<S_ / 256, 1, 4, false> S; S.init(F.G, b_);
            EpiBf16 E{(gbf*)(w_ + WS_P), POOLW, 256, 1.f};
            pg8::gemm_phase<POOLW, 256, 256, 256, 65536>(F.lds, F.tid, (const gbf*)(w_ + WS_YP), (const gbf*)(w_ + WS_WPOOL), S, E);
            SEAM();
        }
        if (IN(6)) { PHASE_BEGIN();
            attn_setup_tables(F, INP(I_RELB));
            const AttnPtrs P{(const gbf*)(w_ + WS_Q), (const gbf*)(w_ + WS_KC), (const gbf*)(w_ + WS_VCT), (const gbf*)(w_ + WS_KSEL), (const gbf*)(w_ + WS_VSELT), (const gbf*)(w_ + WS_KWIN), (const gbf*)(w_ + WS_VWINT),
                             (const gfl*)(w_ + WS_GL), (gbf*)(w_ + WS_A)};
#pragma unroll 1
            for (int it = F.gw; it < (S_ / 4) * NGRP; it += F.NGW) nsa_unit_v1(F, P, it >> 2, it & 3);
            __syncthreads();
            SEAM();
        }
        if (IN(7)) { PHASE_BEGIN();
            pg8::Sched<S_ / 256, DM / 256, 2, true> S; S.init(F.G, b_);
            EpiMerge E{(gbf*)(w_ + WS_Y1), (const gbf*)(w_ + WS_MG)};
            pg8::gemm_phase<NSAW, NSAW, NSAW, (long)(WS_P - WS_A) / 2, (long)(WS_WBRP - WS_WBRA) / 2>(F.lds, F.tid, (const gbf*)(w_ + WS_A), (const gbf*)(w_ + WS_WBRA), S, E);
            SEAM();
        }
        if (IN(8)) { PHASE_BEGIN();
            pg8::Sched<S_ / 256, DM / 256, 1, false> S; S.init(F.G, b_);
            EpiBf16 E{(gbf*)(w_ + WS_Y2), DM, 0, 1.f};
            pg8::gemm_phase<DM, DM, DM, 0, 0>(F.lds, F.tid, (const gbf*)(w_ + WS_Y1), (const gbf*)(w_ + WS_WMIX), S, E);
            SEAM();
        }
        if (IN(9)) { PHASE_BEGIN();
#pragma unroll 1
            for (int m = F.gw; m < S_; m += F.NGW) resid_row(X + (size_t)m * DM, X + (size_t)m * DM, (const gbf*)(w_ + WS_Y2) + (size_t)m * DM, INP(I_LN_MIX_POST) + (size_t)l * DM, INP(I_LN_X_PRE) + (size_t)l * DM, H + (size_t)m * DM, F.lane);
            SEAM();
        }
        if (IN(10)) { PHASE_BEGIN();
            pg8::Sched<S_ / 256, XW / 256, 1, false> S; S.init(F.G, b_);
            EpiBf16 E{(gbf*)(w_ + WS_Q2), XW, 0, 1.f};
            pg8::gemm_phase<DM, DM, DM, 0, 0>(F.lds, F.tid, H, (const gbf*)(w_ + WS_WXQ), S, E);
            SEAM();
        }
        if (IN(11)) { PHASE_BEGIN();
#pragma unroll 1
            for (int it = F.gw; it < (S_ / 16) * 4; it += F.NGW) xattn_unit_v1(F, (const gbf*)(w_ + WS_Q2), (const gbf*)(w_ + WS_KM) + (size_t)l * NMEM * XW, (const gbf*)(w_ + WS_VMT) + (size_t)l * XW * NMEM, (gbf*)(w_ + WS_O2), it >> 2, it & 3);
            SEAM();
        }
        if (IN(12)) { PHASE_BEGIN();
            pg8::Sched<S_ / 256, DM / 256, 1, false> S; S.init(F.G, b_);
            EpiBf16 E{(gbf*)(w_ + WS_Y2), DM, 0, 1.f};
            pg8::gemm_phase<XW, XW, XW, 0, 0>(F.lds, F.tid, (const gbf*)(w_ + WS_O2), (const gbf*)(w_ + WS_WXO), S, E);
            SEAM();
        }
        if (IN(13)) { PHASE_BEGIN();
#pragma unroll 1
            for (int m = F.gw; m < S_; m += F.NGW) resid_row(X + (size_t)m * DM, X + (size_t)m * DM, (const gbf*)(w_ + WS_Y2) + (size_t)m * DM, INP(I_LN_X_POST) + (size_t)l * DM, INP(I_LN_FFN_PRE) + (size_t)l * DM, H + (size_t)m * DM, F.lane);
            SEAM();
        }
        if (IN(14)) { PHASE_BEGIN();
            pg8::Sched<S_ / 256, 2 * DFF / 256, 1, false> S; S.init(F.G, b_);
            EpiSwiGLU E{(gbf*)(w_ + WS_HID)};
            pg8::gemm_phase<DM, DM, DM, 0, 0>(F.lds, F.tid, H, (const gbf*)(w_ + WS_WGU), S, E);
            SEAM();
        }
        if (IN(15)) { PHASE_BEGIN();
            pg8::Sched<S_ / 256, DM / 256, 1, false> S; S.init(F.G, b_);
            EpiBf16 E{(gbf*)(w_ + WS_Y2), DM, 0, 1.f};
            pg8::gemm_phase<DFF, DFF, DFF, 0, 0>(F.lds, F.tid, (const gbf*)(w_ + WS_HID), (const gbf*)(w_ + WS_WDN), S, E);
            SEAM();
        }
        if (IN(16)) { PHASE_BEGIN();
            const gfl* gpre = (l + 1 < NL) ? INP(I_LN_MIX_PRE) + (size_t)(l + 1) * DM : (const gfl*)nullptr;
#pragma unroll 1
            for (int m = F.gw; m < S_; m += F.NGW) resid_row(X + (size_t)m * DM, X + (size_t)m * DM, (const gbf*)(w_ + WS_Y2) + (size_t)m * DM, INP(I_LN_FFN_POST) + (size_t)l * DM, gpre, H + (size_t)m * DM, F.lane);
            if (l + 1 < launder_int(l_hi)) SEAM();
        }
    }

    if (launder_int(l_lo) <= 3 && 3 < launder_int(l_hi)) { constexpr int l = 3;
        if (IN(2)) { PHASE_BEGIN();
            if (F.tid == 0) { LAS TrDesc* tab = (LAS TrDesc*)(F.lds + TR_TAB_OFF); int nd = launder_int(0), total = launder_int(0); const gfl* nul = nullptr;
                TR_PUT(INP(I_W_IN) + (size_t)l * DM * INW, DM, INW, (gbf*)(w_ + WS_WIN), DM, 1, 0, nul);
                TR_PUT(INP(I_W_BR_ATTN) + (size_t)l * NSAW * DM, NSAW, DM, (gbf*)(w_ + WS_WBRA), NSAW, 0, 0, nul);
                TR_PUT(INP(I_W_BR_POOL) + (size_t)l * POOLW * DM, POOLW, DM, (gbf*)(w_ + WS_WBRP), POOLW, 0, 0, nul);
                TR_PUT(INP(I_W_MIX_OUT) + (size_t)l * DM * DM, DM, DM, (gbf*)(w_ + WS_WMIX), DM, 0, 0, nul);
                TR_PUT(INP(I_W_XQ) + (size_t)l * DM * XW, DM, XW, (gbf*)(w_ + WS_WXQ), DM, 0, 0, nul);
                TR_PUT(INP(I_W_XO) + (size_t)l * XW * DM, XW, DM, (gbf*)(w_ + WS_WXO), XW, 0, 0, nul);
                TR_PUT(INP(I_W_GATE) + (size_t)l * DM * DFF, DM, DFF, (gbf*)(w_ + WS_WGU), DM, 2, 0, nul);
                TR_PUT(INP(I_W_UP) + (size_t)l * DM * DFF, DM, DFF, (gbf*)(w_ + WS_WGU), DM, 2, 128, nul);
                TR_PUT(INP(I_W_DOWN) + (size_t)l * DFF * DM, DFF, DM, (gbf*)(w_ + WS_WDN), DFF, 0, 0, nul);
                for (int q = 0; q < 4; ++q) { const int kv = q >> 1, half = q & 1;
                    TR_PUT(INP(I_CMP_W1) + (((size_t)l * 2 + kv) * 2048 + half * 1024) * 128, 1024, 128, (gbf*)(w_ + WS_WC1) + (size_t)kv * 256 * 1024, 1024, 0, half * 128, nul); }
                for (int gi = 0; gi < 4; ++gi)
                    TR_PUT(INP(I_W_POOL) + ((size_t)l * 4 + gi) * 65536, 256, 256, (gbf*)(w_ + WS_WPOOL) + (size_t)gi * 65536, 256, 0, 0, INP(I_POOL_SCALE) + (size_t)l * POOLW + gi * 256);
                trn[0] = nd; trn[1] = total; }
            LDS_WAIT(); __syncthreads();
            if (F.gw < 32) {
                const int p = F.gw >> 2, kv = (F.gw >> 1) & 1, j = (F.gw & 1) * 64 + F.lane;
                const gfl* pe = INP(I_CMP_PE) + ((size_t)l * 2 + kv) * 2048 + p * 256; const gfl* w1 = INP(I_CMP_W1) + (((size_t)l * 2 + kv) * 2048 + p * 256) * 128 + j;
                float a = 0.f;
#pragma unroll 8
                for (int k = 0; k < 256; ++k) a += pe[k] * w1[(size_t)k * 128];
                ((gfl*)(w_ + WS_PEB))[p * 256 + kv * 128 + j] = a;
            }
            tr_run(F, trn[0], trn[1]);
            __syncthreads();
            SEAM();
        }
        if (IN(3)) { PHASE_BEGIN();
            pg8::Sched<S_ / 256, ZN / 256, 1, false> S; S.init(F.G, b_);
            EpiZ E{w_};
            pg8::gemm_phase<DM, DM, DM, 0, 0>(F.lds, F.tid, H, (const gbf*)(w_ + WS_WIN), S, E);
            SEAM();
        }
        if (IN(4)) { PHASE_BEGIN();
#pragma unroll 1
            for (int it = F.gw; it < 2 * S_; it += F.NGW) pool_item((const gbf*)(w_ + WS_U), (gbf*)(w_ + WS_YP), it, F.lane);
            __syncthreads();
            pg8::Sched<16, 1, 2, false> S; S.init(F.G, b_);
            EpiF32 E{(gfl*)(w_ + WS_PQ), 256, (size_t)4096 * 256};
            pg8::gemm_phase<1024, 1024, 1024, (long)(WS_VCR - WS_KCR) / 2, (long)256 * 1024>(F.lds, F.tid, (const gbf*)(w_ + WS_KCR), (const gbf*)(w_ + WS_WC1), S, E);
            SEAM();
        }
        if (IN(5)) { PHASE_BEGIN();
            LAS float* hid = (LAS float*)(F.lds + F.wave * 1024);
#pragma unroll 1
            for (int it = F.gw; it < 8192; it += F.NGW) cmp_final_item((const gfl*)(w_ + WS_PQ), (const gfl*)(w_ + WS_PEB), INP(I_CMP_W2) + (size_t)l * 2 * 128 * 64, (gbf*)(w_ + WS_KC), (gbf*)(w_ + WS_VCT), hid, it, F.lane);
            __syncthreads();
            pg8::Sched<S_ / 256, 1, 4, false> S; S.init(F.G, b_);
            EpiBf16 E{(gbf*)(w_ + WS_P), POOLW, 256, 1.f};
            pg8::gemm_phase<POOLW, 256, 256, 256, 65536>(F.lds, F.tid, (const gbf*)(w_ + WS_YP), (const gbf*)(w_ + WS_WPOOL), S, E);
            SEAM();
        }
        if (IN(6)) { PHASE_BEGIN();
            attn_setup_tables(F, INP(I_RELB));
            const AttnPtrs P{(const gbf*)(w_ + WS_Q), (const gbf*)(w_ + WS_KC), (const gbf*)(w_ + WS_VCT), (const gbf*)(w_ + WS_KSEL), (const gbf*)(w_ + WS_VSELT), (const gbf*)(w_ + WS_KWIN), (const gbf*)(w_ + WS_VWINT),
                             (const gfl*)(w_ + WS_GL), (gbf*)(w_ + WS_A)};
#pragma unroll 1
            for (int it = F.gw; it < (S_ / 4) * NGRP; it += F.NGW) nsa_unit_v1(F, P, it >> 2, it & 3);
            __syncthreads();
            SEAM();
        }
        if (IN(7)) { PHASE_BEGIN();
            pg8::Sched<S_ / 256, DM / 256, 2, true> S; S.init(F.G, b_);
            EpiMerge E{(gbf*)(w_ + WS_Y1), (const gbf*)(w_ + WS_MG)};
            pg8::gemm_phase<NSAW, NSAW, NSAW, (long)(WS_P - WS_A) / 2, (long)(WS_WBRP - WS_WBRA) / 2>(F.lds, F.tid, (const gbf*)(w_ + WS_A), (const gbf*)(w_ + WS_WBRA), S, E);
            SEAM();
        }
        if (IN(8)) { PHASE_BEGIN();
            pg8::Sched<S_ / 256, DM / 256, 1, false> S; S.init(F.G, b_);
            EpiBf16 E{(gbf*)(w_ + WS_Y2), DM, 0, 1.f};
            pg8::gemm_phase<DM, DM, DM, 0, 0>(F.lds, F.tid, (const gbf*)(w_ + WS_Y1), (const gbf*)(w_ + WS_WMIX), S, E);
            SEAM();
        }
        if (IN(9)) { PHASE_BEGIN();
#pragma unroll 1
            for (int m = F.gw; m < S_; m += F.NGW) resid_row(X + (size_t)m * DM, X + (size_t)m * DM, (const gbf*)(w_ + WS_Y2) + (size_t)m * DM, INP(I_LN_MIX_POST) + (size_t)l * DM, INP(I_LN_X_PRE) + (size_t)l * DM, H + (size_t)m * DM, F.lane);
            SEAM();
        }
        if (IN(10)) { PHASE_BEGIN();
            pg8::Sched<S_ / 256, XW / 256, 1, false> S; S.init(F.G, b_);
            EpiBf16 E{(gbf*)(w_ + WS_Q2), XW, 0, 1.f};
            pg8::gemm_phase<DM, DM, DM, 0, 0>(F.lds, F.tid, H, (const gbf*)(w_ + WS_WXQ), S, E);
            SEAM();
        }
        if (IN(11)) { PHASE_BEGIN();
#pragma unroll 1
            for (int it = F.gw; it < (S_ / 16) * 4; it += F.NGW) xattn_unit_v1(F, (const gbf*)(w_ + WS_Q2), (const gbf*)(w_ + WS_KM) + (size_t)l * NMEM * XW, (const gbf*)(w_ + WS_VMT) + (size_t)l * XW * NMEM, (gbf*)(w_ + WS_O2), it >> 2, it & 3);
            SEAM();
        }
        if (IN(12)) { PHASE_BEGIN();
            pg8::Sched<S_ / 256, DM / 256, 1, false> S; S.init(F.G, b_);
            EpiBf16 E{(gbf*)(w_ + WS_Y2), DM, 0, 1.f};
            pg8::gemm_phase<XW, XW, XW, 0, 0>(F.lds, F.tid, (const gbf*)(w_ + WS_O2), (const gbf*)(w_ + WS_WXO), S, E);
            SEAM();
        }
        if (IN(13)) { PHASE_BEGIN();
#pragma unroll 1
            for (int m = F.gw; m < S_; m += F.NGW) resid_row(X + (size_t)m * DM, X + (size_t)m * DM, (const gbf*)(w_ + WS_Y2) + (size_t)m * DM, INP(I_LN_X_POST) + (size_t)l * DM, INP(I_LN_FFN_PRE) + (size_t)l * DM, H + (size_t)m * DM, F.lane);
            SEAM();
        }
        if (IN(14)) { PHASE_BEGIN();
            pg8::Sched<S_ / 256, 2 * DFF / 256, 1, false> S; S.init(F.G, b_);
            EpiSwiGLU E{(gbf*)(w_ + WS_HID)};
            pg8::gemm_phase<DM, DM, DM, 0, 0>(F.lds, F.tid, H, (const gbf*)(w_ + WS_WGU), S, E);
            SEAM();
        }
        if (IN(15)) { PHASE_BEGIN();
            pg8::Sched<S_ / 256, DM / 256, 1, false> S; S.init(F.G, b_);
            EpiBf16 E{(gbf*)(w_ + WS_Y2), DM, 0, 1.f};
            pg8::gemm_phase<DFF, DFF, DFF, 0, 0>(F.lds, F.tid, (const gbf*)(w_ + WS_HID), (const gbf*)(w_ + WS_WDN), S, E);
            SEAM();
        }
        if (IN(16)) { PHASE_BEGIN();
            const gfl* gpre = (l + 1 < NL) ? INP(I_LN_MIX_PRE) + (size_t)(l + 1) * DM : (const gfl*)nullptr;
#pragma unroll 1
            for (int m = F.gw; m < S_; m += F.NGW) resid_row(X + (size_t)m * DM, X + (size_t)m * DM, (const gbf*)(w_ + WS_Y2) + (size_t)m * DM, INP(I_LN_FFN_POST) + (size_t)l * DM, gpre, H + (size_t)m * DM, F.lane);
            if (l + 1 < launder_int(l_hi)) SEAM();
        }
    }

#ifdef MK_DEBUG_DUMP
    if (args.pad > 0) {
        const gbf* src = (const gbf*)(ws + (size_t)args.pad * MiB);
        for (size_t i = (size_t)blockIdx.x * 512 + threadIdx.x; i < (size_t)S_ * DM; i += (size_t)gridDim.x * 512) X[i] = bf2f(src[i]);
    }
#endif
#undef IN
#undef SEAM
}

#ifndef MK_PER_PHASE
#define MK_PER_PHASE 1
#endif
extern "C" void kernel_launch(void* const* d_in, const int* in_sizes, int n_in, void* d_out, int out_size, void* d_ws, size_t ws_size, hipStream_t stream) {
    static int grid = 0;
    if (grid == 0) {
        if (n_in != 25 || out_size != S_ * DM || ws_size < WS_END) { fprintf(stderr, "kernel_launch: unexpected shapes (n_in %d, out %d, ws %zu, need %zu)\n", n_in, out_size, ws_size, (size_t)WS_END); grid = -1; return; }
        int dev = 0, cus = 0, per_cu = 0;
        if (hipGetDevice(&dev) != hipSuccess || hipDeviceGetAttribute(&cus, hipDeviceAttributeMultiprocessorCount, dev) != hipSuccess) { grid = -1; return; }
        if (hipFuncSetAttribute((const void*)mega_fwd, hipFuncAttributeMaxDynamicSharedMemorySize, LDS_BYTES) != hipSuccess) { fprintf(stderr, "kernel_launch: hipFuncSetAttribute failed\n"); grid = -1; return; }
        if (hipOccupancyMaxActiveBlocksPerMultiprocessor(&per_cu, (const void*)mega_fwd, NWAVES * 64, LDS_BYTES) != hipSuccess || per_cu < 1) { fprintf(stderr, "kernel_launch: occupancy query says %d\n", per_cu); (void)hipGetLastError(); grid = -1; return; }
        grid = cus;
    }
    if (grid < 0) return;
#ifdef MK_DEBUG_DUMP
    (void)hipMemsetAsync((char*)d_ws, 0xAA, WS_END, stream);
    (void)hipMemsetAsync((char*)d_out, 0xAA, (size_t)out_size * 4, stream);
#endif
    (void)hipMemsetAsync((char*)d_ws + WS_CTL, 0, CTL_ZERO_BYTES, stream);
    Args a{};
    for (int i = 0; i < 25; ++i) a.in[i] = (const float*)d_in[i];
    a.out = (float*)d_out; a.ws = (unsigned char*)d_ws; a.pad = 0;
#ifdef MK_DEBUG_DUMP
    a.use_bar = 0;
    for (int ph = 0; ph < 2; ++ph) { a.l_lo = 0; a.l_hi = 1; a.ph_lo = ph; a.ph_hi = ph + 1; hipLaunchKernelGGL(mega_fwd, dim3(grid), dim3(NWAVES * 64), LDS_BYTES, stream, a); }
    for (int ph = 2; ph <= MK_DEBUG_LASTPH; ++ph) { if (ph == 6) continue; a.l_lo = 0; a.l_hi = 1; a.ph_lo = ph; a.ph_hi = ph + 1; hipLaunchKernelGGL(mega_fwd, dim3(grid), dim3(NWAVES * 64), LDS_BYTES, stream, a); }
    a.l_lo = 0; a.l_hi = 0; a.ph_lo = 30; a.ph_hi = 31; a.pad = MK_DEBUG_DUMP; hipLaunchKernelGGL(mega_fwd, dim3(grid), dim3(NWAVES * 64), LDS_BYTES, stream, a);
#elif MK_PER_PHASE
    a.use_bar = 0;
    for (int ph = 0; ph < 2; ++ph) { a.l_lo = 0; a.l_hi = 1; a.ph_lo = ph; a.ph_hi = ph + 1; hipLaunchKernelGGL(mega_fwd, dim3(grid), dim3(NWAVES * 64), LDS_BYTES, stream, a); }
    for (int l = 0; l < NL; ++l)
        for (int ph = 2; ph < NPHASE; ++ph) { a.l_lo = l; a.l_hi = l + 1; a.ph_lo = ph; a.ph_hi = ph + 1; hipLaunchKernelGGL(mega_fwd, dim3(grid), dim3(NWAVES * 64), LDS_BYTES, stream, a); }
#else
    a.use_bar = 1; a.l_lo = 0; a.l_hi = NL; a.ph_lo = 0; a.ph_hi = NPHASE;
    hipLaunchKernelGGL(mega_fwd, dim3(grid), dim3(NWAVES * 64), LDS_BYTES, stream, a);
#endif
}
```

```cpp
#include <hip/hip_runtime.h>
#include <cstdio>
#include <cstdint>
namespace pg8 {
#define PG8_LAS __attribute__((address_space(3)))
#define PG8_GAS __attribute__((address_space(1)))
typedef unsigned short bf16_t;
typedef short bf16x8 __attribute__((ext_vector_type(8)));
typedef float f32x4 __attribute__((ext_vector_type(4)));
typedef float f32x2 __attribute__((ext_vector_type(2)));
typedef unsigned u32x4 __attribute__((ext_vector_type(4)));
typedef unsigned u32x2 __attribute__((ext_vector_type(2)));
constexpr int BM = 256, BK = 64, HALF = 128, HTB = HALF * BK * 2  , STAGE_BYTES = 8 * HTB, NXCD = 8, WGM = 8;

__host__ __device__ __forceinline__ int lds_byte(int r, int c) { const int st = (r >> 4) * 2 + (c >> 5), rr = r & 15, cc = c & 31, ob = rr * 64 + cc * 2; return st * 1024 + (ob ^ (((ob >> 9) & 1) << 5)); }
__host__ __device__ __forceinline__ void stage_rc(int b, int& R, int& C) { const int st = b / 1024, sb = b % 1024, swz = sb ^ (((sb >> 9) & 1) << 5); R = (st >> 1) * 16 + swz / 64; C = (st & 1) * 32 + (swz % 64) / 2; }
__host__ __device__ __forceinline__ int perm32(int rho) { const int n = rho >> 4, i = rho & 15; return 8 * (i >> 2) + 4 * n + (i & 3); }

struct Unit { int pm, pn, sel; };


template <int NM, int NN, int NSEL, bool INNER>
struct Sched {
    int G, c;
    __device__ __forceinline__ void init(int G_, int c_) { G = G_; c = c_; }
    __device__ __forceinline__ bool next(int i, Unit& u) const {
        constexpr int nwg = NM * NN;
        long L; int sel;
        if (INNER) { L = (long)(i / NSEL) * G + c; sel = i % NSEL; if (L >= nwg) return false; }
        else { const long LL = (long)i * G + c; if (LL >= (long)nwg * NSEL) return false; sel = (int)(LL / nwg); L = LL % nwg; }
        int wgid = (int)L; { constexpr int q = nwg / NXCD, r = nwg % NXCD; const int xcd = wgid % NXCD, off = wgid / NXCD; wgid = (xcd < r ? xcd * (q + 1) : r * (q + 1) + (xcd - r) * q) + off; }
        constexpr int nig = WGM * NN; const int gid = wgid / nig, fm = gid * WGM, gsz = (NM - fm) < WGM ? (NM - fm) : WGM;
        u.pm = fm + ((wgid % nig) % gsz); u.pn = (wgid % nig) / gsz; u.sel = sel; return true;
    }
};

typedef __bf16 bf16x2_t __attribute__((ext_vector_type(2)));
__device__ __forceinline__ unsigned cvt_pk_bf16(float lo, float hi) { const f32x2 v = {lo, hi}; const bf16x2_t b = __builtin_convertvector(v, bf16x2_t); return __builtin_bit_cast(unsigned, b); }

template <int LDA, int LDB, int K, long ASEL, long BSEL, class Epi, class SchedT>
__device__ __forceinline__ void gemm_phase(PG8_LAS unsigned char* lds, int tid, const PG8_GAS bf16_t* gA, const PG8_GAS bf16_t* gBt, const SchedT& S, const Epi& E) {
    const int wid = __builtin_amdgcn_readfirstlane(tid >> 6), lane = tid & 63, wr = wid >> 2, wc = wid & 3, fr = lane & 15, fq = lane >> 4;
    constexpr int nt = K / BK;
    unsigned voffA[2], voffB[2];
#pragma unroll
    for (int i = 0; i < 2; ++i) { int R, C; stage_rc(tid * 16 + i * 8192, R, C); const int Rb = Epi::PERM ? ((R & ~31) + perm32(R & 31)) : R;
        voffA[i] = (unsigned)(R * LDA + C) * 2u; voffB[i] = (unsigned)(Rb * LDB + C) * 2u; }
    constexpr size_t kstep = (size_t)(BK * 2);
    constexpr size_t hstepA = (size_t)HALF * LDA * 2, hstepB = (size_t)HALF * LDB * 2;
    constexpr size_t tstepA = 2 * hstepA, tstepB = 2 * hstepB;
    const unsigned ldsw = (unsigned)wid * 1024u;
    const int aoff = lds_byte(wr * 64 + fr, fq * 8), boff = lds_byte(wc * 32 + fr, fq * 8);
#define PG8_SA(b, h) (((b) * 2 + (h)) * HTB)
#define PG8_SB(b, h) ((4 + (b) * 2 + (h)) * HTB)
#define PG8_STAGE(bufoff, gbase, voff) do { _Pragma("unroll") for (int _i = 0; _i < 2; ++_i) \
        __builtin_amdgcn_global_load_lds((const PG8_GAS unsigned*)((const PG8_GAS char*)(gbase) + (voff)[_i]), (PG8_LAS unsigned*)(lds + (bufoff) + ldsw + _i * 8192), 16, 0, 0); } while (0)
#define PG8_LDA(dst, b, h) do { _Pragma("unroll") for (int m = 0; m < 4; ++m) _Pragma("unroll") for (int k = 0; k < 2; ++k) dst[m][k] = *(const PG8_LAS bf16x8*)(lds + PG8_SA(b, h) + aoff + m * 2048 + k * 1024); } while (0)
#define PG8_LDB(dst, b, h) do { _Pragma("unroll") for (int n = 0; n < 2; ++n) _Pragma("unroll") for (int k = 0; k < 2; ++k) dst[n][k] = *(const PG8_LAS bf16x8*)(lds + PG8_SB(b, h) + boff + n * 2048 + k * 1024); } while (0)
#define PG8_MMA(ai, bj, At, Bt) do { __builtin_amdgcn_s_setprio(1); _Pragma("unroll") for (int m = 0; m < 4; ++m) _Pragma("unroll") for (int n = 0; n < 2; ++n) _Pragma("unroll") for (int k = 0; k < 2; ++k) \
        acc[ai][bj][m][n] = __builtin_amdgcn_mfma_f32_16x16x32_bf16(Bt[n][k], At[m][k], acc[ai][bj][m][n], 0, 0, 0); __builtin_amdgcn_s_setprio(0); } while (0)
#define PG8_WAIT_V(n) asm volatile("s_waitcnt vmcnt(" #n ")" ::: "memory")
#define PG8_WAIT_L(n) asm volatile("s_waitcnt lgkmcnt(" #n ")" ::: "memory")
#define PG8_BAR __builtin_amdgcn_s_barrier()
#define PG8_SCHED __builtin_amdgcn_sched_barrier(0)
    Unit cur, nxt; int ui = 0;
    if (!S.next(0, cur)) return;
    f32x4 acc[2][2][4][2];
#pragma unroll
    for (int a = 0; a < 2; ++a)
#pragma unroll
        for (int b = 0; b < 2; ++b)
#pragma unroll
            for (int m = 0; m < 4; ++m)
#pragma unroll
                for (int n = 0; n < 2; ++n) acc[a][b][m][n] = (f32x4){0.f, 0.f, 0.f, 0.f};
    bf16x8 At[4][2], B0[2][2], B1[2][2];
    const PG8_GAS char* cA = (const PG8_GAS char*)(gA + (size_t)cur.sel * ASEL) + (size_t)cur.pm * tstepA; const PG8_GAS char* cB = (const PG8_GAS char*)(gBt + (size_t)cur.sel * BSEL) + (size_t)cur.pn * tstepB;
    PG8_STAGE(PG8_SB(0, 0), cB, voffB); PG8_STAGE(PG8_SB(0, 1), cB + hstepB, voffB); PG8_STAGE(PG8_SA(0, 0), cA, voffA); PG8_STAGE(PG8_SA(0, 1), cA + hstepA, voffA);
    if (wr == 1) PG8_BAR;
    PG8_WAIT_V(2); PG8_BAR;
    PG8_STAGE(PG8_SB(1, 0), cB + kstep, voffB); PG8_STAGE(PG8_SA(1, 0), cA + kstep, voffA); PG8_STAGE(PG8_SB(1, 1), cB + hstepB + kstep, voffB);
    PG8_WAIT_V(6); PG8_BAR;
    for (;;) {
        const bool has_next = S.next(ui + 1, nxt);
        const PG8_GAS char* nA = has_next ? (const PG8_GAS char*)(gA + (size_t)nxt.sel * ASEL) + (size_t)nxt.pm * tstepA : cA; const PG8_GAS char* nB = has_next ? (const PG8_GAS char*)(gBt + (size_t)nxt.sel * BSEL) + (size_t)nxt.pn * tstepB : cB;
#pragma unroll 1
        for (int t = 0; t < nt; t += 2) {
            const bool last = (t == nt - 2);
            const PG8_GAS char* a1 = cA + (size_t)(t + 1) * kstep;
            const PG8_GAS char* a2 = last ? nA : cA + (size_t)(t + 2) * kstep; const PG8_GAS char* b2 = last ? nB : cB + (size_t)(t + 2) * kstep;
            const PG8_GAS char* a3 = a2 + kstep; const PG8_GAS char* b3 = b2 + kstep;
            PG8_LDB(B0, 0, 0); PG8_LDB(B1, 0, 1); PG8_SCHED; PG8_LDA(At, 0, 0); PG8_STAGE(PG8_SA(1, 1), a1 + hstepA, voffA);
            PG8_WAIT_V(8); PG8_WAIT_L(0); PG8_BAR; PG8_MMA(0, 0, At, B0); PG8_MMA(0, 1, At, B1); PG8_BAR; PG8_SCHED;
            PG8_LDA(At, 0, 1); PG8_STAGE(PG8_SB(0, 0), b2, voffB); PG8_STAGE(PG8_SB(0, 1), b2 + hstepB, voffB); PG8_STAGE(PG8_SA(0, 0), a2, voffA);
            PG8_WAIT_V(8); PG8_WAIT_L(0); PG8_BAR; PG8_MMA(1, 0, At, B0); PG8_MMA(1, 1, At, B1); PG8_BAR; PG8_SCHED;
            PG8_LDB(B0, 1, 0); PG8_LDB(B1, 1, 1); PG8_SCHED; PG8_LDA(At, 1, 0); PG8_STAGE(PG8_SA(0, 1), a2 + hstepA, voffA);
            PG8_WAIT_V(8); PG8_WAIT_L(0); PG8_BAR; PG8_MMA(0, 0, At, B0); PG8_MMA(0, 1, At, B1); PG8_BAR; PG8_SCHED;
            PG8_LDA(At, 1, 1); PG8_STAGE(PG8_SB(1, 0), b3, voffB); PG8_STAGE(PG8_SB(1, 1), b3 + hstepB, voffB); PG8_STAGE(PG8_SA(1, 0), a3, voffA);
            PG8_WAIT_V(8); PG8_WAIT_L(0); PG8_BAR; PG8_MMA(1, 0, At, B0); PG8_MMA(1, 1, At, B1); PG8_BAR; PG8_SCHED;
        }
        if (wr == 0) PG8_BAR;
        E(acc, cur, wr, wc, fr, fq);
        if (!has_next) break;
#pragma unroll
        for (int a = 0; a < 2; ++a)
#pragma unroll
            for (int b = 0; b < 2; ++b)
#pragma unroll
                for (int m = 0; m < 4; ++m)
#pragma unroll
                    for (int n = 0; n < 2; ++n) acc[a][b][m][n] = (f32x4){0.f, 0.f, 0.f, 0.f};
        cur = nxt; cA = nA; cB = nB; ++ui;
        if (wr == 1) PG8_BAR;
    }
    PG8_WAIT_V(0);
    PG8_BAR;
#undef PG8_SA
#undef PG8_SB
#undef PG8_STAGE
#undef PG8_LDA
#undef PG8_LDB
#undef PG8_MMA
#undef PG8_WAIT_V
#undef PG8_WAIT_L
#undef PG8_BAR
#undef PG8_SCHED
}
}
constexpr int S_ = 16384, DM = 2048, NL = 4, NMEM = 256;
constexpr int NSAW = 1024, KVW = 256, HD = 64, NHEAD = 16, NGRP = 4;
constexpr int POOLW = 1024, DFF = 5632, XW = 512, XHD = 128;
constexpr int INW = 7728, ZN = 7936;
constexpr int NCMP = 1023;
constexpr float RMS_EPS = 1e-6f;
constexpr float LOG2E = 1.4426950408889634f;
constexpr float QSCALE = 0.125f * LOG2E;
constexpr float XSCALE = 0.08838834764831845f * LOG2E;

typedef unsigned short bf16;
typedef short bf16x8 __attribute__((ext_vector_type(8)));
typedef float f32x4 __attribute__((ext_vector_type(4)));
typedef float f32x2 __attribute__((ext_vector_type(2)));
typedef unsigned u32x4 __attribute__((ext_vector_type(4)));
typedef unsigned u32x2 __attribute__((ext_vector_type(2)));
#define GAS __attribute__((address_space(1)))
#define LAS __attribute__((address_space(3)))
typedef GAS unsigned short gbf;
typedef GAS float gfl;
typedef GAS unsigned char gby;

__device__ __forceinline__ unsigned f2bf(float f) { unsigned u = __builtin_bit_cast(unsigned, f); return (u + 0x7fffu + ((u >> 16) & 1u)) >> 16; }
__device__ __forceinline__ unsigned pk2(float lo, float hi) { return pg8::cvt_pk_bf16(lo, hi); }
__device__ __forceinline__ float bf2f(unsigned short b) { return __builtin_bit_cast(float, (unsigned)b << 16); }
__device__ __forceinline__ float bflo(unsigned w) { return __builtin_bit_cast(float, w << 16); }
__device__ __forceinline__ float bfhi(unsigned w) { return __builtin_bit_cast(float, w & 0xffff0000u); }
__device__ __forceinline__ float sigmoidf_(float x) { return __builtin_amdgcn_rcpf(1.f + __builtin_amdgcn_exp2f(-x * LOG2E)); }

constexpr size_t MiB = 1u << 20;
constexpr size_t WS_CTL = 0, CTL_ZERO_BYTES = 1 * MiB;
constexpr size_t WS_WIN = 1 * MiB;
constexpr size_t WS_WBRA = WS_WIN + 31 * MiB;
constexpr size_t WS_WBRP = WS_WBRA + 4 * MiB;
constexpr size_t WS_WMIX = WS_WBRP + 4 * MiB;
constexpr size_t WS_WXQ = WS_WMIX + 8 * MiB;
constexpr size_t WS_WXO = WS_WXQ + 2 * MiB;
constexpr size_t WS_WGU = WS_WXO + 2 * MiB;
constexpr size_t WS_WDN = WS_WGU + 44 * MiB;
constexpr size_t WS_WC1 = WS_WDN + 22 * MiB;
constexpr size_t WS_WPOOL = WS_WC1 + 1 * MiB;
constexpr size_t WS_PEB = WS_WPOOL + MiB / 2;
constexpr size_t WS_ACT = WS_PEB + MiB / 2;
constexpr size_t WS_H = WS_ACT;
constexpr size_t WS_Q = WS_H + 64 * MiB;
constexpr size_t WS_KCR = WS_Q + 32 * MiB;
constexpr size_t WS_VCR = WS_KCR + 8 * MiB;
constexpr size_t WS_KSEL = WS_VCR + 8 * MiB;
constexpr size_t WS_VSELT = WS_KSEL + 8 * MiB;
constexpr size_t WS_KWIN = WS_VSELT + 8 * MiB;
constexpr size_t WS_VWINT = WS_KWIN + 8 * MiB;
constexpr size_t WS_GL = WS_VWINT + 8 * MiB;
constexpr size_t WS_PQ = WS_GL + 3 * MiB;
constexpr size_t WS_KC = WS_PQ + 8 * MiB;
constexpr size_t WS_VCT = WS_KC + MiB / 2;
constexpr size_t WS_KM = WS_VCT + MiB / 2;
constexpr size_t WS_VMT = WS_KM + 1 * MiB;
constexpr size_t WS_Y1 = WS_VMT + 1 * MiB;
constexpr size_t WS_Y2 = WS_Y1 + 64 * MiB;
constexpr size_t WS_Q2 = WS_Y2 + 64 * MiB;
constexpr size_t WS_O2 = WS_Q2 + 16 * MiB;
constexpr size_t WS_BIG = WS_O2 + 16 * MiB;
constexpr size_t WS_MG = WS_BIG;
constexpr size_t WS_U = WS_MG + 128 * MiB;
constexpr size_t WS_A = WS_U + 32 * MiB;
constexpr size_t WS_P = WS_A + 32 * MiB;
constexpr size_t WS_YP = WS_P + 32 * MiB;
constexpr size_t WS_HID = WS_BIG;
constexpr size_t WS_WXKV = WS_BIG;
constexpr size_t WS_MEMN = WS_BIG + 16 * MiB;
constexpr size_t WS_END = WS_BIG + 256 * MiB;
static_assert(WS_HID + (size_t)S_ * DFF * 2 <= WS_P, "HID overlays MG | U | A only");

constexpr int CW_BAR = 4096;

using pg8::Unit; using pg8::HALF; using pg8::BM;
typedef pg8::f32x4 acc_t[2][2][4][2];

struct EpiBf16 {
    static constexpr bool PERM = true;
    gbf* O; int ldc; int selcol; float scale;
    __device__ __forceinline__ void operator()(const acc_t& acc, const Unit& u, int wr, int wc, int fr, int fq) const {
        const int row0 = u.pm * BM + wr * 64 + fr; const int col0 = u.sel * selcol + u.pn * BM + wc * 32 + 8 * fq;
#pragma unroll
        for (int ai = 0; ai < 2; ++ai)
#pragma unroll
            for (int m = 0; m < 4; ++m) { gbf* rowp = O + (size_t)(row0 + ai * HALF + m * 16) * ldc + col0;
#pragma unroll
                for (int bj = 0; bj < 2; ++bj) { const f32x4 v0 = acc[ai][bj][m][0] * scale, v1 = acc[ai][bj][m][1] * scale;
                    u32x4 w; w.x = pk2(v0[0], v0[1]); w.y = pk2(v0[2], v0[3]); w.z = pk2(v1[0], v1[1]); w.w = pk2(v1[2], v1[3]);
                    *(GAS u32x4*)(rowp + bj * HALF) = w; } }
    }
};
struct EpiF32 {
    static constexpr bool PERM = false;
    gfl* O; int ldc; size_t selstride;
    __device__ __forceinline__ void operator()(const acc_t& acc, const Unit& u, int wr, int wc, int fr, int fq) const {
        const int row0 = u.pm * BM + wr * 64 + fr; const int col0 = u.pn * BM + wc * 32 + 4 * fq; gfl* base = O + (size_t)u.sel * selstride;
#pragma unroll
        for (int ai = 0; ai < 2; ++ai)
#pragma unroll
            for (int m = 0; m < 4; ++m) { gfl* rowp = base + (size_t)(row0 + ai * HALF + m * 16) * ldc + col0;
#pragma unroll
                for (int bj = 0; bj < 2; ++bj)
#pragma unroll
                    for (int n = 0; n < 2; ++n) *(GAS f32x4*)(rowp + bj * HALF + n * 16) = acc[ai][bj][m][n]; }
    }
};
struct EpiZ {
    static constexpr bool PERM = true;
    gby* ws;
    __device__ __forceinline__ void operator()(const acc_t& acc, const Unit& u, int wr, int wc, int fr, int fq) const {
        const int row0 = u.pm * BM + wr * 64 + fr; const int pn = u.pn;
        gbf* const Q = (gbf*)(ws + WS_Q); gbf* const U = (gbf*)(ws + WS_U); gbf* const MG = (gbf*)(ws + WS_MG); gfl* const GL = (gfl*)(ws + WS_GL);
        if (pn < 4 || (pn >= 10 && pn < 14)) {
            const bool isq = pn < 4; gbf* base = isq ? Q : U; const float sc = isq ? QSCALE : 1.f; const int col0 = (isq ? pn : pn - 10) * BM + wc * 32 + 8 * fq;
#pragma unroll
            for (int ai = 0; ai < 2; ++ai)
#pragma unroll
                for (int m = 0; m < 4; ++m) { gbf* rowp = base + (size_t)(row0 + ai * HALF + m * 16) * 1024 + col0;
#pragma unroll
                    for (int bj = 0; bj < 2; ++bj) { const f32x4 v0 = acc[ai][bj][m][0] * sc, v1 = acc[ai][bj][m][1] * sc;
                        u32x4 w; w.x = pk2(v0[0], v0[1]); w.y = pk2(v0[2], v0[3]); w.z = pk2(v1[0], v1[1]); w.w = pk2(v1[2], v1[3]);
                        *(GAS u32x4*)(rowp + bj * HALF) = w; } }
        } else if (pn == 4 || pn == 5 || pn == 6 || pn == 8) {
            gbf* base = (gbf*)(ws + (pn == 4 ? WS_KCR : pn == 5 ? WS_VCR : pn == 6 ? WS_KSEL : WS_KWIN));
            const int d0 = 32 * (wc & 1) + 8 * fq;
#pragma unroll
            for (int ai = 0; ai < 2; ++ai)
#pragma unroll
                for (int m = 0; m < 4; ++m) { const int row = row0 + ai * HALF + m * 16;
#pragma unroll
                    for (int bj = 0; bj < 2; ++bj) { const int g = 2 * bj + (wc >> 1); const f32x4 v0 = acc[ai][bj][m][0], v1 = acc[ai][bj][m][1];
                        u32x4 w; w.x = pk2(v0[0], v0[1]); w.y = pk2(v0[2], v0[3]); w.z = pk2(v1[0], v1[1]); w.w = pk2(v1[2], v1[3]);
                        *(GAS u32x4*)(base + ((size_t)g * S_ + row) * 64 + d0) = w; } }
        } else if (pn == 7 || pn == 9) {
            gbf* base = (gbf*)(ws + (pn == 7 ? WS_VSELT : WS_VWINT));
            const int d0 = 32 * (wc & 1) + 8 * fq;
#pragma unroll
            for (int ai = 0; ai < 2; ++ai)
#pragma unroll
                for (int m = 0; m < 4; ++m) { const int row = row0 + ai * HALF + m * 16;
#pragma unroll
                    for (int bj = 0; bj < 2; ++bj) { const int g = 2 * bj + (wc >> 1); gbf* p = base + ((size_t)g * 64 + d0) * S_ + row;
#pragma unroll
                        for (int n = 0; n < 2; ++n)
#pragma unroll
                            for (int e = 0; e < 4; ++e) p[(size_t)(4 * n + e) * S_] = (bf16)f2bf(acc[ai][bj][m][n][e]); } }
        } else if (pn < 30) {
            const int col0 = (pn - 14) * BM + wc * 32 + 8 * fq;
#pragma unroll
            for (int ai = 0; ai < 2; ++ai)
#pragma unroll
                for (int m = 0; m < 4; ++m) { gbf* rowp = MG + (size_t)(row0 + ai * HALF + m * 16) * 4096 + col0;
#pragma unroll
                    for (int bj = 0; bj < 2; ++bj) { const f32x4 a0 = acc[ai][bj][m][0], a1 = acc[ai][bj][m][1];
                        u32x4 w; w.x = pk2(sigmoidf_(a0[0]), sigmoidf_(a0[1])); w.y = pk2(sigmoidf_(a0[2]), sigmoidf_(a0[3])); w.z = pk2(sigmoidf_(a1[0]), sigmoidf_(a1[1])); w.w = pk2(sigmoidf_(a1[2]), sigmoidf_(a1[3]));
                        *(GAS u32x4*)(rowp + bj * HALF) = w; } }
        } else {
            const int col0 = wc * 32 + 8 * fq;
            if (col0 < 48) {
#pragma unroll
                for (int ai = 0; ai < 2; ++ai)
#pragma unroll
                    for (int m = 0; m < 4; ++m) { gfl* rowp = GL + (size_t)(row0 + ai * HALF + m * 16) * 48 + col0;
                        const f32x4 a0 = acc[ai][0][m][0], a1 = acc[ai][0][m][1];
                        *(GAS f32x4*)rowp = (f32x4){sigmoidf_(a0[0]), sigmoidf_(a0[1]), sigmoidf_(a0[2]), sigmoidf_(a0[3])};
                        *(GAS f32x4*)(rowp + 4) = (f32x4){sigmoidf_(a1[0]), sigmoidf_(a1[1]), sigmoidf_(a1[2]), sigmoidf_(a1[3])}; }
            }
        }
    }
};
struct EpiMerge {
    static constexpr bool PERM = true;
    gbf* Y1; const gbf* MG;
    __device__ __forceinline__ void operator()(const acc_t& acc, const Unit& u, int wr, int wc, int fr, int fq) const {
        const int row0 = u.pm * BM + wr * 64 + fr; const int col0 = u.pn * BM + wc * 32 + 8 * fq;
#pragma unroll
        for (int ai = 0; ai < 2; ++ai)
#pragma unroll
            for (int m = 0; m < 4; ++m) { const int row = row0 + ai * HALF + m * 16; gbf* yp = Y1 + (size_t)row * DM + col0; const gbf* gp = MG + (size_t)row * 4096 + u.sel * 2048 + col0;
#pragma unroll
                for (int bj = 0; bj < 2; ++bj) { const u32x4 gw = *(const GAS u32x4*)(gp + bj * HALF); const f32x4 a0 = acc[ai][bj][m][0], a1 = acc[ai][bj][m][1];
                    float v[8] = {a0[0] * bflo(gw.x), a0[1] * bfhi(gw.x), a0[2] * bflo(gw.y), a0[3] * bfhi(gw.y), a1[0] * bflo(gw.z), a1[1] * bfhi(gw.z), a1[2] * bflo(gw.w), a1[3] * bfhi(gw.w)};
                    if (u.sel) { const u32x4 yw = *(const GAS u32x4*)(yp + bj * HALF);
                        v[0] += bflo(yw.x); v[1] += bfhi(yw.x); v[2] += bflo(yw.y); v[3] += bfhi(yw.y); v[4] += bflo(yw.z); v[5] += bfhi(yw.z); v[6] += bflo(yw.w); v[7] += bfhi(yw.w); }
                    u32x4 w; w.x = pk2(v[0], v[1]); w.y = pk2(v[2], v[3]); w.z = pk2(v[4], v[5]); w.w = pk2(v[6], v[7]);
                    *(GAS u32x4*)(yp + bj * HALF) = w; } }
    }
};
struct EpiSwiGLU {
    static constexpr bool PERM = true;
    gbf* Hd;
    __device__ __forceinline__ void operator()(const acc_t& acc, const Unit& u, int wr, int wc, int fr, int fq) const {
        const int row0 = u.pm * BM + wr * 64 + fr; const int col0 = u.pn * 128 + wc * 32 + 8 * fq;
#pragma unroll
        for (int ai = 0; ai < 2; ++ai)
#pragma unroll
            for (int m = 0; m < 4; ++m) { gbf* rowp = Hd + (size_t)(row0 + ai * HALF + m * 16) * DFF + col0; float v[8];
#pragma unroll
                for (int n = 0; n < 2; ++n)
#pragma unroll
                    for (int e = 0; e < 4; ++e) { const float gx = acc[ai][0][m][n][e], ux = acc[ai][1][m][n][e]; v[4 * n + e] = gx * sigmoidf_(gx) * ux; }
                u32x4 w; w.x = pk2(v[0], v[1]); w.y = pk2(v[2], v[3]); w.z = pk2(v[4], v[5]); w.w = pk2(v[6], v[7]);
                *(GAS u32x4*)rowp = w; }
    }
};
struct EpiKVmem {
    static constexpr bool PERM = true;
    gbf *KM, *VMT;
    __device__ __forceinline__ void operator()(const acc_t& acc, const Unit& u, int wr, int wc, int fr, int fq) const {
        const int row0 = wr * 64 + fr; const int l = u.sel;
        if (u.pn < 2) {
            const int col0 = u.pn * BM + wc * 32 + 8 * fq;
#pragma unroll
            for (int ai = 0; ai < 2; ++ai)
#pragma unroll
                for (int m = 0; m < 4; ++m) { gbf* rowp = KM + ((size_t)l * NMEM + row0 + ai * HALF + m * 16) * XW + col0;
#pragma unroll
                    for (int bj = 0; bj < 2; ++bj) { const f32x4 v0 = acc[ai][bj][m][0] * XSCALE, v1 = acc[ai][bj][m][1] * XSCALE;
                        u32x4 w; w.x = pk2(v0[0], v0[1]); w.y = pk2(v0[2], v0[3]); w.z = pk2(v1[0], v1[1]); w.w = pk2(v1[2], v1[3]);
                        *(GAS u32x4*)(rowp + bj * HALF) = w; } }
        } else {
            const int col0 = (u.pn - 2) * BM + wc * 32 + 8 * fq;
#pragma unroll
            for (int ai = 0; ai < 2; ++ai)
#pragma unroll
                for (int m = 0; m < 4; ++m) { const int row = row0 + ai * HALF + m * 16;
#pragma unroll
                    for (int bj = 0; bj < 2; ++bj) { gbf* p = VMT + ((size_t)l * XW + col0 + bj * HALF) * NMEM + row;
#pragma unroll
                        for (int n = 0; n < 2; ++n)
#pragma unroll
                            for (int e = 0; e < 4; ++e) p[(size_t)(4 * n + e) * NMEM] = (bf16)f2bf(acc[ai][bj][m][n][e]); } }
        }
    }
};
constexpr int RING_BYTES = 131072;
constexpr int LDSCTL_OFF = RING_BYTES, MISC_OFF = LDSCTL_OFF + 320;
constexpr int LDS_BYTES = 147456;
constexpr int NWAVES = 8;

typedef GAS unsigned gu32;
#define RLX_AGENT __ATOMIC_RELAXED, __HIP_MEMORY_SCOPE_AGENT
#define LDS_WAIT() asm volatile("s_waitcnt lgkmcnt(0)" ::: "memory")
#define VM_WAIT() asm volatile("s_waitcnt vmcnt(0)" ::: "memory")

#define XB_TMO      128
#define XB_XCNT(j)  (256  + 64 * (j))
#define XB_XSUB(j)  (1280 + 64 * (j))
#define XB_XGEN(j)  (2304 + 64 * (j))
#define XB_TOP      3328
#define XB_TOPGEN   3392
#define XCD_BAR_WORDS 3456
#define XB_SPIN_CAP (1u << 22)

__device__ __forceinline__ unsigned xb_ld(GAS unsigned* p)              { return __hip_atomic_load(p, __ATOMIC_RELAXED, __HIP_MEMORY_SCOPE_AGENT); }
__device__ __forceinline__ unsigned xb_add(GAS unsigned* p, unsigned v) { return __hip_atomic_fetch_add(p, v, __ATOMIC_RELAXED, __HIP_MEMORY_SCOPE_AGENT); }
__device__ __forceinline__ unsigned xb_xcc_id() { return (unsigned)__builtin_amdgcn_s_getreg((3 << 11) | 20) & 0xFu; }
#define XB_SPIN(cond, bar) do { unsigned _sp = 0; while (cond) { __builtin_amdgcn_s_sleep(1); \
    if ((++_sp & 255u) == 0u) { if (xb_ld(&(bar)[XB_TMO])) break; if (_sp > XB_SPIN_CAP) { (void)xb_add(&(bar)[XB_TMO], 1u); break; } } } } while (0)

struct XcdBarrier { GAS unsigned* bar; unsigned x; volatile LAS unsigned* st; };

__device__ __forceinline__ XcdBarrier xcd_barrier_post(GAS unsigned* bar, volatile LAS unsigned* st) {
    XcdBarrier b; b.bar = bar; b.x = xb_xcc_id(); b.st = st;
    if (threadIdx.x == 0) (void)xb_add(&bar[XB_XCNT(b.x)], 1u);
    return b;
}
__device__ __forceinline__ void xcd_barrier_complete(GAS unsigned* bar, unsigned x, unsigned& nloc, unsigned& nx) {
    const unsigned G = gridDim.x * gridDim.y * gridDim.z;
    unsigned sum, cnt, mine, sp = 0u;
    for (;;) {
        sum = 0u; cnt = 0u; mine = 0u;
#pragma unroll 1
        for (unsigned j = 0; j < 16; ++j) { const unsigned c = xb_ld(&bar[XB_XCNT(j)]); sum += c; cnt += (c > 0u) ? 1u : 0u; mine = (j == x) ? c : mine; }
        if (sum == G) break;
        __builtin_amdgcn_s_sleep(1);
        if ((++sp & 255u) == 0u) { if (xb_ld(&bar[XB_TMO])) break; if (sp > XB_SPIN_CAP) { (void)xb_add(&bar[XB_TMO], 1u); break; } }
    }
    nloc = mine > 0u ? mine : 1u; nx = cnt > 0u ? cnt : 1u;
}
__device__ __forceinline__ void xcd_barrier(const XcdBarrier& b) {
    asm volatile("s_waitcnt vmcnt(0)" ::: "memory");
    __syncthreads();
    if (threadIdx.x == 0) {
        GAS unsigned* bar = b.bar; unsigned bx = b.x;
        asm volatile("" : "+s"(bar), "+s"(bx));
        __builtin_amdgcn_s_waitcnt(0);
        unsigned nloc = b.st[0], nx = b.st[1];
        if (nloc == 0u) { xcd_barrier_complete(bar, bx, nloc, nx); b.st[0] = nloc; b.st[1] = nx; }
        const unsigned old = xb_add(&bar[XB_XSUB(bx)], 1u);
        const unsigned gen = old / nloc;
        if (old + 1u == (gen + 1u) * nloc) {
            __builtin_amdgcn_fence(__ATOMIC_RELEASE, "agent");
            asm volatile("s_waitcnt vmcnt(0)" ::: "memory");
            const unsigned og = xb_add(&bar[XB_TOP], 1u);
            const unsigned tg = og / nx;
            if (og + 1u == (tg + 1u) * nx) xb_add(&bar[XB_TOPGEN], 1u);
            else XB_SPIN(xb_ld(&bar[XB_TOPGEN]) == tg, bar);
            __builtin_amdgcn_fence(__ATOMIC_ACQUIRE, "agent");
            xb_add(&bar[XB_XGEN(bx)], 1u);
            asm volatile("s_waitcnt vmcnt(0)" ::: "memory");
        } else {
            XB_SPIN(xb_ld(&bar[XB_XGEN(bx)]) == gen, bar);
            __builtin_amdgcn_fence(__ATOMIC_ACQUIRE, "agent");
            asm volatile("s_waitcnt vmcnt(0)" ::: "memory");
        }
    }
    __syncthreads();
}

struct Frame {
    LAS unsigned char* lds;
    int tid, lane, wave, vcu, G, gw, NGW;
    gby* ws;
};

__device__ __forceinline__ float wave_sum(float v) {
#pragma unroll
    for (int o = 1; o < 64; o <<= 1) v += __shfl_xor(v, o);
    return v;
}

__device__ __forceinline__ int tr_map(int code, int moff, int n) {
    if (code == 0) return n + moff;
    if (code == 1) return n < 2560 ? n : (n < 2608 ? 7680 + (n - 2560) : (n < 3632 ? 2560 + (n - 2608) : 3584 + (n - 3632)));
    return (n >> 7) * 256 + moff + (n & 127);
}
struct TrDesc { const gfl* W; gbf* WT; const gfl* cs; int K, N, ldk, code, moff, start; };
__device__ __forceinline__ void tr_item(const gfl* W, int N, gbf* WT, int ldk, LAS float* scr, int item, int lane, int code, int moff, const gfl* colscale) {
    const int nblk = (N + 31) / 32, kb = item / nblk, nb = item % nblk, k0 = 64 * kb, n0 = 32 * nb;
    const int nl = n0 + (lane & 31); const bool nok = nl < N; const float cs = (colscale && nok) ? colscale[nl] : 1.f;
#pragma unroll 8
    for (int i = 0; i < 32; ++i) { const int kk = 2 * i + (lane >> 5); scr[kk * 33 + (lane & 31)] = nok ? W[(size_t)(k0 + kk) * N + nl] * cs : 0.f; }
    LDS_WAIT(); asm volatile("" ::: "memory");
    const int c = lane & 7;
#pragma unroll
    for (int j = 0; j < 4; ++j) { const int n = (lane >> 3) + 8 * j; const LAS float* s = scr + (8 * c) * 33 + n;
        u32x4 o; o.x = pk2(s[0 * 33], s[1 * 33]); o.y = pk2(s[2 * 33], s[3 * 33]); o.z = pk2(s[4 * 33], s[5 * 33]); o.w = pk2(s[6 * 33], s[7 * 33]);
        if (n0 + n < N) *(GAS u32x4*)(WT + (size_t)tr_map(code, moff, n0 + n) * ldk + k0 + 8 * c) = o; }
    LDS_WAIT(); asm volatile("" ::: "memory");
}

__device__ __forceinline__ void rms_row_to_bf16(const gfl* xrow, const gfl* gain, gbf* orow, int lane) {
    f32x4 v[4][2]; float ss = 0.f;
#pragma unroll
    for (int j = 0; j < 4; ++j) { const int c = lane + 64 * j; v[j][0] = *(const GAS f32x4*)(xrow + 8 * c); v[j][1] = *(const GAS f32x4*)(xrow + 8 * c + 4);
        ss += (v[j][0].x * v[j][0].x + v[j][0].y * v[j][0].y) + (v[j][0].z * v[j][0].z + v[j][0].w * v[j][0].w) + (v[j][1].x * v[j][1].x + v[j][1].y * v[j][1].y) + (v[j][1].z * v[j][1].z + v[j][1].w * v[j][1].w); }
    const float r = 1.0f / sqrtf(wave_sum(ss) * (1.f / DM) + RMS_EPS);
#pragma unroll
    for (int j = 0; j < 4; ++j) { const int c = lane + 64 * j; const f32x4 g0 = *(const GAS f32x4*)(gain + 8 * c), g1 = *(const GAS f32x4*)(gain + 8 * c + 4);
        const f32x4 a = v[j][0] * r * g0, b = v[j][1] * r * g1;
        u32x4 w; w.x = pk2(a.x, a.y); w.y = pk2(a.z, a.w); w.z = pk2(b.x, b.y); w.w = pk2(b.z, b.w);
        *(GAS u32x4*)(orow + 8 * c) = w; }
}
__device__ __forceinline__ void resid_row(const gfl* xin, gfl* xout, const gbf* yrow, const gfl* gpost, const gfl* gpre, gbf* hrow, int lane) {
    f32x4 y[4][2]; float ss = 0.f;
#pragma unroll
    for (int j = 0; j < 4; ++j) { const int c = lane + 64 * j; const u32x4 w = *(const GAS u32x4*)(yrow + 8 * c);
        y[j][0] = (f32x4){bflo(w.x), bfhi(w.x), bflo(w.y), bfhi(w.y)}; y[j][1] = (f32x4){bflo(w.z), bfhi(w.z), bflo(w.w), bfhi(w.w)};
        ss += (y[j][0].x * y[j][0].x + y[j][0].y * y[j][0].y) + (y[j][0].z * y[j][0].z + y[j][0].w * y[j][0].w) + (y[j][1].x * y[j][1].x + y[j][1].y * y[j][1].y) + (y[j][1].z * y[j][1].z + y[j][1].w * y[j][1].w); }
    const float r = 1.0f / sqrtf(wave_sum(ss) * (1.f / DM) + RMS_EPS);
    float s2 = 0.f;
#pragma unroll
    for (int j = 0; j < 4; ++j) { const int c = lane + 64 * j; const f32x4 g0 = *(const GAS f32x4*)(gpost + 8 * c), g1 = *(const GAS f32x4*)(gpost + 8 * c + 4);
        const f32x4 x0 = *(const GAS f32x4*)(xin + 8 * c), x1 = *(const GAS f32x4*)(xin + 8 * c + 4);
        y[j][0] = x0 + y[j][0] * r * g0; y[j][1] = x1 + y[j][1] * r * g1;
        *(GAS f32x4*)(xout + 8 * c) = y[j][0]; *(GAS f32x4*)(xout + 8 * c + 4) = y[j][1];
        s2 += (y[j][0].x * y[j][0].x + y[j][0].y * y[j][0].y) + (y[j][0].z * y[j][0].z + y[j][0].w * y[j][0].w) + (y[j][1].x * y[j][1].x + y[j][1].y * y[j][1].y) + (y[j][1].z * y[j][1].z + y[j][1].w * y[j][1].w); }
    if (gpre) {
        const float r2 = 1.0f / sqrtf(wave_sum(s2) * (1.f / DM) + RMS_EPS);
#pragma unroll
        for (int j = 0; j < 4; ++j) { const int c = lane + 64 * j; const f32x4 g0 = *(const GAS f32x4*)(gpre + 8 * c), g1 = *(const GAS f32x4*)(gpre + 8 * c + 4);
            const f32x4 a = y[j][0] * r2 * g0, b = y[j][1] * r2 * g1;
            u32x4 w; w.x = pk2(a.x, a.y); w.y = pk2(a.z, a.w); w.z = pk2(b.x, b.y); w.w = pk2(b.z, b.w);
            *(GAS u32x4*)(hrow + 8 * c) = w; }
    }
}
__device__ __forceinline__ float gelu_tanh(float x) {
    const float z = 0.7978845608028654f * (x + 0.044715f * x * x * x);
    const float e = __builtin_amdgcn_exp2f(2.f * z * LOG2E);
    const float th = 1.f - 2.f * __builtin_amdgcn_rcpf(1.f + e);
    return 0.5f * x * (1.f + th);
}
constexpr float NEGBIG = -1e30f;
constexpr int ATT_BKT_OFF = 0;
constexpr int ATT_TAB_OFF = 2048;
constexpr int ATT_WAVE_OFF = 4096;
constexpr int ATT_IMP_STRIDE = 264;
constexpr int ATT_WAVE_BYTES = 2 * 4 * ATT_IMP_STRIDE * 4 + 128;
static_assert(ATT_WAVE_OFF + NWAVES * ATT_WAVE_BYTES <= RING_BYTES, "attention LDS");

__device__ __forceinline__ int t5_bucket(int n) {
    if (n < 16) return n;
    int b = 16;
    b += (n >= 22); b += (n >= 30); b += (n >= 40); b += (n >= 54); b += (n >= 73); b += (n >= 99); b += (n >= 134); b += (n >= 182);
    b += (n >= 246); b += (n >= 332); b += (n >= 450); b += (n >= 609); b += (n >= 825); b += (n >= 1117); b += (n >= 1513);
    return b;
}
struct AttSt { f32x4 o[4]; float m, l; };
__device__ __forceinline__ void att_reset(AttSt& st) {
#pragma unroll
    for (int i = 0; i < 4; ++i) st.o[i] = (f32x4){0.f, 0.f, 0.f, 0.f};
    st.m = NEGBIG; st.l = 0.f;
}
template <int MODE>
__device__ __forceinline__ void att_scores(float (&sv)[8], const bf16x8 (&qf)[2], const gbf* Kg, int kb, int t, int head, bool rowsel, int lane, const LAS unsigned char* bkt, const LAS float* tab) {
    const int i16 = lane & 15, gq = lane >> 4;
    f32x4 s[2];
#pragma unroll
    for (int tau = 0; tau < 2; ++tau) {
        const int ko = 8 * (i16 >> 2) + 4 * tau + (i16 & 3);
        const gbf* kp = Kg + (size_t)(kb + ko) * 64 + 8 * gq;
        const bf16x8 k0 = *(const GAS bf16x8*)kp, k1 = *(const GAS bf16x8*)(kp + 32);
        s[tau] = __builtin_amdgcn_mfma_f32_16x16x32_bf16(k0, qf[0], (f32x4){0.f, 0.f, 0.f, 0.f}, 0, 0, 0);
        s[tau] = __builtin_amdgcn_mfma_f32_16x16x32_bf16(k1, qf[1], s[tau], 0, 0, 0);
    }
#pragma unroll
    for (int tau = 0; tau < 2; ++tau)
#pragma unroll
        for (int r = 0; r < 4; ++r) {
            const int idx = kb + 8 * gq + 4 * tau + r;
            int dist; bool valid;
            if (MODE == 0) { dist = t - (16 * idx + 31); valid = dist >= 0; }
            else if (MODE == 1) { dist = t - idx; valid = rowsel && dist >= 0; }
            else { dist = t - idx; valid = (unsigned)dist < 512u; }
            const int dc = dist < 0 ? 0 : (dist > 2047 ? 2047 : dist);
            const float b = tab[head * 32 + bkt[dc]];
            sv[4 * tau + r] = valid ? s[tau][r] + b : NEGBIG;
        }
}
template <int MODE>
__device__ __forceinline__ void att_step(AttSt& st, const bf16x8 (&qf)[2], const gbf* Kg, const gbf* VTg, int vpitch, int kb, int t, int head, bool rowsel, int lane, const LAS unsigned char* bkt, const LAS float* tab) {
    const int i16 = lane & 15, gq = lane >> 4;
    float sv[8];
    att_scores<MODE>(sv, qf, Kg, kb, t, head, rowsel, lane, bkt, tab);
    float mx = fmaxf(fmaxf(fmaxf(sv[0], sv[1]), fmaxf(sv[2], sv[3])), fmaxf(fmaxf(sv[4], sv[5]), fmaxf(sv[6], sv[7])));
    mx = fmaxf(mx, __shfl_xor(mx, 16)); mx = fmaxf(mx, __shfl_xor(mx, 32));
    const float mn = fmaxf(st.m, mx);
    const float alpha = __builtin_amdgcn_exp2f(st.m - mn);
    st.m = mn;
    float p[8]; float ps = 0.f;
#pragma unroll
    for (int e = 0; e < 8; ++e) { p[e] = __builtin_amdgcn_exp2f(sv[e] - mn); ps += p[e]; }
    st.l = st.l * alpha + ps;
    u32x4 pw; pw.x = pk2(p[0], p[1]); pw.y = pk2(p[2], p[3]); pw.z = pk2(p[4], p[5]); pw.w = pk2(p[6], p[7]);
    const bf16x8 pb = __builtin_bit_cast(bf16x8, pw);
#pragma unroll
    for (int dt = 0; dt < 4; ++dt) {
        const bf16x8 vf = *(const GAS bf16x8*)(VTg + (size_t)(16 * dt + i16) * vpitch + kb + 8 * gq);
        st.o[dt] = st.o[dt] * alpha;
        st.o[dt] = __builtin_amdgcn_mfma_f32_16x16x32_bf16(vf, pb, st.o[dt], 0, 0, 0);
    }
}
__device__ __forceinline__ void att_finish(const AttSt& st, f32x4 (&acc)[4], float gate) {
    float l = st.l; l += __shfl_xor(l, 16); l += __shfl_xor(l, 32);
    const float sc = (st.m > -1e29f) ? gate / l : 0.f;
#pragma unroll
    for (int dt = 0; dt < 4; ++dt) acc[dt] += st.o[dt] * sc;
}
__device__ __forceinline__ unsigned wave_max_u32(unsigned v) {
#pragma unroll
    for (int o = 1; o < 64; o <<= 1) { const unsigned w = (unsigned)__shfl_xor((int)v, o); v = v > w ? v : w; }
    return v;
}

struct AttnPtrs { const gbf *Q, *KC, *VCT, *KSEL, *VSELT, *KWIN, *VWINT; const gfl* GL; gbf* A; };

__device__ __forceinline__ void attn_setup_tables(Frame& F, const gfl* rel_bias) {
    LAS unsigned char* bkt = F.lds + ATT_BKT_OFF; LAS float* tab = (LAS float*)(F.lds + ATT_TAB_OFF);
    for (int i = F.tid; i < 2048; i += NWAVES * 64) bkt[i] = (unsigned char)t5_bucket(i);
    for (int i = F.tid; i < 512; i += NWAVES * 64) tab[i] = rel_bias[i] * LOG2E;
    LDS_WAIT(); __syncthreads();
}

__device__ __forceinline__ void nsa_unit_v1(Frame& F, const AttnPtrs& P, int qt, int g) {
    const int lane = F.lane, i16 = lane & 15, gq = lane >> 4, ql = i16 >> 2, hl = i16 & 3;
    const LAS unsigned char* bkt = F.lds + ATT_BKT_OFF; const LAS float* tab = (const LAS float*)(F.lds + ATT_TAB_OFF);
    LAS float* impA = (LAS float*)(F.lds + ATT_WAVE_OFF + F.wave * ATT_WAVE_BYTES); LAS float* impB = impA + 4 * ATT_IMP_STRIDE;
    LAS unsigned* selm = (LAS unsigned*)(impB + 4 * ATT_IMP_STRIDE);
    const int t0 = 4 * qt, t = t0 + ql, head = 4 * g + hl;
    bf16x8 qf[2];
    { const gbf* qp = P.Q + (size_t)t * NSAW + head * 64 + 8 * gq; qf[0] = *(const GAS bf16x8*)qp; qf[1] = *(const GAS bf16x8*)(qp + 32); }
    const float g_c = P.GL[(size_t)t * 48 + head * 3 + 0], g_s = P.GL[(size_t)t * 48 + head * 3 + 1], g_w = P.GL[(size_t)t * 48 + head * 3 + 2];
    f32x4 acc[4];
#pragma unroll
    for (int i = 0; i < 4; ++i) acc[i] = (f32x4){0.f, 0.f, 0.f, 0.f};
    AttSt st;
    const gbf* KCg = P.KC + (size_t)g * 1024 * 64; const gbf* VCTg = P.VCT + (size_t)g * 64 * 1024;
    const int nlast = (t0 + 3 >= 31) ? (t0 + 3 - 31) / 16 : -1;
    att_reset(st);
    for (int kb = 0; kb <= nlast; kb += 32) att_step<0>(st, qf, KCg, VCTg, 1024, kb, t, head, true, lane, bkt, tab);
    att_finish(st, acc, g_c);
    const int cur_max = (t0 + 3) >> 6;
    if (cur_max >= 16) {
        float lt = st.l; lt += __shfl_xor(lt, 16); lt += __shfl_xor(lt, 32);
        const float inv_l = (st.m > -1e29f) ? 1.f / lt : 0.f; const float mfin = st.m;
        for (int kb = 0; kb <= nlast; kb += 32) {
            float sv[8];
            att_scores<0>(sv, qf, KCg, kb, t, head, true, lane, bkt, tab);
            float ps[8];
#pragma unroll
            for (int e = 0; e < 8; ++e) { float p = (sv[e] > -1e29f) ? __builtin_amdgcn_exp2f(sv[e] - mfin) * inv_l : 0.f; p += __shfl_xor(p, 1); p += __shfl_xor(p, 2); ps[e] = p; }
            const float a0 = ps[0] + ps[1] + ps[2] + 0.5f * ps[3], c0 = 0.5f * ps[3];
            const float a1 = ps[4] + ps[5] + ps[6] + 0.5f * ps[7] + c0, c1 = 0.5f * ps[7];
            const int j0 = (kb + 8 * gq) >> 2;
            if (hl == 0) { impA[ql * ATT_IMP_STRIDE + j0] = a0; impA[ql * ATT_IMP_STRIDE + j0 + 1] = a1; impB[ql * ATT_IMP_STRIDE + j0 + 2] = c1; }
        }
    }
    LDS_WAIT();
#pragma unroll 1
    for (int q = 0; q < 4; ++q) {
        const int tq = t0 + q, cur = tq >> 6;
        unsigned mword = 0u;
        if (cur <= 15) { if (lane == 0) mword = (2u << cur) - 1u; }
        else {
            unsigned key[4];
#pragma unroll
            for (int e = 0; e < 4; ++e) { const int j = 4 * lane + e; float v = impA[q * ATT_IMP_STRIDE + j]; if ((j & 1) == 0 && j > 0) v += impB[q * ATT_IMP_STRIDE + j];
                const bool cand = (j >= 1) && (j <= cur - 2);
                key[e] = cand ? ((__builtin_bit_cast(unsigned, v) & 0xffffff00u) | (unsigned)(255 - j)) : 0u; }
#pragma unroll 1
            for (int round = 0; round < 13; ++round) {
                unsigned best = key[0] > key[1] ? key[0] : key[1]; const unsigned b2 = key[2] > key[3] ? key[2] : key[3]; best = best > b2 ? best : b2;
                const unsigned wk = (unsigned)__builtin_amdgcn_readfirstlane((int)wave_max_u32(best));
                const int js = 255 - (int)(wk & 255u);
                if (lane == (js >> 2)) {
#pragma unroll
                    for (int e = 0; e < 4; ++e) if ((js & 3) == e) key[e] = 0u;
                }
                if (lane == (js >> 5)) mword |= 1u << (js & 31);
            }
            if (lane == 0) mword |= 1u;
            if (lane == (cur >> 5)) mword |= 1u << (cur & 31);
            if (lane == ((cur - 1) >> 5)) mword |= 1u << ((cur - 1) & 31);
        }
        if (lane < 8) selm[q * 8 + lane] = mword;
    }
    LDS_WAIT();
    const gbf* KSg = P.KSEL + (size_t)g * S_ * 64; const gbf* VSTg = P.VSELT + (size_t)g * 64 * S_;
    att_reset(st);
#pragma unroll 1
    for (int w = 0; w < 8; ++w) {
        unsigned U = selm[w] | selm[8 + w] | selm[16 + w] | selm[24 + w];
        U = (unsigned)__builtin_amdgcn_readfirstlane((int)U);
        const unsigned myw = selm[ql * 8 + w];
        while (U) {
            const int b = __builtin_ctz(U); U &= U - 1u;
            const int blk = 32 * w + b; const bool rs = (myw >> b) & 1u;
            att_step<1>(st, qf, KSg, VSTg, S_, blk * 64, t, head, rs, lane, bkt, tab);
            att_step<1>(st, qf, KSg, VSTg, S_, blk * 64 + 32, t, head, rs, lane, bkt, tab);
        }
    }
    att_finish(st, acc, g_s);
    const gbf* KWg = P.KWIN + (size_t)g * S_ * 64; const gbf* VWTg = P.VWINT + (size_t)g * 64 * S_;
    att_reset(st);
    { int kb0 = t0 - 511; kb0 = kb0 < 0 ? 0 : (kb0 & ~31);
      for (int kb = kb0; kb <= t0 + 3; kb += 32) att_step<2>(st, qf, KWg, VWTg, S_, kb, t, head, true, lane, bkt, tab); }
    att_finish(st, acc, g_w);
    gbf* ap = P.A + (size_t)t * NSAW + head * 64 + 4 * gq;
#pragma unroll
    for (int dt = 0; dt < 4; ++dt) { u32x2 w; w.x = pk2(acc[dt][0], acc[dt][1]); w.y = pk2(acc[dt][2], acc[dt][3]); *(GAS u32x2*)(ap + 16 * dt) = w; }
}

__device__ __forceinline__ void xattn_unit_v1(Frame& F, const gbf* Q2, const gbf* KM, const gbf* VMT, gbf* O2, int qt, int h) {
    const int lane = F.lane, i16 = lane & 15, gq = lane >> 4;
    const int t = 16 * qt + i16;
    bf16x8 qf[4];
#pragma unroll
    for (int s = 0; s < 4; ++s) qf[s] = *(const GAS bf16x8*)(Q2 + (size_t)t * XW + h * XHD + 32 * s + 8 * gq);
    f32x4 o[8];
#pragma unroll
    for (int i = 0; i < 8; ++i) o[i] = (f32x4){0.f, 0.f, 0.f, 0.f};
    float m = NEGBIG, l = 0.f;
#pragma unroll 1
    for (int kb = 0; kb < NMEM; kb += 32) {
        f32x4 s[2];
#pragma unroll
        for (int tau = 0; tau < 2; ++tau) {
            const int ko = 8 * (i16 >> 2) + 4 * tau + (i16 & 3);
            const gbf* kp = KM + (size_t)(kb + ko) * XW + h * XHD + 8 * gq;
            s[tau] = (f32x4){0.f, 0.f, 0.f, 0.f};
#pragma unroll
            for (int ks = 0; ks < 4; ++ks) s[tau] = __builtin_amdgcn_mfma_f32_16x16x32_bf16(*(const GAS bf16x8*)(kp + 32 * ks), qf[ks], s[tau], 0, 0, 0);
        }
        float mx = fmaxf(fmaxf(fmaxf(s[0][0], s[0][1]), fmaxf(s[0][2], s[0][3])), fmaxf(fmaxf(s[1][0], s[1][1]), fmaxf(s[1][2], s[1][3])));
        mx = fmaxf(mx, __shfl_xor(mx, 16)); mx = fmaxf(mx, __shfl_xor(mx, 32));
        const float mn = fmaxf(m, mx); const float alpha = __builtin_amdgcn_exp2f(m - mn); m = mn;
        float p[8]; float ps = 0.f;
#pragma unroll
        for (int e = 0; e < 8; ++e) { p[e] = __builtin_amdgcn_exp2f(s[e >> 2][e & 3] - mn); ps += p[e]; }
        l = l * alpha + ps;
        u32x4 pw; pw.x = pk2(p[0], p[1]); pw.y = pk2(p[2], p[3]); pw.z = pk2(p[4], p[5]); pw.w = pk2(p[6], p[7]);
        const bf16x8 pb = __builtin_bit_cast(bf16x8, pw);
#pragma unroll
        for (int dt = 0; dt < 8; ++dt) {
            const bf16x8 vf = *(const GAS bf16x8*)(VMT + (size_t)(h * XHD + 16 * dt + i16) * NMEM + kb + 8 * gq);
            o[dt] = o[dt] * alpha;
            o[dt] = __builtin_amdgcn_mfma_f32_16x16x32_bf16(vf, pb, o[dt], 0, 0, 0);
        }
    }
    l += __shfl_xor(l, 16); l += __shfl_xor(l, 32);
    const float inv = 1.f / l;
    gbf* op = O2 + (size_t)t * XW + h * XHD + 4 * gq;
#pragma unroll
    for (int dt = 0; dt < 8; ++dt) { u32x2 w; w.x = pk2(o[dt][0] * inv, o[dt][1] * inv); w.y = pk2(o[dt][2] * inv, o[dt][3] * inv); *(GAS u32x2*)(op + 16 * dt) = w; }
}
__device__ __forceinline__ void pool_item(const gbf* U, gbf* YP, int item, int lane) {
    const int t = item >> 1, half = item & 1, gi = half * 2 + (lane >> 5), w = 2 << gi, col = half * 512 + lane * 8;
    const int cnt = (t + 1) < w ? (t + 1) : w;
    float s[8];
#pragma unroll
    for (int e = 0; e < 8; ++e) s[e] = 0.f;
    float u0[8];
    for (int i = 0; i < cnt; ++i) {
        const u32x4 v = *(const GAS u32x4*)(U + (size_t)(t - i) * POOLW + col);
        const float f[8] = {bflo(v.x), bfhi(v.x), bflo(v.y), bfhi(v.y), bflo(v.z), bfhi(v.z), bflo(v.w), bfhi(v.w)};
#pragma unroll
        for (int e = 0; e < 8; ++e) { s[e] += f[e]; if (i == 0) u0[e] = f[e]; }
    }
    const float inv = 1.f / (float)cnt;
    u32x4 o; o.x = pk2(s[0] * inv - u0[0], s[1] * inv - u0[1]); o.y = pk2(s[2] * inv - u0[2], s[3] * inv - u0[3]); o.z = pk2(s[4] * inv - u0[4], s[5] * inv - u0[5]); o.w = pk2(s[6] * inv - u0[6], s[7] * inv - u0[7]);
    *(GAS u32x4*)(YP + (size_t)t * POOLW + col) = o;
}
__device__ __forceinline__ void cmp_final_item(const gfl* PQ, const gfl* PEB, const gfl* w2  , gbf* KC, gbf* VCT, LAS float* hid, int item, int lane) {
    const int kv = item >> 12, g = (item >> 10) & 3, n = item & 1023;
    float out = 0.f;
    if (n < NCMP) {
        const gfl* p1 = PQ + ((size_t)kv * 4096 + g * 1024 + n) * 256; const gfl* p2 = p1 + 256 + 128;
#pragma unroll
        for (int hh = 0; hh < 2; ++hh) { const int j = lane + 64 * hh; float pe = 0.f;
#pragma unroll
            for (int p = 0; p < 8; ++p) pe += PEB[p * 256 + kv * 128 + j];
            hid[j] = gelu_tanh(p1[j] + p2[j] + pe); }
        LDS_WAIT(); asm volatile("" ::: "memory");
        const gfl* wp = w2 + (size_t)kv * 128 * 64 + lane;
#pragma unroll 8
        for (int j = 0; j < 128; ++j) out += hid[j] * wp[j * 64];
        LDS_WAIT(); asm volatile("" ::: "memory");
    }
    if (kv == 0) KC[((size_t)g * 1024 + n) * 64 + lane] = (bf16)f2bf(out);
    else VCT[((size_t)g * 64 + lane) * 1024 + n] = (bf16)f2bf(out);
}

struct Args { const float* in[25]; float* out; unsigned char* ws; int l_lo, l_hi, ph_lo, ph_hi, use_bar, pad; };
enum { I_X = 0, I_MEM, I_RELB, I_LN_MIX_PRE, I_LN_MIX_POST, I_LN_X_PRE, I_LN_X_POST, I_LN_MEM, I_LN_FFN_PRE, I_LN_FFN_POST, I_W_IN, I_CMP_PE, I_CMP_W1, I_CMP_W2, I_W_POOL, I_POOL_SCALE,
       I_W_BR_ATTN, I_W_BR_POOL, I_W_MIX_OUT, I_W_XQ, I_W_XKV, I_W_XO, I_W_GATE, I_W_UP, I_W_DOWN };
constexpr int NPHASE = 17;
constexpr int TR_SCR_STRIDE = 12288, TR_TAB_OFF = 8 * TR_SCR_STRIDE;
__device__ __forceinline__ gby* launder_ptr(gby* p) { asm volatile("" : "+s"(p)); return p; }
__device__ __forceinline__ int launder_int(int v) { asm volatile("" : "+s"(v)); return v; }
template <class T> __device__ __forceinline__ T* uniform_ptr(T* p) { const unsigned long long v = (unsigned long long)p; const unsigned lo = (unsigned)__builtin_amdgcn_readfirstlane((int)(unsigned)v), hi = (unsigned)__builtin_amdgcn_readfirstlane((int)(unsigned)(v >> 32)); return (T*)(((unsigned long long)hi << 32) | lo); }

__device__ __forceinline__ void tr_run(Frame& F, int nd, int total) {
    const LAS TrDesc* tab = (const LAS TrDesc*)(F.lds + TR_TAB_OFF); LAS float* scr = (LAS float*)(F.lds + F.wave * TR_SCR_STRIDE);
#pragma unroll 1
    for (int it = F.gw; it < total; it += F.NGW) {
        int d = 0;
#pragma unroll 1
        for (int e = 1; e < nd; ++e) if (tab[e].start <= it) d = e;
        d = __builtin_amdgcn_readfirstlane(d);
        const gfl* W = uniform_ptr(tab[d].W); gbf* WT = uniform_ptr(tab[d].WT); const gfl* cs = uniform_ptr(tab[d].cs);
        const int N = __builtin_amdgcn_readfirstlane(tab[d].N), ldk = __builtin_amdgcn_readfirstlane(tab[d].ldk), code = __builtin_amdgcn_readfirstlane(tab[d].code), moff = __builtin_amdgcn_readfirstlane(tab[d].moff), st = __builtin_amdgcn_readfirstlane(tab[d].start);
        tr_item(W, N, WT, ldk, scr, it - st, F.lane, code, moff, cs);
    }
}
#define TR_PUT(W_, K_, N_, WT_, ldk_, code_, moff_, cs_) do { tab[nd].W = (W_); tab[nd].WT = (WT_); tab[nd].cs = (cs_); tab[nd].K = (K_); tab[nd].N = (N_); tab[nd].ldk = (ldk_); tab[nd].code = (code_); tab[nd].moff = (moff_); \
    tab[nd].start = total; total += ((K_) / 64) * (((N_) + 31) / 32); ++nd; } while (0)

#define PHASE_BEGIN() gby* const w_ = launder_ptr(ws_k); const int b_ = launder_int(bid_k); Frame F = F0; \
    { int t_ = F0.tid; asm volatile("" : "+v"(t_)); const int v_ = launder_int(F0.vcu); F.tid = t_; F.lane = t_ & 63; F.wave = __builtin_amdgcn_readfirstlane(t_ >> 6); F.vcu = v_; F.gw = v_ * NWAVES + F.wave; F.ws = w_; }
__global__ void __launch_bounds__(NWAVES * 64, 2) mega_fwd(Args args) {
    extern __shared__ __attribute__((aligned(16))) unsigned char lds_raw[];
    Frame F;
    F.lds = (LAS unsigned char*)lds_raw;
    F.tid = threadIdx.x; F.lane = F.tid & 63; F.wave = __builtin_amdgcn_readfirstlane(F.tid >> 6);
    F.G = gridDim.x; { const int bx = blockIdx.x; F.vcu = (F.G % 8 == 0) ? (bx % 8) * (F.G / 8) + bx / 8 : bx; }
    F.gw = F.vcu * NWAVES + F.wave; F.NGW = F.G * NWAVES; F.ws = (gby*)args.ws;
    gby* const ws = (gby*)args.ws; gby* const ws_k = ws;
#define INP(i) ((const gfl*)args.in[i])
    volatile LAS unsigned* MISC = (volatile LAS unsigned*)(F.lds + MISC_OFF);
    for (int u = F.tid; u < (LDS_BYTES - LDSCTL_OFF) / 4; u += NWAVES * 64) ((LAS unsigned*)(F.lds + LDSCTL_OFF))[u] = 0u;
    __syncthreads();
    XcdBarrier bar; bar.bar = (GAS unsigned*)(ws + WS_CTL) + CW_BAR; bar.x = 0; bar.st = nullptr;
    const bool use_bar = args.use_bar != 0;
    if (use_bar) bar = xcd_barrier_post((GAS unsigned*)(ws + WS_CTL) + CW_BAR, MISC + 8);
#define SEAM() do { if (use_bar) xcd_barrier(bar); } while (0)
    const int phmask = (int)(((1u << args.ph_hi) - 1u) & ~((1u << args.ph_lo) - 1u));
#ifndef PHMASK
#define PHMASK 0x1ffff
#endif
#define IN(k) (((PHMASK >> (k)) & 1) && ((launder_int(phmask) >> (k)) & 1))
    gfl* const X = (gfl*)args.out;
    gbf* const H = (gbf*)(ws + WS_H);
    const int bid = (int)blockIdx.x; const int bid_k = bid;
    LAS int* const trn = (LAS int*)(F.lds + TR_TAB_OFF + 32 * 48);

    if (args.l_lo == 0 && IN(0)) {
        if (F.tid == 0) { LAS TrDesc* tab = (LAS TrDesc*)(F.lds + TR_TAB_OFF); int nd = launder_int(0), total = launder_int(0);
            for (int l = 0; l < NL; ++l) TR_PUT(INP(I_W_XKV) + (size_t)l * DM * 1024, DM, 1024, (gbf*)(ws + WS_WXKV) + (size_t)l * 1024 * DM, DM, 0, 0, (const gfl*)nullptr);
            trn[0] = nd; trn[1] = total; }
        LDS_WAIT(); __syncthreads();
        tr_run(F, trn[0], trn[1]);
        for (int it = F.gw; it < 4 * NMEM; it += F.NGW) { const int l = it >> 8, r = it & 255;
            rms_row_to_bf16(INP(I_MEM) + (size_t)r * DM, INP(I_LN_MEM) + (size_t)l * DM, (gbf*)(ws + WS_MEMN) + ((size_t)l * NMEM + r) * DM, F.lane); }
        for (int m = F.gw; m < S_; m += F.NGW) {
            const gfl* xr = INP(I_X) + (size_t)m * DM; gfl* xo = X + (size_t)m * DM;
#pragma unroll
            for (int j = 0; j < 8; ++j) *(GAS f32x4*)(xo + 4 * (F.lane + 64 * j)) = *(const GAS f32x4*)(xr + 4 * (F.lane + 64 * j));
            rms_row_to_bf16(xr, INP(I_LN_MIX_PRE), H + (size_t)m * DM, F.lane);
        }
        __syncthreads();
        SEAM();
    }
    if (args.l_lo == 0 && IN(1)) {
        pg8::Sched<1, 4, 4, false> S; S.init(F.G, bid);
        EpiKVmem E{(gbf*)(ws + WS_KM), (gbf*)(ws + WS_VMT)};
        pg8::gemm_phase<DM, DM, DM, (long)NMEM * DM, (long)1024 * DM>(F.lds, F.tid, (const gbf*)(ws + WS_MEMN), (const gbf*)(ws + WS_WXKV), S, E);
        SEAM();
    }

    const Frame F0 = F;
    const int l_lo = args.l_lo, l_hi = args.l_hi;

    if (launder_int(l_lo) <= 0 && 0 < launder_int(l_hi)) { constexpr int l = 0;
        if (IN(2)) { PHASE_BEGIN();
            if (F.tid == 0) { LAS TrDesc* tab = (LAS TrDesc*)(F.lds + TR_TAB_OFF); int nd = launder_int(0), total = launder_int(0); const gfl* nul = nullptr;
                TR_PUT(INP(I_W_IN) + (size_t)l * DM * INW, DM, INW, (gbf*)(w_ + WS_WIN), DM, 1, 0, nul);
                TR_PUT(INP(I_W_BR_ATTN) + (size_t)l * NSAW * DM, NSAW, DM, (gbf*)(w_ + WS_WBRA), NSAW, 0, 0, nul);
                TR_PUT(INP(I_W_BR_POOL) + (size_t)l * POOLW * DM, POOLW, DM, (gbf*)(w_ + WS_WBRP), POOLW, 0, 0, nul);
                TR_PUT(INP(I_W_MIX_OUT) + (size_t)l * DM * DM, DM, DM, (gbf*)(w_ + WS_WMIX), DM, 0, 0, nul);
                TR_PUT(INP(I_W_XQ) + (size_t)l * DM * XW, DM, XW, (gbf*)(w_ + WS_WXQ), DM, 0, 0, nul);
                TR_PUT(INP(I_W_XO) + (size_t)l * XW * DM, XW, DM, (gbf*)(w_ + WS_WXO), XW, 0, 0, nul);
                TR_PUT(INP(I_W_GATE) + (size_t)l * DM * DFF, DM, DFF, (gbf*)(w_ + WS_WGU), DM, 2, 0, nul);
                TR_PUT(INP(I_W_UP) + (size_t)l * DM * DFF, DM, DFF, (gbf*)(w_ + WS_WGU), DM, 2, 128, nul);
                TR_PUT(INP(I_W_DOWN) + (size_t)l * DFF * DM, DFF, DM, (gbf*)(w_ + WS_WDN), DFF, 0, 0, nul);
                for (int q = 0; q < 4; ++q) { const int kv = q >> 1, half = q & 1;
                    TR_PUT(INP(I_CMP_W1) + (((size_t)l * 2 + kv) * 2048 + half * 1024) * 128, 1024, 128, (gbf*)(w_ + WS_WC1) + (size_t)kv * 256 * 1024, 1024, 0, half * 128, nul); }
                for (int gi = 0; gi < 4; ++gi)
                    TR_PUT(INP(I_W_POOL) + ((size_t)l * 4 + gi) * 65536, 256, 256, (gbf*)(w_ + WS_WPOOL) + (size_t)gi * 65536, 256, 0, 0, INP(I_POOL_SCALE) + (size_t)l * POOLW + gi * 256);
                trn[0] = nd; trn[1] = total; }
            LDS_WAIT(); __syncthreads();
            if (F.gw < 32) {
                const int p = F.gw >> 2, kv = (F.gw >> 1) & 1, j = (F.gw & 1) * 64 + F.lane;
                const gfl* pe = INP(I_CMP_PE) + ((size_t)l * 2 + kv) * 2048 + p * 256; const gfl* w1 = INP(I_CMP_W1) + (((size_t)l * 2 + kv) * 2048 + p * 256) * 128 + j;
                float a = 0.f;
#pragma unroll 8
                for (int k = 0; k < 256; ++k) a += pe[k] * w1[(size_t)k * 128];
                ((gfl*)(w_ + WS_PEB))[p * 256 + kv * 128 + j] = a;
            }
            tr_run(F, trn[0], trn[1]);
            __syncthreads();
            SEAM();
        }
        if (IN(3)) { PHASE_BEGIN();
            pg8::Sched<S_ / 256, ZN / 256, 1, false> S; S.init(F.G, b_);
            EpiZ E{w_};
            pg8::gemm_phase<DM, DM, DM, 0, 0>(F.lds, F.tid, H, (const gbf*)(w_ + WS_WIN), S, E);
            SEAM();
        }
        if (IN(4)) { PHASE_BEGIN();
#pragma unroll 1
            for (int it = F.gw; it < 2 * S_; it += F.NGW) pool_item((const gbf*)(w_ + WS_U), (gbf*)(w_ + WS_YP), it, F.lane);
            __syncthreads();
            pg8::Sched<16, 1, 2, false> S; S.init(F.G, b_);
            EpiF32 E{(gfl*)(w_ + WS_PQ), 256, (size_t)4096 * 256};
            pg8::gemm_phase<1024, 1024, 1024, (long)(WS_VCR - WS_KCR) / 2, (long)256 * 1024>(F.lds, F.tid, (const gbf*)(w_ + WS_KCR), (const gbf*)(w_ + WS_WC1), S, E);
            SEAM();
        }
        if (IN(5)) { PHASE_BEGIN();
            LAS float* hid = (LAS float*)(F.lds + F.wave * 1024);
#pragma unroll 1
            for (int it = F.gw; it < 8192; it += F.NGW) cmp_final_item((const gfl*)(w_ + WS_PQ), (const gfl*)(w_ + WS_PEB), INP(I_CMP_W2) + (size_t)l * 2 * 128 * 64, (gbf*)(w_ + WS_KC), (gbf*)(w_ + WS_VCT), hid, it, F.lane);
            __syncthreads();
            pg8::Sched<S_ / 256, 1, 4, false> S; S.init(F.G, b_);
            EpiBf16 E{(gbf*)(w_ + WS_P), POOLW, 256, 1.f};
            pg8::gemm_phase<POOLW, 256, 256, 256, 65536>(F.lds, F.tid, (const gbf*)(w_ + WS_YP), (const gbf*)(w_ + WS_WPOOL), S, E);
            SEAM();
        }
        if (IN(6)) { PHASE_BEGIN();
            attn_setup_tables(F, INP(I_RELB));
            const AttnPtrs P{(const gbf*)(w_ + WS_Q), (const gbf*)(w_ + WS_KC), (const gbf*)(w_ + WS_VCT), (const gbf*)(w_ + WS_KSEL), (const gbf*)(w_ + WS_VSELT), (const gbf*)(w_ + WS_KWIN), (const gbf*)(w_ + WS_VWINT),
                             (const gfl*)(w_ + WS_GL), (gbf*)(w_ + WS_A)};
#pragma unroll 1
            for (int it = F.gw; it < (S_ / 4) * NGRP; it += F.NGW) nsa_unit_v1(F, P, it >> 2, it & 3);
            __syncthreads();
            SEAM();
        }
        if (IN(7)) { PHASE_BEGIN();
            pg8::Sched<S_ / 256, DM / 256, 2, true> S; S.init(F.G, b_);
            EpiMerge E{(gbf*)(w_ + WS_Y1), (const gbf*)(w_ + WS_MG)};
            pg8::gemm_phase<NSAW, NSAW, NSAW, (long)(WS_P - WS_A) / 2, (long)(WS_WBRP - WS_WBRA) / 2>(F.lds, F.tid, (const gbf*)(w_ + WS_A), (const gbf*)(w_ + WS_WBRA), S, E);
            SEAM();
        }
        if (IN(8)) { PHASE_BEGIN();
            pg8::Sched<S_ / 256, DM / 256, 1, false> S; S.init(F.G, b_);
            EpiBf16 E{(gbf*)(w_ + WS_Y2), DM, 0, 1.f};
            pg8::gemm_phase<DM, DM, DM, 0, 0>(F.lds, F.tid, (const gbf*)(w_ + WS_Y1), (const gbf*)(w_ + WS_WMIX), S, E);
            SEAM();
        }
        if (IN(9)) { PHASE_BEGIN();
#pragma unroll 1
            for (int m = F.gw; m < S_; m += F.NGW) resid_row(X + (size_t)m * DM, X + (size_t)m * DM, (const gbf*)(w_ + WS_Y2) + (size_t)m * DM, INP(I_LN_MIX_POST) + (size_t)l * DM, INP(I_LN_X_PRE) + (size_t)l * DM, H + (size_t)m * DM, F.lane);
            SEAM();
        }
        if (IN(10)) { PHASE_BEGIN();
            pg8::Sched<S_ / 256, XW / 256, 1, false> S; S.init(F.G, b_);
            EpiBf16 E{(gbf*)(w_ + WS_Q2), XW, 0, 1.f};
            pg8::gemm_phase<DM, DM, DM, 0, 0>(F.lds, F.tid, H, (const gbf*)(w_ + WS_WXQ), S, E);
            SEAM();
        }
        if (IN(11)) { PHASE_BEGIN();
#pragma unroll 1
            for (int it = F.gw; it < (S_ / 16) * 4; it += F.NGW) xattn_unit_v1(F, (const gbf*)(w_ + WS_Q2), (const gbf*)(w_ + WS_KM) + (size_t)l * NMEM * XW, (const gbf*)(w_ + WS_VMT) + (size_t)l * XW * NMEM, (gbf*)(w_ + WS_O2), it >> 2, it & 3);
            SEAM();
        }
        if (IN(12)) { PHASE_BEGIN();
            pg8::Sched<S_ / 256, DM / 256, 1, false> S; S.init(F.G, b_);
            EpiBf16 E{(gbf*)(w_ + WS_Y2), DM, 0, 1.f};
            pg8::gemm_phase<XW, XW, XW, 0, 0>(F.lds, F.tid, (const gbf*)(w_ + WS_O2), (const gbf*)(w_ + WS_WXO), S, E);
            SEAM();
        }
        if (IN(13)) { PHASE_BEGIN();
#pragma unroll 1
            for (int m = F.gw; m < S_; m += F.NGW) resid_row(X + (size_t)m * DM, X + (size_t)m * DM, (const gbf*)(w_ + WS_Y2) + (size_t)m * DM, INP(I_LN_X_POST) + (size_t)l * DM, INP(I_LN_FFN_PRE) + (size_t)l * DM, H + (size_t)m * DM, F.lane);
            SEAM();
        }
        if (IN(14)) { PHASE_BEGIN();
            pg8::Sched<S_ / 256, 2 * DFF / 256, 1, false> S; S.init(F.G, b_);
            EpiSwiGLU E{(gbf*)(w_ + WS_HID)};
            pg8::gemm_phase<DM, DM, DM, 0, 0>(F.lds, F.tid, H, (const gbf*)(w_ + WS_WGU), S, E);
            SEAM();
        }
        if (IN(15)) { PHASE_BEGIN();
            pg8::Sched<S_ / 256, DM / 256, 1, false> S; S.init(F.G, b_);
            EpiBf16 E{(gbf*)(w_ + WS_Y2), DM, 0, 1.f};
            pg8::gemm_phase<DFF, DFF, DFF, 0, 0>(F.lds, F.tid, (const gbf*)(w_ + WS_HID), (const gbf*)(w_ + WS_WDN), S, E);
            SEAM();
        }
        if (IN(16)) { PHASE_BEGIN();
            const gfl* gpre = (l + 1 < NL) ? INP(I_LN_MIX_PRE) + (size_t)(l + 1) * DM : (const gfl*)nullptr;
#pragma unroll 1
            for (int m = F.gw; m < S_; m += F.NGW) resid_row(X + (size_t)m * DM, X + (size_t)m * DM, (const gbf*)(w_ + WS_Y2) + (size_t)m * DM, INP(I_LN_FFN_POST) + (size_t)l * DM, gpre, H + (size_t)m * DM, F.lane);
            if (l + 1 < launder_int(l_hi)) SEAM();
        }
    }

    if (launder_int(l_lo) <= 1 && 1 < launder_int(l_hi)) { constexpr int l = 1;
        if (IN(2)) { PHASE_BEGIN();
            if (F.tid == 0) { LAS TrDesc* tab = (LAS TrDesc*)(F.lds + TR_TAB_OFF); int nd = launder_int(0), total = launder_int(0); const gfl* nul = nullptr;
                TR_PUT(INP(I_W_IN) + (size_t)l * DM * INW, DM, INW, (gbf*)(w_ + WS_WIN), DM, 1, 0, nul);
                TR_PUT(INP(I_W_BR_ATTN) + (size_t)l * NSAW * DM, NSAW, DM, (gbf*)(w_ + WS_WBRA), NSAW, 0, 0, nul);
                TR_PUT(INP(I_W_BR_POOL) + (size_t)l * POOLW * DM, POOLW, DM, (gbf*)(w_ + WS_WBRP), POOLW, 0, 0, nul);
                TR_PUT(INP(I_W_MIX_OUT) + (size_t)l * DM * DM, DM, DM, (gbf*)(w_ + WS_WMIX), DM, 0, 0, nul);
                TR_PUT(INP(I_W_XQ) + (size_t)l * DM * XW, DM, XW, (gbf*)(w_ + WS_WXQ), DM, 0, 0, nul);
                TR_PUT(INP(I_W_XO) + (size_t)l * XW * DM, XW, DM, (gbf*)(w_ + WS_WXO), XW, 0, 0, nul);
                TR_PUT(INP(I_W_GATE) + (size_t)l * DM * DFF, DM, DFF, (gbf*)(w_ + WS_WGU), DM, 2, 0, nul);
                TR_PUT(INP(I_W_UP) + (size_t)l * DM * DFF, DM, DFF, (gbf*)(w_ + WS_WGU), DM, 2, 128, nul);
                TR_PUT(INP(I_W_DOWN) + (size_t)l * DFF * DM, DFF, DM, (gbf*)(w_ + WS_WDN), DFF, 0, 0, nul);
                for (int q = 0; q < 4; ++q) { const int kv = q >> 1, half = q & 1;
                    TR_PUT(INP(I_CMP_W1) + (((size_t)l * 2 + kv) * 2048 + half * 1024) * 128, 1024, 128, (gbf*)(w_ + WS_WC1) + (size_t)kv * 256 * 1024, 1024, 0, half * 128, nul); }
                for (int gi = 0; gi < 4; ++gi)
                    TR_PUT(INP(I_W_POOL) + ((size_t)l * 4 + gi) * 65536, 256, 256, (gbf*)(w_ + WS_WPOOL) + (size_t)gi * 65536, 256, 0, 0, INP(I_POOL_SCALE) + (size_t)l * POOLW + gi * 256);
                trn[0] = nd; trn[1] = total; }
            LDS_WAIT(); __syncthreads();
            if (F.gw < 32) {
                const int p = F.gw >> 2, kv = (F.gw >> 1) & 1, j = (F.gw & 1) * 64 + F.lane;
                const gfl* pe = INP(I_CMP_PE) + ((size_t)l * 2 + kv) * 2048 + p * 256; const gfl* w1 = INP(I_CMP_W1) + (((size_t)l * 2 + kv) * 2048 + p * 256) * 128 + j;
                float a = 0.f;
#pragma unroll 8
                for (int k = 0; k < 256; ++k) a += pe[k] * w1[(size_t)k * 128];
                ((gfl*)(w_ + WS_PEB))[p * 256 + kv * 128 + j] = a;
            }
            tr_run(F, trn[0], trn[1]);
            __syncthreads();
            SEAM();
        }
        if (IN(3)) { PHASE_BEGIN();
            pg8::Sched<S_ / 256, ZN / 256, 1, false> S; S.init(F.G, b_);
            EpiZ E{w_};
            pg8::gemm_phase<DM, DM, DM, 0, 0>(F.lds, F.tid, H, (const gbf*)(w_ + WS_WIN), S, E);
            SEAM();
        }
        if (IN(4)) { PHASE_BEGIN();
#pragma unroll 1
            for (int it = F.gw; it < 2 * S_; it += F.NGW) pool_item((const gbf*)(w_ + WS_U), (gbf*)(w_ + WS_YP), it, F.lane);
            __syncthreads();
            pg8::Sched<16, 1, 2, false> S; S.init(F.G, b_);
            EpiF32 E{(gfl*)(w_ + WS_PQ), 256, (size_t)4096 * 256};
            pg8::gemm_phase<1024, 1024, 1024, (long)(WS_VCR - WS_KCR) / 2, (long)256 * 1024>(F.lds, F.tid, (const gbf*)(w_ + WS_KCR), (const gbf*)(w_ + WS_WC1), S, E);
            SEAM();
        }
        if (IN(5)) { PHASE_BEGIN();
            LAS float* hid = (LAS float*)(F.lds + F.wave * 1024);
#pragma unroll 1
            for (int it = F.gw; it < 8192; it += F.NGW) cmp_final_item((const gfl*)(w_ + WS_PQ), (const gfl*)(w_ + WS_PEB), INP(I_CMP_W2) + (size_t)l * 2 * 128 * 64, (gbf*)(w_ + WS_KC), (gbf*)(w_ + WS_VCT), hid, it, F.lane);
            __syncthreads();
            pg8::Sched<S_ / 256, 1, 4, false> S; S.init(F.G, b_);
            EpiBf16 E{(gbf*)(w_ + WS_P), POOLW, 256, 1.f};
            pg8::gemm_phase<POOLW, 256, 256, 256, 65536>(F.lds, F.tid, (const gbf*)(w_ + WS_YP), (const gbf*)(w_ + WS_WPOOL), S, E);
            SEAM();
        }
        if (IN(6)) { PHASE_BEGIN();
            attn_setup_tables(F, INP(I_RELB));
            const AttnPtrs P{(const gbf*)(w_ + WS_Q), (const gbf*)(w_ + WS_KC), (const gbf*)(w_ + WS_VCT), (const gbf*)(w_ + WS_KSEL), (const gbf*)(w_ + WS_VSELT), (const gbf*)(w_ + WS_KWIN), (const gbf*)(w_ + WS_VWINT),
                             (const gfl*)(w_ + WS_GL), (gbf*)(w_ + WS_A)};
#pragma unroll 1
            for (int it = F.gw; it < (S_ / 4) * NGRP; it += F.NGW) nsa_unit_v1(F, P, it >> 2, it & 3);
            __syncthreads();
            SEAM();
        }
        if (IN(7)) { PHASE_BEGIN();
            pg8::Sched<S_ / 256, DM / 256, 2, true> S; S.init(F.G, b_);
            EpiMerge E{(gbf*)(w_ + WS_Y1), (const gbf*)(w_ + WS_MG)};
            pg8::gemm_phase<NSAW, NSAW, NSAW, (long)(WS_P - WS_A) / 2, (long)(WS_WBRP - WS_WBRA) / 2>(F.lds, F.tid, (const gbf*)(w_ + WS_A), (const gbf*)(w_ + WS_WBRA), S, E);
            SEAM();
        }
        if (IN(8)) { PHASE_BEGIN();
            pg8::Sched<S_ / 256, DM / 256, 1, false> S; S.init(F.G, b_);
            EpiBf16 E{(gbf*)(w_ + WS_Y2), DM, 0, 1.f};
            pg8::gemm_phase<DM, DM, DM, 0, 0>(F.lds, F.tid, (const gbf*)(w_ + WS_Y1), (const gbf*)(w_ + WS_WMIX), S, E);
            SEAM();
        }
        if (IN(9)) { PHASE_BEGIN();
#pragma unroll 1
            for (int m = F.gw; m < S_; m += F.NGW) resid_row(X + (size_t)m * DM, X + (size_t)m * DM, (const gbf*)(w_ + WS_Y2) + (size_t)m * DM, INP(I_LN_MIX_POST) + (size_t)l * DM, INP(I_LN_X_PRE) + (size_t)l * DM, H + (size_t)m * DM, F.lane);
            SEAM();
        }
        if (IN(10)) { PHASE_BEGIN();
            pg8::Sched<S_ / 256, XW / 256, 1, false> S; S.init(F.G, b_);
            EpiBf16 E{(gbf*)(w_ + WS_Q2), XW, 0, 1.f};
            pg8::gemm_phase<DM, DM, DM, 0, 0>(F.lds, F.tid, H, (const gbf*)(w_ + WS_WXQ), S, E);
            SEAM();
        }
        if (IN(11)) { PHASE_BEGIN();
#pragma unroll 1
            for (int it = F.gw; it < (S_ / 16) * 4; it += F.NGW) xattn_unit_v1(F, (const gbf*)(w_ + WS_Q2), (const gbf*)(w_ + WS_KM) + (size_t)l * NMEM * XW, (const gbf*)(w_ + WS_VMT) + (size_t)l * XW * NMEM, (gbf*)(w_ + WS_O2), it >> 2, it & 3);
            SEAM();
        }
        if (IN(12)) { PHASE_BEGIN();
            pg8::Sched<S_ / 256, DM / 256, 1, false> S; S.init(F.G, b_);
            EpiBf16 E{(gbf*)(w_ + WS_Y2), DM, 0, 1.f};
            pg8::gemm_phase<XW, XW, XW, 0, 0>(F.lds, F.tid, (const gbf*)(w_ + WS_O2), (const gbf*)(w_ + WS_WXO), S, E);
            SEAM();
        }
        if (IN(13)) { PHASE_BEGIN();
#pragma unroll 1
            for (int m = F.gw; m < S_; m += F.NGW) resid_row(X + (size_t)m * DM, X + (size_t)m * DM, (const gbf*)(w_ + WS_Y2) + (size_t)m * DM, INP(I_LN_X_POST) + (size_t)l * DM, INP(I_LN_FFN_PRE) + (size_t)l * DM, H + (size_t)m * DM, F.lane);
            SEAM();
        }
        if (IN(14)) { PHASE_BEGIN();
            pg8::Sched<S_ / 256, 2 * DFF / 256, 1, false> S; S.init(F.G, b_);
            EpiSwiGLU E{(gbf*)(w_ + WS_HID)};
            pg8::gemm_phase<DM, DM, DM, 0, 0>(F.lds, F.tid, H, (const gbf*)(w_ + WS_WGU), S, E);
            SEAM();
        }
        if (IN(15)) { PHASE_BEGIN();
            pg8::Sched<S_ / 256, DM / 256, 1, false> S; S.init(F.G, b_);
            EpiBf16 E{(gbf*)(w_ + WS_Y2), DM, 0, 1.f};
            pg8::gemm_phase<DFF, DFF, DFF, 0, 0>(F.lds, F.tid, (const gbf*)(w_ + WS_HID), (const gbf*)(w_ + WS_WDN), S, E);
            SEAM();
        }
        if (IN(16)) { PHASE_BEGIN();
            const gfl* gpre = (l + 1 < NL) ? INP(I_LN_MIX_PRE) + (size_t)(l + 1) * DM : (const gfl*)nullptr;
#pragma unroll 1
            for (int m = F.gw; m < S_; m += F.NGW) resid_row(X + (size_t)m * DM, X + (size_t)m * DM, (const gbf*)(w_ + WS_Y2) + (size_t)m * DM, INP(I_LN_FFN_POST) + (size_t)l * DM, gpre, H + (size_t)m * DM, F.lane);
            if (l + 1 < launder_int(l_hi)) SEAM();
        }
    }

    if (launder_int(l_lo) <= 2 && 2 < launder_int(l_hi)) { constexpr int l = 2;
        if (IN(2)) { PHASE_BEGIN();
            if (F.tid == 0) { LAS TrDesc* tab = (LAS TrDesc*)(F.lds + TR_TAB_OFF); int nd = launder_int(0), total = launder_int(0); const gfl* nul = nullptr;
                TR_PUT(INP(I_W_IN) + (size_t)l * DM * INW, DM, INW, (gbf*)(w_ + WS_WIN), DM, 1, 0, nul);
                TR_PUT(INP(I_W_BR_ATTN) + (size_t)l * NSAW * DM, NSAW, DM, (gbf*)(w_ + WS_WBRA), NSAW, 0, 0, nul);
                TR_PUT(INP(I_W_BR_POOL) + (size_t)l * POOLW * DM, POOLW, DM, (gbf*)(w_ + WS_WBRP), POOLW, 0, 0, nul);
                TR_PUT(INP(I_W_MIX_OUT) + (size_t)l * DM * DM, DM, DM, (gbf*)(w_ + WS_WMIX), DM, 0, 0, nul);
                TR_PUT(INP(I_W_XQ) + (size_t)l * DM * XW, DM, XW, (gbf*)(w_ + WS_WXQ), DM, 0, 0, nul);
                TR_PUT(INP(I_W_XO) + (size_t)l * XW * DM, XW, DM, (gbf*)(w_ + WS_WXO), XW, 0, 0, nul);
                TR_PUT(INP(I_W_GATE) + (size_t)l * DM * DFF, DM, DFF, (gbf*)(w_ + WS_WGU), DM, 2, 0, nul);
                TR_PUT(INP(I_W_UP) + (size_t)l * DM * DFF, DM, DFF, (gbf*)(w_ + WS_WGU), DM, 2, 128, nul);
                TR_PUT(INP(I_W_DOWN) + (size_t)l * DFF * DM, DFF, DM, (gbf*)(w_ + WS_WDN), DFF, 0, 0, nul);
                for (int q = 0; q < 4; ++q) { const int kv = q >> 1, half = q & 1;
                    TR_PUT(INP(I_CMP_W1) + (((size_t)l * 2 + kv) * 2048 + half * 1024) * 128, 1024, 128, (gbf*)(w_ + WS_WC1) + (size_t)kv * 256 * 1024, 1024, 0, half * 128, nul); }
                for (int gi = 0; gi < 4; ++gi)
                    TR_PUT(INP(I_W_POOL) + ((size_t)l * 4 + gi) * 65536, 256, 256, (gbf*)(w_ + WS_WPOOL) + (size_t)gi * 65536, 256, 0, 0, INP(I_POOL_SCALE) + (size_t)l * POOLW + gi * 256);
                trn[0] = nd; trn[1] = total; }
            LDS_WAIT(); __syncthreads();
            if (F.gw < 32) {
                const int p = F.gw >> 2, kv = (F.gw >> 1) & 1, j = (F.gw & 1) * 64 + F.lane;
                const gfl* pe = INP(I_CMP_PE) + ((size_t)l * 2 + kv) * 2048 + p * 256; const gfl* w1 = INP(I_CMP_W1) + (((size_t)l * 2 + kv) * 2048 + p * 256) * 128 + j;
                float a = 0.f;
#pragma unroll 8
                for (int k = 0; k < 256; ++k) a += pe[k] * w1[(size_t)k * 128];
                ((gfl*)(w_ + WS_PEB))[p * 256 + kv * 128 + j] = a;
            }
            tr_run(F, trn[0], trn[1]);
            __syncthreads();
            SEAM();
        }
        if (IN(3)) { PHASE_BEGIN();
            pg8::Sched<S_ / 256, ZN / 256, 1, false> S; S.init(F.G, b_);
            EpiZ E{w_};
            pg8::gemm_phase<DM, DM, DM, 0, 0>(F.lds, F.tid, H, (const gbf*)(w_ + WS_WIN), S, E);
            SEAM();
        }
        if (IN(4)) { PHASE_BEGIN();
#pragma unroll 1
            for (int it = F.gw; it < 2 * S_; it += F.NGW) pool_item((const gbf*)(w_ + WS_U), (gbf*)(w_ + WS_YP), it, F.lane);
            __syncthreads();
            pg8::Sched<16, 1, 2, false> S; S.init(F.G, b_);
            EpiF32 E{(gfl*)(w_ + WS_PQ), 256, (size_t)4096 * 256};
            pg8::gemm_phase<1024, 1024, 1024, (long)(WS_VCR - WS_KCR) / 2, (long)256 * 1024>(F.lds, F.tid, (const gbf*)(w_ + WS_KCR), (const gbf*)(w_ + WS_WC1), S, E);
            SEAM();
        }
        if (IN(5)) { PHASE_BEGIN();
            LAS float* hid = (LAS float*)(F.lds + F.wave * 1024);
#pragma unroll 1
            for (int it = F.gw; it < 8192; it += F.NGW) cmp_final_item((const gfl*)(w_ + WS_PQ), (const gfl*)(w_ + WS_PEB), INP(I_CMP_W2) + (size_t)l * 2 * 128 * 64, (gbf*)(w_ + WS_KC), (gbf*)(w_ + WS_VCT), hid, it, F.lane);
            __syncthreads();
            pg8::Sched<S_ / 256, 1, 4, false> S; S.init(F.G, b_);
            EpiBf16 E{(gbf*)(w_ + WS_P), POOLW, 256, 1.f};
            pg8::gemm_phase<POOLW, 256, 256, 256, 65536>(F.lds, F.tid, (const gbf*)(w_ + WS_YP), (const gbf*)(w_ + WS_WPOOL), S, E);
            SEAM();
        }
        if (IN(6)) { PHASE_BEGIN();
            attn_setup_tables(F, INP(I_RELB));
            const AttnPtrs P{(const gbf*)(w_ + WS_Q), (const gbf*)(w_ + WS_KC), (const gbf*)(w_ + WS_VCT), (const gbf*)(w_ + WS_KSEL), (const gbf*)(w_ + WS_VSELT), (const gbf*)(w_ + WS_KWIN), (const gbf*)(w_ + WS_VWINT),
                             (const gfl*)(w_ + WS_GL), (gbf*)(w_ + WS_A)};
#pragma unroll 1
            for (int it = F.gw; it < (S_ / 4) * NGRP; it += F.NGW) nsa_unit_v1(F, P, it >> 2, it & 3);
            __syncthreads();
            SEAM();
        }
        if (IN(7)) { PHASE_BEGIN();
            pg8::Sched<S_ / 256, DM / 256, 2, true> S; S.init(F.G, b_);
            EpiMerge E{(gbf*)(w_ + WS_Y1), (const gbf*)(w_ + WS_MG)};
            pg8::gemm_phase<NSAW, NSAW, NSAW, (long)(WS_P - WS_A) / 2, (long)(WS_WBRP - WS_WBRA) / 2>(F.lds, F.tid, (const gbf*)(w_ + WS_A), (const gbf*)(w_ + WS_WBRA), S, E);
            SEAM();
        }
        if (IN(8)) { PHASE_BEGIN();
            pg8::Sched<S_ / 256, DM / 256, 1, false> S; S.init(F.G, b_);
            EpiBf16 E{(gbf*)(w_ + WS_Y2), DM, 0, 1.f};
            pg8::gemm_phase<DM, DM, DM, 0, 0>(F.lds, F.tid, (const gbf*)(w_ + WS_Y1), (const gbf*)(w_ + WS_WMIX), S, E);
            SEAM();
        }
        if (IN(9)) { PHASE_BEGIN();
#pragma unroll 1
            for (int m = F.gw; m < S_; m += F.NGW) resid_row(X + (size_t)m * DM, X + (size_t)m * DM, (const gbf*)(w_ + WS_Y2) + (size_t)m * DM, INP(I_LN_MIX_POST) + (size_t)l * DM, INP(I_LN_X_PRE) + (size_t)l * DM, H + (size_t)m * DM, F.lane);
            SEAM();
        }
        if (IN(10)) { PHASE_BEGIN();
            pg8::Sched<S_ / 256, XW / 256, 1, false> S; S.init(F.G, b_);
            EpiBf16 E{(gbf*)(w_ + WS_Q2), XW, 0, 1.f};
            pg8::gemm_phase<DM, DM, DM, 0, 0>(F.lds, F.tid, H, (const gbf*)(w_ + WS_WXQ), S, E);
            SEAM();
        }
        if (IN(11)) { PHASE_BEGIN();
#pragma unroll 1
            for (int it = F.gw; it < (S_ / 16) * 4; it += F.NGW) xattn_unit_v1(F, (const gbf*)(w_ + WS_Q2), (const gbf*)(w_ + WS_KM) + (size_t)l * NMEM * XW, (const gbf*)(w_ + WS_VMT) + (size_t)l * XW * NMEM, (gbf*)(w_ + WS_O2), it >> 2, it & 3);
            SEAM();
        }
        if (IN(12)) { PHASE_BEGIN();
            pg8::Sched<S_ / 256, DM / 256, 1, false> S; S.init(F.G, b_);
            EpiBf16 E{(gbf*)(w_ + WS_Y2), DM, 0, 1.f};
            pg8::gemm_phase<XW, XW, XW, 0, 0>(F.lds, F.tid, (const gbf*)(w_ + WS_O2), (const gbf*)(w_ + WS_WXO), S, E);
            SEAM();
        }
        if (IN(13)) { PHASE_BEGIN();
#pragma unroll 1
            for (int m = F.gw; m < S_; m += F.NGW) resid_row(X + (size_t)m * DM, X + (size_t)m * DM, (const gbf*)(w_ + WS_Y2) + (size_t)m * DM, INP(I_LN_X_POST) + (size_t)l * DM, INP(I_LN_FFN_PRE) + (size_t)l * DM, H + (size_t)m * DM, F.lane);
            SEAM();
        }
        if (IN(14)) { PHASE_BEGIN();
            pg8::Sched<S_ / 256, 2 * DFF / 256, 1, false> S; S.init(F.G, b_);
            EpiSwiGLU E{(gbf*)(w_ + WS_HID)};
            pg8::gemm_phase<DM, DM, DM, 0, 0>(F.lds, F.tid, H, (const gbf*)(w_ + WS_WGU), S, E);
            SEAM();
        }
        if (IN(15)) { PHASE_BEGIN();
            pg8::Sched<S_ / 256, DM / 256, 1, false> S; S.init(F.G, b_);
            EpiBf16 E{(gbf*)(w_ + WS_Y2), DM, 0, 1.f};
            pg8::gemm_phase<DFF, DFF, DFF, 0, 0>(F.lds, F.tid, (const gbf*)(w_ + WS_HID), (const gbf*)(w_ + WS_WDN), S, E);
            SEAM();
        }
        if (IN(16)) { PHASE_BEGIN();
            const gfl* gpre = (l + 1 < NL) ? INP(I_LN_MIX_PRE) + (size_t)(l + 1) * DM : (const gfl*)nullptr;
#pragma unroll 1
            for (int m = F.gw; m < S_; m += F.NGW) resid_row(X + (size_t)m * DM, X + (size_t)m * DM, (const gbf*)(w_ + WS_Y2) + (size_t)m * DM, INP(I_LN_FFN_POST) + (size_t)l * DM, gpre, H + (size_t)m * DM, F.lane);
            if (l + 1 < launder_int(l_hi)) SEAM();
        }
    }

    if (launder_int(l_lo) <= 3 && 3 < launder_int(l_hi)) { constexpr int l = 3;
        if (IN(2)) { PHASE_BEGIN();
            if (F.tid == 0) { LAS TrDesc* tab = (LAS TrDesc*)(F.lds + TR_TAB_OFF); int nd = launder_int(0), total = launder_int(0); const gfl* nul = nullptr;
                TR_PUT(INP(I_W_IN) + (size_t)l * DM * INW, DM, INW, (gbf*)(w_ + WS_WIN), DM, 1, 0, nul);
                TR_PUT(INP(I_W_BR_ATTN) + (size_t)l * NSAW * DM, NSAW, DM, (gbf*)(w_ + WS_WBRA), NSAW, 0, 0, nul);
                TR_PUT(INP(I_W_BR_POOL) + (size_t)l * POOLW * DM, POOLW, DM, (gbf*)(w_ + WS_WBRP), POOLW, 0, 0, nul);
                TR_PUT(INP(I_W_MIX_OUT) + (size_t)l * DM * DM, DM, DM, (gbf*)(w_ + WS_WMIX), DM, 0, 0, nul);
                TR_PUT(INP(I_W_XQ) + (size_t)l * DM * XW, DM, XW, (gbf*)(w_ + WS_WXQ), DM, 0, 0, nul);
                TR_PUT(INP(I_W_XO) + (size_t)l * XW * DM, XW, DM, (gbf*)(w_ + WS_WXO), XW, 0, 0, nul);
                TR_PUT(INP(I_W_GATE) + (size_t)l * DM * DFF, DM, DFF, (gbf*)(w_ + WS_WGU), DM, 2, 0, nul);
                TR_PUT(INP(I_W_UP) + (size_t)l * DM * DFF, DM, DFF, (gbf*)(w_ + WS_WGU), DM, 2, 128, nul);
                TR_PUT(INP(I_W_DOWN) + (size_t)l * DFF * DM, DFF, DM, (gbf*)(w_ + WS_WDN), DFF, 0, 0, nul);
                for (int q = 0; q < 4; ++q) { const int kv = q >> 1, half = q & 1;
                    TR_PUT(INP(I_CMP_W1) + (((size_t)l * 2 + kv) * 2048 + half * 1024) * 128, 1024, 128, (gbf*)(w_ + WS_WC1) + (size_t)kv * 256 * 1024, 1024, 0, half * 128, nul); }
                for (int gi = 0; gi < 4; ++gi)
                    TR_PUT(INP(I_W_POOL) + ((size_t)l * 4 + gi) * 65536, 256, 256, (gbf*)(w_ + WS_WPOOL) + (size_t)gi * 65536, 256, 0, 0, INP(I_POOL_SCALE) + (size_t)l * POOLW + gi * 256);
                trn[0] = nd; trn[1] = total; }
            LDS_WAIT(); __syncthreads();
            if (F.gw < 32) {
                const int p = F.gw >> 2, kv = (F.gw >> 1) & 1, j = (F.gw & 1) * 64 + F.lane;
                const gfl* pe = INP(I_CMP_PE) + ((size_t)l * 2 + kv) * 2048 + p * 256; const gfl* w1 = INP(I_CMP_W1) + (((size_t)l * 2 + kv) * 2048 + p * 256) * 128 + j;
                float a = 0.f;
#pragma unroll 8
                for (int k = 0; k < 256; ++k) a += pe[k] * w1[(size_t)k * 128];
                ((gfl*)(w_ + WS_PEB))[p * 256 + kv * 128 + j] = a;
            }
            tr_run(F, trn[0], trn[1]);
            __syncthreads();
            SEAM();
        }
        if (IN(3)) { PHASE_BEGIN();
            pg8::Sched<S_ / 256, ZN / 256, 1, false> S; S.init(F.G, b_);
            EpiZ E{w_};
            pg8::gemm_phase<DM, DM, DM, 0, 0>(F.lds, F.tid, H, (const gbf*)(w_ + WS_WIN), S, E);
            SEAM();
        }
        if (IN(4)) { PHASE_BEGIN();
#pragma unroll 1
            for (int it = F.gw; it < 2 * S_; it += F.NGW) pool_item((const gbf*)(w_ + WS_U), (gbf*)(w_ + WS_YP), it, F.lane);
            __syncthreads();
            pg8::Sched<16, 1, 2, false> S; S.init(F.G, b_);
            EpiF32 E{(gfl*)(w_ + WS_PQ), 256, (size_t)4096 * 256};
            pg8::gemm_phase<1024, 1024, 1024, (long)(WS_VCR - WS_KCR) / 2, (long)256 * 1024>(F.lds, F.tid, (const gbf*)(w_ + WS_KCR), (const gbf*)(w_ + WS_WC1), S, E);
            SEAM();
        }
        if (IN(5)) { PHASE_BEGIN();
            LAS float* hid = (LAS float*)(F.lds + F.wave * 1024);
#pragma unroll 1
            for (int it = F.gw; it < 8192; it += F.NGW) cmp_final_item((const gfl*)(w_ + WS_PQ), (const gfl*)(w_ + WS_PEB), INP(I_CMP_W2) + (size_t)l * 2 * 128 * 64, (gbf*)(w_ + WS_KC), (gbf*)(w_ + WS_VCT), hid, it, F.lane);
            __syncthreads();
            pg8::Sched<S_ / 256, 1, 4, false> S; S.init(F.G, b_);
            EpiBf16 E{(gbf*)(w_ + WS_P), POOLW, 256, 1.f};
            pg8::gemm_phase<POOLW, 256, 256, 256, 65536>(F.lds, F.tid, (const gbf*)(w_ + WS_YP), (const gbf*)(w_ + WS_WPOOL), S, E);
            SEAM();
        }
        if (IN(6)) { PHASE_BEGIN();
            attn_setup_tables(F, INP(I_RELB));
            const AttnPtrs P{(const gbf*)(w_ + WS_Q), (const gbf*)(w_ + WS_KC), (const gbf*)(w_ + WS_VCT), (const gbf*)(w_ + WS_KSEL), (const gbf*)(w_ + WS_VSELT), (const gbf*)(w_ + WS_KWIN), (const gbf*)(w_ + WS_VWINT),
                             (const gfl*)(w_ + WS_GL), (gbf*)(w_ + WS_A)};
#pragma unroll 1
            for (int it = F.gw; it < (S_ / 4) * NGRP; it += F.NGW) nsa_unit_v1(F, P, it >> 2, it & 3);
            __syncthreads();
            SEAM();
        }
        if (IN(7)) { PHASE_BEGIN();
            pg8::Sched<S_ / 256, DM / 256, 2, true> S; S.init(F.G, b_);
            EpiMerge E{(gbf*)(w_ + WS_Y1), (const gbf*)(w_ + WS_MG)};
            pg8::gemm_phase<NSAW, NSAW, NSAW, (long)(WS_P - WS_A) / 2, (long)(WS_WBRP - WS_WBRA) / 2>(F.lds, F.tid, (const gbf*)(w_ + WS_A), (const gbf*)(w_ + WS_WBRA), S, E);
            SEAM();
        }
        if (IN(8)) { PHASE_BEGIN();
            pg8::Sched<S_ / 256, DM / 256, 1, false> S; S.init(F.G, b_);
            EpiBf16 E{(gbf*)(w_ + WS_Y2), DM, 0, 1.f};
            pg8::gemm_phase<DM, DM, DM, 0, 0>(F.lds, F.tid, (const gbf*)(w_ + WS_Y1), (const gbf*)(w_ + WS_WMIX), S, E);
            SEAM();
        }
        if (IN(9)) { PHASE_BEGIN();
#pragma unroll 1
            for (int m = F.gw; m < S_; m += F.NGW) resid_row(X + (size_t)m * DM, X + (size_t)m * DM, (const gbf*)(w_ + WS_Y2) + (size_t)m * DM, INP(I_LN_MIX_POST) + (size_t)l * DM, INP(I_LN_X_PRE) + (size_t)l * DM, H + (size_t)m * DM, F.lane);
            SEAM();
        }
        if (IN(10)) { PHASE_BEGIN();
            pg8::Sched<S_ / 256, XW / 256, 1, false> S; S.init(F.G, b_);
            EpiBf16 E{(gbf*)(w_ + WS_Q2), XW, 0, 1.f};
            pg8::gemm_phase<DM, DM, DM, 0, 0>(F.lds, F.tid, H, (const gbf*)(w_ + WS_WXQ), S, E);
            SEAM();
        }
        if (IN(11)) { PHASE_BEGIN();
#pragma unroll 1
            for (int it = F.gw; it < (S_ / 16) * 4; it += F.NGW) xattn_unit_v1(F, (const gbf*)(w_ + WS_Q2), (const gbf*)(w_ + WS_KM) + (size_t)l * NMEM * XW, (const gbf*)(w_ + WS_VMT) + (size_t)l * XW * NMEM, (gbf*)(w_ + WS_O2), it >> 2, it & 3);
            SEAM();
        }
        if (IN(12)) { PHASE_BEGIN();
            pg8::Sched<S_ / 256, DM / 256, 1, false> S; S.init(F.G, b_);
            EpiBf16 E{(gbf*)(w_ + WS_Y2), DM, 0, 1.f};
            pg8::gemm_phase<XW, XW, XW, 0, 0>(F.lds, F.tid, (const gbf*)(w_ + WS_O2), (const gbf*)(w_ + WS_WXO), S, E);
            SEAM();
        }
        if (IN(13)) { PHASE_BEGIN();
#pragma unroll 1
            for (int m = F.gw; m < S_; m += F.NGW) resid_row(X + (size_t)m * DM, X + (size_t)m * DM, (const gbf*)(w_ + WS_Y2) + (size_t)m * DM, INP(I_LN_X_POST) + (size_t)l * DM, INP(I_LN_FFN_PRE) + (size_t)l * DM, H + (size_t)m * DM, F.lane);
            SEAM();
        }
        if (IN(14)) { PHASE_BEGIN();
            pg8::Sched<S_ / 256, 2 * DFF / 256, 1, false> S; S.init(F.G, b_);
            EpiSwiGLU E{(gbf*)(w_ + WS_HID)};
            pg8::gemm_phase<DM, DM, DM, 0, 0>(F.lds, F.tid, H, (const gbf*)(w_ + WS_WGU), S, E);
            SEAM();
        }
        if (IN(15)) { PHASE_BEGIN();
            pg8::Sched<S_ / 256, DM / 256, 1, false> S; S.init(F.G, b_);
            EpiBf16 E{(gbf*)(w_ + WS_Y2), DM, 0, 1.f};
            pg8::gemm_phase<DFF, DFF, DFF, 0, 0>(F.lds, F.tid, (const gbf*)(w_ + WS_HID), (const gbf*)(w_ + WS_WDN), S, E);
            SEAM();
        }
        if (IN(16)) { PHASE_BEGIN();
            const gfl* gpre = (l + 1 < NL) ? INP(I_LN_MIX_PRE) + (size_t)(l + 1) * DM : (const gfl*)nullptr;
#pragma unroll 1
            for (int m = F.gw; m < S_; m += F.NGW) resid_row(X + (size_t)m * DM, X + (size_t)m * DM, (const gbf*)(w_ + WS_Y2) + (size_t)m * DM, INP(I_LN_FFN_POST) + (size_t)l * DM, gpre, H + (size_t)m * DM, F.lane);
            if (l + 1 < launder_int(l_hi)) SEAM();
        }
    }

#ifdef MK_DEBUG_DUMP
    if (args.pad > 0) {
        const gbf* src = (const gbf*)(ws + (size_t)args.pad * MiB);
        for (size_t i = (size_t)blockIdx.x * 512 + threadIdx.x; i < (size_t)S_ * DM; i += (size_t)gridDim.x * 512) X[i] = bf2f(src[i]);
    }
#endif
#undef IN
#undef SEAM
}

#ifndef MK_PER_PHASE
#define MK_PER_PHASE 0
#endif
extern "C" void kernel_launch(void* const* d_in, const int* in_sizes, int n_in, void* d_out, int out_size, void* d_ws, size_t ws_size, hipStream_t stream) {
    static int grid = 0;
    if (grid == 0) {
        if (n_in != 25 || out_size != S_ * DM || ws_size < WS_END) { fprintf(stderr, "kernel_launch: unexpected shapes (n_in %d, out %d, ws %zu, need %zu)\n", n_in, out_size, ws_size, (size_t)WS_END); grid = -1; return; }
        int dev = 0, cus = 0, per_cu = 0;
        if (hipGetDevice(&dev) != hipSuccess || hipDeviceGetAttribute(&cus, hipDeviceAttributeMultiprocessorCount, dev) != hipSuccess) { grid = -1; return; }
        if (hipFuncSetAttribute((const void*)mega_fwd, hipFuncAttributeMaxDynamicSharedMemorySize, LDS_BYTES) != hipSuccess) { fprintf(stderr, "kernel_launch: hipFuncSetAttribute failed\n"); grid = -1; return; }
        if (hipOccupancyMaxActiveBlocksPerMultiprocessor(&per_cu, (const void*)mega_fwd, NWAVES * 64, LDS_BYTES) != hipSuccess || per_cu < 1) { fprintf(stderr, "kernel_launch: occupancy query says %d\n", per_cu); (void)hipGetLastError(); grid = -1; return; }
        grid = cus;
    }
    if (grid < 0) return;
#ifdef MK_DEBUG_DUMP
    (void)hipMemsetAsync((char*)d_ws, 0xAA, WS_END, stream);
    (void)hipMemsetAsync((char*)d_out, 0xAA, (size_t)out_size * 4, stream);
#endif
    (void)hipMemsetAsync((char*)d_ws + WS_CTL, 0, CTL_ZERO_BYTES, stream);
    Args a{};
    for (int i = 0; i < 25; ++i) a.in[i] = (const float*)d_in[i];
    a.out = (float*)d_out; a.ws = (unsigned char*)d_ws; a.pad = 0;
#ifdef MK_DEBUG_DUMP
    a.use_bar = 0;
    for (int ph = 0; ph < 2; ++ph) { a.l_lo = 0; a.l_hi = 1; a.ph_lo = ph; a.ph_hi = ph + 1; hipLaunchKernelGGL(mega_fwd, dim3(grid), dim3(NWAVES * 64), LDS_BYTES, stream, a); }
    for (int ph = 2; ph <= MK_DEBUG_LASTPH; ++ph) { if (ph == 6) continue; a.l_lo = 0; a.l_hi = 1; a.ph_lo = ph; a.ph_hi = ph + 1; hipLaunchKernelGGL(mega_fwd, dim3(grid), dim3(NWAVES * 64), LDS_BYTES, stream, a); }
    a.l_lo = 0; a.l_hi = 0; a.ph_lo = 30; a.ph_hi = 31; a.pad = MK_DEBUG_DUMP; hipLaunchKernelGGL(mega_fwd, dim3(grid), dim3(NWAVES * 64), LDS_BYTES, stream, a);
#elif MK_PER_PHASE
    a.use_bar = 0;
    for (int ph = 0; ph < 2; ++ph) { a.l_lo = 0; a.l_hi = 1; a.ph_lo = ph; a.ph_hi = ph + 1; hipLaunchKernelGGL(mega_fwd, dim3(grid), dim3(NWAVES * 64), LDS_BYTES, stream, a); }
    for (int l = 0; l < NL; ++l)
        for (int ph = 2; ph < NPHASE; ++ph) { a.l_lo = l; a.l_hi = l + 1; a.ph_lo = ph; a.ph_hi = ph + 1; hipLaunchKernelGGL(mega_fwd, dim3(grid), dim3(NWAVES * 64), LDS_BYTES, stream, a); }
#else
    a.use_bar = 1; a.l_lo = 0; a.l_hi = NL; a.ph_lo = 0; a.ph_hi = NPHASE;
    hipLaunchKernelGGL(mega_fwd, dim3(grid), dim3(NWAVES * 64), LDS_BYTES, stream, a);
#endif
}
```

```cpp
#include <hip/hip_runtime.h>
#include <cstdio>
#include <cstdint>
namespace pg8 {
#define PG8_LAS __attribute__((address_space(3)))
#define PG8_GAS __attribute__((address_space(1)))
typedef unsigned short bf16_t;
typedef short bf16x8 __attribute__((ext_vector_type(8)));
typedef float f32x4 __attribute__((ext_vector_type(4)));
typedef float f32x2 __attribute__((ext_vector_type(2)));
typedef unsigned u32x4 __attribute__((ext_vector_type(4)));
typedef unsigned u32x2 __attribute__((ext_vector_type(2)));
constexpr int BM = 256, BK = 64, HALF = 128, HTB = HALF * BK * 2  , STAGE_BYTES = 8 * HTB, NXCD = 8, WGM = 8;

__host__ __device__ __forceinline__ int lds_byte(int r, int c) { const int st = (r >> 4) * 2 + (c >> 5), rr = r & 15, cc = c & 31, ob = rr * 64 + cc * 2; return st * 1024 + (ob ^ (((ob >> 9) & 1) << 5)); }
__host__ __device__ __forceinline__ void stage_rc(int b, int& R, int& C) { const int st = b / 1024, sb = b % 1024, swz = sb ^ (((sb >> 9) & 1) << 5); R = (st >> 1) * 16 + swz / 64; C = (st & 1) * 32 + (swz % 64) / 2; }
__host__ __device__ __forceinline__ int perm32(int rho) { const int n = rho >> 4, i = rho & 15; return 8 * (i >> 2) + 4 * n + (i & 3); }

struct Unit { int pm, pn, sel; };


template <int NM, int NN, int NSEL, bool INNER>
struct Sched {
    int G, c;
    __device__ __forceinline__ void init(int G_, int c_) { G = G_; c = c_; }
    __device__ __forceinline__ bool next(int i, Unit& u) const {
        constexpr int nwg = NM * NN;
        long L; int sel;
        if (INNER) { L = (long)(i / NSEL) * G + c; sel = i % NSEL; if (L >= nwg) return false; }
        else { const long LL = (long)i * G + c; if (LL >= (long)nwg * NSEL) return false; sel = (int)(LL / nwg); L = LL % nwg; }
        int wgid = (int)L; { constexpr int q = nwg / NXCD, r = nwg % NXCD; const int xcd = wgid % NXCD, off = wgid / NXCD; wgid = (xcd < r ? xcd * (q + 1) : r * (q + 1) + (xcd - r) * q) + off; }
        constexpr int nig = WGM * NN; const int gid = wgid / nig, fm = gid * WGM, gsz = (NM - fm) < WGM ? (NM - fm) : WGM;
        u.pm = fm + ((wgid % nig) % gsz); u.pn = (wgid % nig) / gsz; u.sel = sel; return true;
    }
};

template <int NM>
struct SchedPanel {
    int G, c;
    __device__ __forceinline__ void init(int G_, int c_) { G = G_; c = c_; }
    __device__ __forceinline__ bool next(int i, Unit& u) const {
        const int xcd = c & 7, j = c >> 3, ppx = G >> 6;
        const int pm = i * (G >> 3) + xcd * ppx + (j >> 3);
        if (pm >= NM) return false;
        u.pm = pm; u.pn = j & 7; u.sel = 0; return true;
    }
};

typedef __bf16 bf16x2_t __attribute__((ext_vector_type(2)));
__device__ __forceinline__ unsigned cvt_pk_bf16(float lo, float hi) { const f32x2 v = {lo, hi}; const bf16x2_t b = __builtin_convertvector(v, bf16x2_t); return __builtin_bit_cast(unsigned, b); }

template <int LDA, int LDB, int K, long ASEL, long BSEL, class Epi, class SchedT>
__device__ __forceinline__ void gemm_phase(PG8_LAS unsigned char* lds, int tid, const PG8_GAS bf16_t* gA, const PG8_GAS bf16_t* gBt, const SchedT& S, const Epi& E) {
    const int wid = __builtin_amdgcn_readfirstlane(tid >> 6), lane = tid & 63, wr = wid >> 2, wc = wid & 3, fr = lane & 15, fq = lane >> 4;
    constexpr int nt = K / BK;
    unsigned voffA[2], voffB[2];
#pragma unroll
    for (int i = 0; i < 2; ++i) { int R, C; stage_rc(tid * 16 + i * 8192, R, C); const int Rb = Epi::PERM ? ((R & ~31) + perm32(R & 31)) : R;
        voffA[i] = (unsigned)(R * LDA + C) * 2u; voffB[i] = (unsigned)(Rb * LDB + C) * 2u; }
    constexpr size_t kstep = (size_t)(BK * 2);
    constexpr size_t hstepA = (size_t)HALF * LDA * 2, hstepB = (size_t)HALF * LDB * 2;
    constexpr size_t tstepA = 2 * hstepA, tstepB = 2 * hstepB;
    const unsigned ldsw = (unsigned)wid * 1024u;
    const int aoff = lds_byte(wr * 64 + fr, fq * 8), boff = lds_byte(wc * 32 + fr, fq * 8);
#define PG8_SA(b, h) (((b) * 2 + (h)) * HTB)
#define PG8_SB(b, h) ((4 + (b) * 2 + (h)) * HTB)
#define PG8_STAGE(bufoff, gbase, voff) do { _Pragma("unroll") for (int _i = 0; _i < 2; ++_i) \
        __builtin_amdgcn_global_load_lds((const PG8_GAS unsigned*)((const PG8_GAS char*)(gbase) + (voff)[_i]), (PG8_LAS unsigned*)(lds + (bufoff) + ldsw + _i * 8192), 16, 0, 0); } while (0)
#define PG8_LDA(dst, b, h) do { _Pragma("unroll") for (int m = 0; m < 4; ++m) _Pragma("unroll") for (int k = 0; k < 2; ++k) dst[m][k] = *(const PG8_LAS bf16x8*)(lds + PG8_SA(b, h) + aoff + m * 2048 + k * 1024); } while (0)
#define PG8_LDB(dst, b, h) do { _Pragma("unroll") for (int n = 0; n < 2; ++n) _Pragma("unroll") for (int k = 0; k < 2; ++k) dst[n][k] = *(const PG8_LAS bf16x8*)(lds + PG8_SB(b, h) + boff + n * 2048 + k * 1024); } while (0)
#define PG8_MMA(ai, bj, At, Bt) do { __builtin_amdgcn_s_setprio(1); _Pragma("unroll") for (int m = 0; m < 4; ++m) _Pragma("unroll") for (int n = 0; n < 2; ++n) _Pragma("unroll") for (int k = 0; k < 2; ++k) \
        acc[ai][bj][m][n] = __builtin_amdgcn_mfma_f32_16x16x32_bf16(Bt[n][k], At[m][k], acc[ai][bj][m][n], 0, 0, 0); __builtin_amdgcn_s_setprio(0); } while (0)
#define PG8_WAIT_V(n) asm volatile("s_waitcnt vmcnt(" #n ")" ::: "memory")
#define PG8_WAIT_L(n) asm volatile("s_waitcnt lgkmcnt(" #n ")" ::: "memory")
#define PG8_BAR __builtin_amdgcn_s_barrier()
#define PG8_SCHED __builtin_amdgcn_sched_barrier(0)
    Unit cur, nxt; int ui = 0;
    if (!S.next(0, cur)) return;
    f32x4 acc[2][2][4][2];
#pragma unroll
    for (int a = 0; a < 2; ++a)
#pragma unroll
        for (int b = 0; b < 2; ++b)
#pragma unroll
            for (int m = 0; m < 4; ++m)
#pragma unroll
                for (int n = 0; n < 2; ++n) acc[a][b][m][n] = (f32x4){0.f, 0.f, 0.f, 0.f};
    bf16x8 At[4][2], B0[2][2], B1[2][2];
    const PG8_GAS char* cA = (const PG8_GAS char*)(gA + (size_t)cur.sel * ASEL) + (size_t)cur.pm * tstepA; const PG8_GAS char* cB = (const PG8_GAS char*)(gBt + (size_t)cur.sel * BSEL) + (size_t)cur.pn * tstepB;
    PG8_STAGE(PG8_SB(0, 0), cB, voffB); PG8_STAGE(PG8_SB(0, 1), cB + hstepB, voffB); PG8_STAGE(PG8_SA(0, 0), cA, voffA); PG8_STAGE(PG8_SA(0, 1), cA + hstepA, voffA);
    if (wr == 1) PG8_BAR;
    PG8_WAIT_V(2); PG8_BAR;
    PG8_STAGE(PG8_SB(1, 0), cB + kstep, voffB); PG8_STAGE(PG8_SA(1, 0), cA + kstep, voffA); PG8_STAGE(PG8_SB(1, 1), cB + hstepB + kstep, voffB);
    PG8_WAIT_V(6); PG8_BAR;
    for (;;) {
        const bool has_next = S.next(ui + 1, nxt);
        const PG8_GAS char* nA = has_next ? (const PG8_GAS char*)(gA + (size_t)nxt.sel * ASEL) + (size_t)nxt.pm * tstepA : cA; const PG8_GAS char* nB = has_next ? (const PG8_GAS char*)(gBt + (size_t)nxt.sel * BSEL) + (size_t)nxt.pn * tstepB : cB;
#pragma unroll 1
        for (int t = 0; t < nt; t += 2) {
            const bool last = (t == nt - 2);
            const PG8_GAS char* a1 = cA + (size_t)(t + 1) * kstep;
            const PG8_GAS char* a2 = last ? nA : cA + (size_t)(t + 2) * kstep; const PG8_GAS char* b2 = last ? nB : cB + (size_t)(t + 2) * kstep;
            const PG8_GAS char* a3 = a2 + kstep; const PG8_GAS char* b3 = b2 + kstep;
            PG8_LDB(B0, 0, 0); PG8_LDB(B1, 0, 1); PG8_SCHED; PG8_LDA(At, 0, 0); PG8_STAGE(PG8_SA(1, 1), a1 + hstepA, voffA);
            PG8_WAIT_V(8); PG8_WAIT_L(0); PG8_BAR; PG8_MMA(0, 0, At, B0); PG8_MMA(0, 1, At, B1); PG8_BAR; PG8_SCHED;
            PG8_LDA(At, 0, 1); PG8_STAGE(PG8_SB(0, 0), b2, voffB); PG8_STAGE(PG8_SB(0, 1), b2 + hstepB, voffB); PG8_STAGE(PG8_SA(0, 0), a2, voffA);
            PG8_WAIT_V(8); PG8_WAIT_L(0); PG8_BAR; PG8_MMA(1, 0, At, B0); PG8_MMA(1, 1, At, B1); PG8_BAR; PG8_SCHED;
            PG8_LDB(B0, 1, 0); PG8_LDB(B1, 1, 1); PG8_SCHED; PG8_LDA(At, 1, 0); PG8_STAGE(PG8_SA(0, 1), a2 + hstepA, voffA);
            PG8_WAIT_V(8); PG8_WAIT_L(0); PG8_BAR; PG8_MMA(0, 0, At, B0); PG8_MMA(0, 1, At, B1); PG8_BAR; PG8_SCHED;
            PG8_LDA(At, 1, 1); PG8_STAGE(PG8_SB(1, 0), b3, voffB); PG8_STAGE(PG8_SB(1, 1), b3 + hstepB, voffB); PG8_STAGE(PG8_SA(1, 0), a3, voffA);
            PG8_WAIT_V(8); PG8_WAIT_L(0); PG8_BAR; PG8_MMA(1, 0, At, B0); PG8_MMA(1, 1, At, B1); PG8_BAR; PG8_SCHED;
        }
        if (wr == 0) PG8_BAR;
        E(acc, cur, wr, wc, fr, fq);
        if (!has_next) break;
#pragma unroll
        for (int a = 0; a < 2; ++a)
#pragma unroll
            for (int b = 0; b < 2; ++b)
#pragma unroll
                for (int m = 0; m < 4; ++m)
#pragma unroll
                    for (int n = 0; n < 2; ++n) acc[a][b][m][n] = (f32x4){0.f, 0.f, 0.f, 0.f};
        cur = nxt; cA = nA; cB = nB; ++ui;
        if (wr == 1) PG8_BAR;
    }
    PG8_WAIT_V(0);
    PG8_BAR;
#undef PG8_SA
#undef PG8_SB
#undef PG8_STAGE
#undef PG8_LDA
#undef PG8_LDB
#undef PG8_MMA
#undef PG8_WAIT_V
#undef PG8_WAIT_L
#undef PG8_BAR
#undef PG8_SCHED
}
}
constexpr int S_ = 16384, DM = 2048, NL = 4, NMEM = 256;
constexpr int NSAW = 1024, KVW = 256, HD = 64, NHEAD = 16, NGRP = 4;
constexpr int POOLW = 1024, DFF = 5632, XW = 512, XHD = 128;
constexpr int INW = 7728, ZN = 7936;
constexpr int NCMP = 1023;
constexpr float RMS_EPS = 1e-6f;
constexpr float LOG2E = 1.4426950408889634f;
constexpr float QSCALE = 0.125f * LOG2E;
constexpr float XSCALE = 0.08838834764831845f * LOG2E;

typedef unsigned short bf16;
typedef short bf16x8 __attribute__((ext_vector_type(8)));
typedef float f32x4 __attribute__((ext_vector_type(4)));
typedef float f32x2 __attribute__((ext_vector_type(2)));
typedef unsigned u32x4 __attribute__((ext_vector_type(4)));
typedef unsigned u32x2 __attribute__((ext_vector_type(2)));
#define GAS __attribute__((address_space(1)))
#define LAS __attribute__((address_space(3)))
typedef GAS unsigned short gbf;
typedef GAS float gfl;
typedef GAS unsigned char gby;

__device__ __forceinline__ unsigned f2bf(float f) { unsigned u = __builtin_bit_cast(unsigned, f); return (u + 0x7fffu + ((u >> 16) & 1u)) >> 16; }
__device__ __forceinline__ unsigned pk2(float lo, float hi) { return pg8::cvt_pk_bf16(lo, hi); }
__device__ __forceinline__ float bf2f(unsigned short b) { return __builtin_bit_cast(float, (unsigned)b << 16); }
__device__ __forceinline__ float bflo(unsigned w) { return __builtin_bit_cast(float, w << 16); }
__device__ __forceinline__ float bfhi(unsigned w) { return __builtin_bit_cast(float, w & 0xffff0000u); }
__device__ __forceinline__ float sigmoidf_(float x) { return __builtin_amdgcn_rcpf(1.f + __builtin_amdgcn_exp2f(-x * LOG2E)); }

constexpr size_t MiB = 1u << 20;
constexpr size_t WS_CTL = 0, CTL_ZERO_BYTES = 1 * MiB;
constexpr size_t WS_WIN = 1 * MiB;
constexpr size_t WS_WBRA = WS_WIN + 31 * MiB;
constexpr size_t WS_WBRP = WS_WBRA + 4 * MiB;
constexpr size_t WS_WMIX = WS_WBRP + 4 * MiB;
constexpr size_t WS_WXQ = WS_WMIX + 8 * MiB;
constexpr size_t WS_WXO = WS_WXQ + 2 * MiB;
constexpr size_t WS_WGU = WS_WXO + 2 * MiB;
constexpr size_t WS_WDN = WS_WGU + 44 * MiB;
constexpr size_t WS_WC1 = WS_WDN + 22 * MiB;
constexpr size_t WS_WPOOL = WS_WC1 + 1 * MiB;
constexpr size_t WS_PEB = WS_WPOOL + MiB / 2;
constexpr size_t WS_ACT = WS_PEB + MiB / 2;
constexpr size_t WS_H = WS_ACT;
constexpr size_t WS_Q = WS_H + 64 * MiB;
constexpr size_t WS_KCR = WS_Q + 32 * MiB;
constexpr size_t WS_VCR = WS_KCR + 8 * MiB;
constexpr size_t WS_KSEL = WS_VCR + 8 * MiB;
constexpr size_t WS_VSELT = WS_KSEL + 8 * MiB;
constexpr size_t WS_KWIN = WS_VSELT + 8 * MiB;
constexpr size_t WS_VWINT = WS_KWIN + 8 * MiB;
constexpr size_t WS_GL = WS_VWINT + 8 * MiB;
constexpr size_t WS_PQ = WS_GL + 3 * MiB;
constexpr size_t WS_KC = WS_PQ + 8 * MiB;
constexpr size_t WS_VCT = WS_KC + MiB / 2;
constexpr size_t WS_KM = WS_VCT + MiB / 2;
constexpr size_t WS_VMT = WS_KM + 1 * MiB;
constexpr size_t WS_Y1 = WS_VMT + 1 * MiB;
constexpr size_t WS_Y2 = WS_Y1 + 64 * MiB;
constexpr size_t WS_Q2 = WS_Y2 + 64 * MiB;
constexpr size_t WS_O2 = WS_Q2 + 16 * MiB;
constexpr size_t WS_BIG = WS_O2 + 16 * MiB;
constexpr size_t WS_MG = WS_BIG;
constexpr size_t WS_U = WS_MG + 128 * MiB;
constexpr size_t WS_A = WS_U + 32 * MiB;
constexpr size_t WS_P = WS_A + 32 * MiB;
constexpr size_t WS_YP = WS_P + 32 * MiB;
constexpr size_t WS_HID = WS_BIG;
constexpr size_t WS_WXKV_OLD = WS_BIG;
constexpr size_t WS_MEMN_OLD = WS_BIG + 16 * MiB;
constexpr size_t WS_XB = WS_BIG + 256 * MiB;
constexpr size_t WS_WXKV2 = WS_XB + 64 * MiB;
constexpr size_t WS_MEMN2 = WS_WXKV2 + 16 * MiB;
constexpr size_t WS_R = WS_MEMN2 + 4 * MiB;
constexpr size_t WS_END = WS_R + 1 * MiB;
static_assert(WS_HID + (size_t)S_ * DFF * 2 <= WS_P, "HID overlays MG | U | A only");

constexpr int CW_BAR = 4096;

using pg8::Unit; using pg8::HALF; using pg8::BM;
typedef pg8::f32x4 acc_t[2][2][4][2];

struct EpiBf16 {
    static constexpr bool PERM = true;
    gbf* O; int ldc; int selcol; float scale; const gfl* R = nullptr;
    __device__ __forceinline__ void operator()(const acc_t& acc, const Unit& u, int wr, int wc, int fr, int fq) const {
        const int row0 = u.pm * BM + wr * 64 + fr; const int col0 = u.sel * selcol + u.pn * BM + wc * 32 + 8 * fq;
#pragma unroll
        for (int ai = 0; ai < 2; ++ai)
#pragma unroll
            for (int m = 0; m < 4; ++m) { gbf* rowp = O + (size_t)(row0 + ai * HALF + m * 16) * ldc + col0; const float sc_ = R ? scale * R[row0 + ai * HALF + m * 16] : scale;
#pragma unroll
                for (int bj = 0; bj < 2; ++bj) { const f32x4 v0 = acc[ai][bj][m][0] * sc_, v1 = acc[ai][bj][m][1] * sc_;
                    u32x4 w; w.x = pk2(v0[0], v0[1]); w.y = pk2(v0[2], v0[3]); w.z = pk2(v1[0], v1[1]); w.w = pk2(v1[2], v1[3]);
                    *(GAS u32x4*)(rowp + bj * HALF) = w; } }
    }
};
struct EpiF32 {
    static constexpr bool PERM = false;
    gfl* O; int ldc; size_t selstride;
    __device__ __forceinline__ void operator()(const acc_t& acc, const Unit& u, int wr, int wc, int fr, int fq) const {
        const int row0 = u.pm * BM + wr * 64 + fr; const int col0 = u.pn * BM + wc * 32 + 4 * fq; gfl* base = O + (size_t)u.sel * selstride;
#pragma unroll
        for (int ai = 0; ai < 2; ++ai)
#pragma unroll
            for (int m = 0; m < 4; ++m) { gfl* rowp = base + (size_t)(row0 + ai * HALF + m * 16) * ldc + col0;
#pragma unroll
                for (int bj = 0; bj < 2; ++bj)
#pragma unroll
                    for (int n = 0; n < 2; ++n) *(GAS f32x4*)(rowp + bj * HALF + n * 16) = acc[ai][bj][m][n]; }
    }
};
struct EpiZ {
    static constexpr bool PERM = true;
    gby* ws;
    __device__ __forceinline__ void operator()(const acc_t& acc, const Unit& u, int wr, int wc, int fr, int fq) const {
        const int row0 = u.pm * BM + wr * 64 + fr; const int pn = u.pn;
        float rr[2][4];
#pragma unroll
        for (int ai = 0; ai < 2; ++ai)
#pragma unroll
            for (int m = 0; m < 4; ++m) rr[ai][m] = ((const gfl*)(ws + WS_R))[row0 + ai * HALF + m * 16];
        gbf* const Q = (gbf*)(ws + WS_Q); gbf* const U = (gbf*)(ws + WS_U); gbf* const MG = (gbf*)(ws + WS_MG); gfl* const GL = (gfl*)(ws + WS_GL);
        if (pn < 4 || (pn >= 10 && pn < 14)) {
            const bool isq = pn < 4; gbf* base = isq ? Q : U; const float sc = isq ? QSCALE : 1.f; const int col0 = (isq ? pn : pn - 10) * BM + wc * 32 + 8 * fq;
#pragma unroll
            for (int ai = 0; ai < 2; ++ai)
#pragma unroll
                for (int m = 0; m < 4; ++m) { gbf* rowp = base + (size_t)(row0 + ai * HALF + m * 16) * 1024 + col0;
#pragma unroll
                    for (int bj = 0; bj < 2; ++bj) { const f32x4 v0 = acc[ai][bj][m][0] * (sc * rr[ai][m]), v1 = acc[ai][bj][m][1] * (sc * rr[ai][m]);
                        u32x4 w; w.x = pk2(v0[0], v0[1]); w.y = pk2(v0[2], v0[3]); w.z = pk2(v1[0], v1[1]); w.w = pk2(v1[2], v1[3]);
                        *(GAS u32x4*)(rowp + bj * HALF) = w; } }
        } else if (pn == 4 || pn == 5 || pn == 6 || pn == 8) {
            gbf* base = (gbf*)(ws + (pn == 4 ? WS_KCR : pn == 5 ? WS_VCR : pn == 6 ? WS_KSEL : WS_KWIN));
            const int d0 = 32 * (wc & 1) + 8 * fq;
#pragma unroll
            for (int ai = 0; ai < 2; ++ai)
#pragma unroll
                for (int m = 0; m < 4; ++m) { const int row = row0 + ai * HALF + m * 16;
#pragma unroll
                    for (int bj = 0; bj < 2; ++bj) { const int g = 2 * bj + (wc >> 1); const f32x4 v0 = acc[ai][bj][m][0] * rr[ai][m], v1 = acc[ai][bj][m][1] * rr[ai][m];
                        u32x4 w; w.x = pk2(v0[0], v0[1]); w.y = pk2(v0[2], v0[3]); w.z = pk2(v1[0], v1[1]); w.w = pk2(v1[2], v1[3]);
                        *(GAS u32x4*)(base + ((size_t)g * S_ + row) * 64 + d0) = w; } }
        } else if (pn == 7 || pn == 9) {
            gbf* base = (gbf*)(ws + (pn == 7 ? WS_VSELT : WS_VWINT));
            const int d0 = 32 * (wc & 1) + 8 * fq;
#pragma unroll
            for (int ai = 0; ai < 2; ++ai)
#pragma unroll
                for (int m = 0; m < 4; ++m) { const int row = row0 + ai * HALF + m * 16;
#pragma unroll
                    for (int bj = 0; bj < 2; ++bj) { const int g = 2 * bj + (wc >> 1); gbf* p = base + ((size_t)g * 64 + d0) * S_ + row;
#pragma unroll
                        for (int n = 0; n < 2; ++n)
#pragma unroll
                            for (int e = 0; e < 4; ++e) p[(size_t)(4 * n + e) * S_] = (bf16)f2bf(acc[ai][bj][m][n][e] * rr[ai][m]); } }
        } else if (pn < 30) {
            const int col0 = (pn - 14) * BM + wc * 32 + 8 * fq;
#pragma unroll
            for (int ai = 0; ai < 2; ++ai)
#pragma unroll
                for (int m = 0; m < 4; ++m) { gbf* rowp = MG + (size_t)(row0 + ai * HALF + m * 16) * 4096 + col0;
#pragma unroll
                    for (int bj = 0; bj < 2; ++bj) { const f32x4 a0 = acc[ai][bj][m][0] * rr[ai][m], a1 = acc[ai][bj][m][1] * rr[ai][m];
                        u32x4 w; w.x = pk2(sigmoidf_(a0[0]), sigmoidf_(a0[1])); w.y = pk2(sigmoidf_(a0[2]), sigmoidf_(a0[3])); w.z = pk2(sigmoidf_(a1[0]), sigmoidf_(a1[1])); w.w = pk2(sigmoidf_(a1[2]), sigmoidf_(a1[3]));
                        *(GAS u32x4*)(rowp + bj * HALF) = w; } }
        } else {
            const int col0 = wc * 32 + 8 * fq;
            if (col0 < 48) {
#pragma unroll
                for (int ai = 0; ai < 2; ++ai)
#pragma unroll
                    for (int m = 0; m < 4; ++m) { gfl* rowp = GL + (size_t)(row0 + ai * HALF + m * 16) * 48 + col0;
                        const f32x4 a0 = acc[ai][0][m][0] * rr[ai][m], a1 = acc[ai][0][m][1] * rr[ai][m];
                        *(GAS f32x4*)rowp = (f32x4){sigmoidf_(a0[0]), sigmoidf_(a0[1]), sigmoidf_(a0[2]), sigmoidf_(a0[3])};
                        *(GAS f32x4*)(rowp + 4) = (f32x4){sigmoidf_(a1[0]), sigmoidf_(a1[1]), sigmoidf_(a1[2]), sigmoidf_(a1[3])}; }
            }
        }
    }
};
struct EpiMerge {
    static constexpr bool PERM = true;
    gbf* Y1; const gbf* MG;
    __device__ __forceinline__ void operator()(const acc_t& acc, const Unit& u, int wr, int wc, int fr, int fq) const {
        const int row0 = u.pm * BM + wr * 64 + fr; const int col0 = u.pn * BM + wc * 32 + 8 * fq;
#pragma unroll
        for (int ai = 0; ai < 2; ++ai)
#pragma unroll
            for (int m = 0; m < 4; ++m) { const int row = row0 + ai * HALF + m * 16; gbf* yp = Y1 + (size_t)row * DM + col0; const gbf* gp = MG + (size_t)row * 4096 + u.sel * 2048 + col0;
#pragma unroll
                for (int bj = 0; bj < 2; ++bj) { const u32x4 gw = *(const GAS u32x4*)(gp + bj * HALF); const f32x4 a0 = acc[ai][bj][m][0], a1 = acc[ai][bj][m][1];
                    float v[8] = {a0[0] * bflo(gw.x), a0[1] * bfhi(gw.x), a0[2] * bflo(gw.y), a0[3] * bfhi(gw.y), a1[0] * bflo(gw.z), a1[1] * bfhi(gw.z), a1[2] * bflo(gw.w), a1[3] * bfhi(gw.w)};
                    if (u.sel) { const u32x4 yw = *(const GAS u32x4*)(yp + bj * HALF);
                        v[0] += bflo(yw.x); v[1] += bfhi(yw.x); v[2] += bflo(yw.y); v[3] += bfhi(yw.y); v[4] += bflo(yw.z); v[5] += bfhi(yw.z); v[6] += bflo(yw.w); v[7] += bfhi(yw.w); }
                    u32x4 w; w.x = pk2(v[0], v[1]); w.y = pk2(v[2], v[3]); w.z = pk2(v[4], v[5]); w.w = pk2(v[6], v[7]);
                    *(GAS u32x4*)(yp + bj * HALF) = w; } }
    }
};
struct EpiSwiGLU {
    static constexpr bool PERM = true;
    gbf* Hd; const gfl* R;
    __device__ __forceinline__ void operator()(const acc_t& acc, const Unit& u, int wr, int wc, int fr, int fq) const {
        const int row0 = u.pm * BM + wr * 64 + fr; const int col0 = u.pn * 128 + wc * 32 + 8 * fq;
#pragma unroll
        for (int ai = 0; ai < 2; ++ai)
#pragma unroll
            for (int m = 0; m < 4; ++m) { gbf* rowp = Hd + (size_t)(row0 + ai * HALF + m * 16) * DFF + col0; float v[8]; const float rr = R[row0 + ai * HALF + m * 16];
#pragma unroll
                for (int n = 0; n < 2; ++n)
#pragma unroll
                    for (int e = 0; e < 4; ++e) { const float gx = acc[ai][0][m][n][e] * rr, ux = acc[ai][1][m][n][e] * rr; v[4 * n + e] = gx * sigmoidf_(gx) * ux; }
                u32x4 w; w.x = pk2(v[0], v[1]); w.y = pk2(v[2], v[3]); w.z = pk2(v[4], v[5]); w.w = pk2(v[6], v[7]);
                *(GAS u32x4*)rowp = w; }
    }
};
struct EpiKVmem {
    static constexpr bool PERM = true;
    gbf *KM, *VMT;
    __device__ __forceinline__ void operator()(const acc_t& acc, const Unit& u, int wr, int wc, int fr, int fq) const {
        const int row0 = wr * 64 + fr; const int l = u.sel;
        if (u.pn < 2) {
            const int col0 = u.pn * BM + wc * 32 + 8 * fq;
#pragma unroll
            for (int ai = 0; ai < 2; ++ai)
#pragma unroll
                for (int m = 0; m < 4; ++m) { gbf* rowp = KM + ((size_t)l * NMEM + row0 + ai * HALF + m * 16) * XW + col0;
#pragma unroll
                    for (int bj = 0; bj < 2; ++bj) { const f32x4 v0 = acc[ai][bj][m][0] * XSCALE, v1 = acc[ai][bj][m][1] * XSCALE;
                        u32x4 w; w.x = pk2(v0[0], v0[1]); w.y = pk2(v0[2], v0[3]); w.z = pk2(v1[0], v1[1]); w.w = pk2(v1[2], v1[3]);
                        *(GAS u32x4*)(rowp + bj * HALF) = w; } }
        } else {
            const int col0 = (u.pn - 2) * BM + wc * 32 + 8 * fq;
#pragma unroll
            for (int ai = 0; ai < 2; ++ai)
#pragma unroll
                for (int m = 0; m < 4; ++m) { const int row = row0 + ai * HALF + m * 16;
#pragma unroll
                    for (int bj = 0; bj < 2; ++bj) { gbf* p = VMT + ((size_t)l * XW + col0 + bj * HALF) * NMEM + row;
#pragma unroll
                        for (int n = 0; n < 2; ++n)
#pragma unroll
                            for (int e = 0; e < 4; ++e) p[(size_t)(4 * n + e) * NMEM] = (bf16)f2bf(acc[ai][bj][m][n][e]); } }
        }
    }
};
constexpr int RING_BYTES = 131072;
constexpr int LDSCTL_OFF = RING_BYTES, MISC_OFF = LDSCTL_OFF + 320;
constexpr int LDS_BYTES = 147456;
constexpr int NWAVES = 8;

typedef GAS unsigned gu32;
#define RLX_AGENT __ATOMIC_RELAXED, __HIP_MEMORY_SCOPE_AGENT
#define LDS_WAIT() asm volatile("s_waitcnt lgkmcnt(0)" ::: "memory")
#define VM_WAIT() asm volatile("s_waitcnt vmcnt(0)" ::: "memory")

#define XB_TMO      128
#define XB_XCNT(j)  (256  + 64 * (j))
#define XB_XSUB(j)  (1280 + 64 * (j))
#define XB_XGEN(j)  (2304 + 64 * (j))
#define XB_TOP      3328
#define XB_TOPGEN   3392
#define XCD_BAR_WORDS 3456
#define XB_SPIN_CAP (1u << 22)

__device__ __forceinline__ unsigned xb_ld(GAS unsigned* p)              { return __hip_atomic_load(p, __ATOMIC_RELAXED, __HIP_MEMORY_SCOPE_AGENT); }
__device__ __forceinline__ unsigned xb_add(GAS unsigned* p, unsigned v) { return __hip_atomic_fetch_add(p, v, __ATOMIC_RELAXED, __HIP_MEMORY_SCOPE_AGENT); }
__device__ __forceinline__ unsigned xb_xcc_id() { return (unsigned)__builtin_amdgcn_s_getreg((3 << 11) | 20) & 0xFu; }
#define XB_SPIN(cond, bar) do { unsigned _sp = 0; while (cond) { __builtin_amdgcn_s_sleep(1); \
    if ((++_sp & 255u) == 0u) { if (xb_ld(&(bar)[XB_TMO])) break; if (_sp > XB_SPIN_CAP) { (void)xb_add(&(bar)[XB_TMO], 1u); break; } } } } while (0)

struct XcdBarrier { GAS unsigned* bar; unsigned x; volatile LAS unsigned* st; };

__device__ __forceinline__ XcdBarrier xcd_barrier_post(GAS unsigned* bar, volatile LAS unsigned* st) {
    XcdBarrier b; b.bar = bar; b.x = xb_xcc_id(); b.st = st;
    if (threadIdx.x == 0) (void)xb_add(&bar[XB_XCNT(b.x)], 1u);
    return b;
}
__device__ __forceinline__ void xcd_barrier_complete(GAS unsigned* bar, unsigned x, unsigned& nloc, unsigned& nx) {
    const unsigned G = gridDim.x * gridDim.y * gridDim.z;
    unsigned sum, cnt, mine, sp = 0u;
    for (;;) {
        sum = 0u; cnt = 0u; mine = 0u;
#pragma unroll 1
        for (unsigned j = 0; j < 16; ++j) { const unsigned c = xb_ld(&bar[XB_XCNT(j)]); sum += c; cnt += (c > 0u) ? 1u : 0u; mine = (j == x) ? c : mine; }
        if (sum == G) break;
        __builtin_amdgcn_s_sleep(1);
        if ((++sp & 255u) == 0u) { if (xb_ld(&bar[XB_TMO])) break; if (sp > XB_SPIN_CAP) { (void)xb_add(&bar[XB_TMO], 1u); break; } }
    }
    nloc = mine > 0u ? mine : 1u; nx = cnt > 0u ? cnt : 1u;
}
__device__ __forceinline__ void xcd_barrier(const XcdBarrier& b, bool leader) {
    asm volatile("s_waitcnt vmcnt(0)" ::: "memory");
    __syncthreads();
    if (leader) {
        GAS unsigned* bar = b.bar; unsigned bx = b.x;
        asm volatile("" : "+s"(bar), "+s"(bx));
        __builtin_amdgcn_s_waitcnt(0);
        unsigned nloc = b.st[0], nx = b.st[1];
        if (nloc == 0u) { xcd_barrier_complete(bar, bx, nloc, nx); b.st[0] = nloc; b.st[1] = nx; }
        const unsigned old = xb_add(&bar[XB_XSUB(bx)], 1u);
        const unsigned gen = old / nloc;
        if (old + 1u == (gen + 1u) * nloc) {
            __builtin_amdgcn_fence(__ATOMIC_RELEASE, "agent");
            asm volatile("s_waitcnt vmcnt(0)" ::: "memory");
            const unsigned og = xb_add(&bar[XB_TOP], 1u);
            const unsigned tg = og / nx;
            if (og + 1u == (tg + 1u) * nx) xb_add(&bar[XB_TOPGEN], 1u);
            else XB_SPIN(xb_ld(&bar[XB_TOPGEN]) == tg, bar);
            __builtin_amdgcn_fence(__ATOMIC_ACQUIRE, "agent");
            xb_add(&bar[XB_XGEN(bx)], 1u);
            asm volatile("s_waitcnt vmcnt(0)" ::: "memory");
        } else {
            XB_SPIN(xb_ld(&bar[XB_XGEN(bx)]) == gen, bar);
            __builtin_amdgcn_fence(__ATOMIC_ACQUIRE, "agent");
            asm volatile("s_waitcnt vmcnt(0)" ::: "memory");
        }
    }
    __syncthreads();
}

struct Frame {
    LAS unsigned char* lds;
    int tid, lane, wave, vcu, G, gw, NGW;
    gby* ws;
};

__device__ __forceinline__ float wave_sum(float v) {
#pragma unroll
    for (int o = 1; o < 64; o <<= 1) v += __shfl_xor(v, o);
    return v;
}

__device__ __forceinline__ int tr_map(int code, int moff, int n) {
    if (code == 0) return n + moff;
    if (code == 1) return n < 2560 ? n : (n < 2608 ? 7680 + (n - 2560) : (n < 3632 ? 2560 + (n - 2608) : 3584 + (n - 3632)));
    return (n >> 7) * 256 + moff + (n & 127);
}
struct TrDesc { const gfl* W; gbf* WT; const gfl* cs; int K, N, ldk, code, moff, start; };
__device__ __forceinline__ void tr_load(float (&wv)[32], float& cs, const gfl* W, int N, int item, int lane, const gfl* colscale) {
    const int nblk = (N + 31) / 32, kb = item / nblk, nb = item % nblk, k0 = 64 * kb, n0 = 32 * nb;
    int nl = n0 + (lane & 31); nl = nl < N ? nl : N - 1;
    cs = colscale ? colscale[nl] : 1.f;
    const gfl* wp = W + (size_t)(k0 + (lane >> 5)) * N + nl;
#pragma unroll
    for (int i = 0; i < 32; ++i) wv[i] = wp[(size_t)(2 * i) * N];
}
__device__ __forceinline__ void tr_store(const float (&wv)[32], float cs, int N, gbf* WT, int ldk, LAS float* scr, int item, int lane, int code, int moff, const gfl* rowscale) {
    const int nblk = (N + 31) / 32, kb = item / nblk, nb = item % nblk, k0 = 64 * kb, n0 = 32 * nb;
#pragma unroll
    for (int i = 0; i < 32; ++i) { const int kk = 2 * i + (lane >> 5); scr[kk * 33 + (lane & 31)] = wv[i] * cs; }
    LDS_WAIT(); asm volatile("" ::: "memory");
    const int c = lane & 7;
    f32x4 r0 = {1.f, 1.f, 1.f, 1.f}, r1 = r0;
    if (rowscale) { r0 = *(const GAS f32x4*)(rowscale + k0 + 8 * c); r1 = *(const GAS f32x4*)(rowscale + k0 + 8 * c + 4); }
#pragma unroll
    for (int j = 0; j < 4; ++j) { const int n = (lane >> 3) + 8 * j; const LAS float* s = scr + (8 * c) * 33 + n;
        u32x4 o; o.x = pk2(s[0 * 33] * r0.x, s[1 * 33] * r0.y); o.y = pk2(s[2 * 33] * r0.z, s[3 * 33] * r0.w); o.z = pk2(s[4 * 33] * r1.x, s[5 * 33] * r1.y); o.w = pk2(s[6 * 33] * r1.z, s[7 * 33] * r1.w);
        if (n0 + n < N) *(GAS u32x4*)(WT + (size_t)tr_map(code, moff, n0 + n) * ldk + k0 + 8 * c) = o; }
    LDS_WAIT(); asm volatile("" ::: "memory");
}

__device__ __forceinline__ void rms_row_to_bf16(const gfl* xrow, const gfl* gain, gbf* orow, int lane) {
    f32x4 v[4][2]; float ss = 0.f;
#pragma unroll
    for (int j = 0; j < 4; ++j) { const int c = lane + 64 * j; v[j][0] = *(const GAS f32x4*)(xrow + 8 * c); v[j][1] = *(const GAS f32x4*)(xrow + 8 * c + 4);
        ss += (v[j][0].x * v[j][0].x + v[j][0].y * v[j][0].y) + (v[j][0].z * v[j][0].z + v[j][0].w * v[j][0].w) + (v[j][1].x * v[j][1].x + v[j][1].y * v[j][1].y) + (v[j][1].z * v[j][1].z + v[j][1].w * v[j][1].w); }
    const float r = 1.0f / sqrtf(wave_sum(ss) * (1.f / DM) + RMS_EPS);
#pragma unroll
    for (int j = 0; j < 4; ++j) { const int c = lane + 64 * j; const f32x4 g0 = *(const GAS f32x4*)(gain + 8 * c), g1 = *(const GAS f32x4*)(gain + 8 * c + 4);
        const f32x4 a = v[j][0] * r * g0, b = v[j][1] * r * g1;
        u32x4 w; w.x = pk2(a.x, a.y); w.y = pk2(a.z, a.w); w.z = pk2(b.x, b.y); w.w = pk2(b.z, b.w);
        *(GAS u32x4*)(orow + 8 * c) = w; }
}
__device__ __forceinline__ void rms_row_r(const gfl* xrow, gfl* rout, int lane) {
    float ss = 0.f;
#pragma unroll
    for (int j = 0; j < 4; ++j) { const int c = lane + 64 * j; const f32x4 a = *(const GAS f32x4*)(xrow + 8 * c), b = *(const GAS f32x4*)(xrow + 8 * c + 4);
        ss += (a.x * a.x + a.y * a.y) + (a.z * a.z + a.w * a.w) + (b.x * b.x + b.y * b.y) + (b.z * b.z + b.w * b.w); }
    const float r = 1.0f / sqrtf(wave_sum(ss) * (1.f / DM) + RMS_EPS);
    if (lane == 0) *rout = r;
}
__device__ __forceinline__ void resid_row(const gbf* xin, gbf* xb_out, gfl* xf_out, const gbf* yrow, const gfl* gpost, gfl* rout, int lane) {
    f32x4 y[4][2]; float ss = 0.f;
#pragma unroll
    for (int j = 0; j < 4; ++j) { const int c = lane + 64 * j; const u32x4 w = *(const GAS u32x4*)(yrow + 8 * c);
        y[j][0] = (f32x4){bflo(w.x), bfhi(w.x), bflo(w.y), bfhi(w.y)}; y[j][1] = (f32x4){bflo(w.z), bfhi(w.z), bflo(w.w), bfhi(w.w)};
        ss += (y[j][0].x * y[j][0].x + y[j][0].y * y[j][0].y) + (y[j][0].z * y[j][0].z + y[j][0].w * y[j][0].w) + (y[j][1].x * y[j][1].x + y[j][1].y * y[j][1].y) + (y[j][1].z * y[j][1].z + y[j][1].w * y[j][1].w); }
    u32x4 xw[4];
#pragma unroll
    for (int j = 0; j < 4; ++j) xw[j] = *(const GAS u32x4*)(xin + 8 * (lane + 64 * j));
    const float r = 1.0f / sqrtf(wave_sum(ss) * (1.f / DM) + RMS_EPS);
    float s2 = 0.f;
#pragma unroll
    for (int j = 0; j < 4; ++j) { const int c = lane + 64 * j; const f32x4 g0 = *(const GAS f32x4*)(gpost + 8 * c), g1 = *(const GAS f32x4*)(gpost + 8 * c + 4);
        const f32x4 x0 = (f32x4){bflo(xw[j].x), bfhi(xw[j].x), bflo(xw[j].y), bfhi(xw[j].y)}, x1 = (f32x4){bflo(xw[j].z), bfhi(xw[j].z), bflo(xw[j].w), bfhi(xw[j].w)};
        y[j][0] = x0 + y[j][0] * r * g0; y[j][1] = x1 + y[j][1] * r * g1;
        if (xf_out) { *(GAS f32x4*)(xf_out + 8 * c) = y[j][0]; *(GAS f32x4*)(xf_out + 8 * c + 4) = y[j][1]; }
        else { u32x4 w; w.x = pk2(y[j][0].x, y[j][0].y); w.y = pk2(y[j][0].z, y[j][0].w); w.z = pk2(y[j][1].x, y[j][1].y); w.w = pk2(y[j][1].z, y[j][1].w); *(GAS u32x4*)(xb_out + 8 * c) = w; }
        s2 += (y[j][0].x * y[j][0].x + y[j][0].y * y[j][0].y) + (y[j][0].z * y[j][0].z + y[j][0].w * y[j][0].w) + (y[j][1].x * y[j][1].x + y[j][1].y * y[j][1].y) + (y[j][1].z * y[j][1].z + y[j][1].w * y[j][1].w); }
    if (rout) { const float r2 = 1.0f / sqrtf(wave_sum(s2) * (1.f / DM) + RMS_EPS); if (lane == 0) *rout = r2; }
}
__device__ __forceinline__ float gelu_tanh(float x) {
    const float z = 0.7978845608028654f * (x + 0.044715f * x * x * x);
    const float e = __builtin_amdgcn_exp2f(2.f * z * LOG2E);
    const float th = 1.f - 2.f * __builtin_amdgcn_rcpf(1.f + e);
    return 0.5f * x * (1.f + th);
}
constexpr float NEGBIG = -1e30f;
constexpr int ATT_BKT_OFF = 0;
constexpr int ATT_TAB_OFF = 2048;
constexpr int ATT_WAVE_OFF = 4096;
constexpr int ATT_IMP_STRIDE = 264;
constexpr int ATT_WAVE_BYTES = 2 * 4 * ATT_IMP_STRIDE * 4 + 128;
static_assert(ATT_WAVE_OFF + NWAVES * ATT_WAVE_BYTES <= RING_BYTES, "attention LDS");

__device__ __forceinline__ int t5_bucket(int n) {
    if (n < 16) return n;
    int b = 16;
    b += (n >= 22); b += (n >= 30); b += (n >= 40); b += (n >= 54); b += (n >= 73); b += (n >= 99); b += (n >= 134); b += (n >= 182);
    b += (n >= 246); b += (n >= 332); b += (n >= 450); b += (n >= 609); b += (n >= 825); b += (n >= 1117); b += (n >= 1513);
    return b;
}
struct AttSt { f32x4 o[4]; float m, l; };
__device__ __forceinline__ void att_reset(AttSt& st) {
#pragma unroll
    for (int i = 0; i < 4; ++i) st.o[i] = (f32x4){0.f, 0.f, 0.f, 0.f};
    st.m = NEGBIG; st.l = 0.f;
}
template <int MODE>
__device__ __forceinline__ void att_scores(float (&sv)[8], const bf16x8 (&qf)[2], const gbf* Kg, int kb, int t, int head, bool rowsel, int lane, const LAS unsigned char* bkt, const LAS float* tab) {
    const int i16 = lane & 15, gq = lane >> 4;
    f32x4 s[2];
#pragma unroll
    for (int tau = 0; tau < 2; ++tau) {
        const int ko = 8 * (i16 >> 2) + 4 * tau + (i16 & 3);
        const gbf* kp = Kg + (size_t)(kb + ko) * 64 + 8 * gq;
        const bf16x8 k0 = *(const GAS bf16x8*)kp, k1 = *(const GAS bf16x8*)(kp + 32);
        s[tau] = __builtin_amdgcn_mfma_f32_16x16x32_bf16(k0, qf[0], (f32x4){0.f, 0.f, 0.f, 0.f}, 0, 0, 0);
        s[tau] = __builtin_amdgcn_mfma_f32_16x16x32_bf16(k1, qf[1], s[tau], 0, 0, 0);
    }
#pragma unroll
    for (int tau = 0; tau < 2; ++tau)
#pragma unroll
        for (int r = 0; r < 4; ++r) {
            const int idx = kb + 8 * gq + 4 * tau + r;
            int dist; bool valid;
            if (MODE == 0) { dist = t - (16 * idx + 31); valid = dist >= 0; }
            else if (MODE == 1) { dist = t - idx; valid = rowsel && dist >= 0; }
            else { dist = t - idx; valid = (unsigned)dist < 512u; }
            const int dc = dist < 0 ? 0 : (dist > 2047 ? 2047 : dist);
            const float b = tab[head * 32 + bkt[dc]];
            sv[4 * tau + r] = valid ? s[tau][r] + b : NEGBIG;
        }
}
template <int MODE>
__device__ __forceinline__ void att_step(AttSt& st, const bf16x8 (&qf)[2], const gbf* Kg, const gbf* VTg, int vpitch, int kb, int t, int head, bool rowsel, int lane, const LAS unsigned char* bkt, const LAS float* tab) {
    const int i16 = lane & 15, gq = lane >> 4;
    float sv[8];
    att_scores<MODE>(sv, qf, Kg, kb, t, head, rowsel, lane, bkt, tab);
    float mx = fmaxf(fmaxf(fmaxf(sv[0], sv[1]), fmaxf(sv[2], sv[3])), fmaxf(fmaxf(sv[4], sv[5]), fmaxf(sv[6], sv[7])));
    mx = fmaxf(mx, __shfl_xor(mx, 16)); mx = fmaxf(mx, __shfl_xor(mx, 32));
    const float mn = fmaxf(st.m, mx);
    const float alpha = __builtin_amdgcn_exp2f(st.m - mn);
    st.m = mn;
    float p[8]; float ps = 0.f;
#pragma unroll
    for (int e = 0; e < 8; ++e) { p[e] = __builtin_amdgcn_exp2f(sv[e] - mn); ps += p[e]; }
    st.l = st.l * alpha + ps;
    u32x4 pw; pw.x = pk2(p[0], p[1]); pw.y = pk2(p[2], p[3]); pw.z = pk2(p[4], p[5]); pw.w = pk2(p[6], p[7]);
    const bf16x8 pb = __builtin_bit_cast(bf16x8, pw);
#pragma unroll
    for (int dt = 0; dt < 4; ++dt) {
        const bf16x8 vf = *(const GAS bf16x8*)(VTg + (size_t)(16 * dt + i16) * vpitch + kb + 8 * gq);
        st.o[dt] = st.o[dt] * alpha;
        st.o[dt] = __builtin_amdgcn_mfma_f32_16x16x32_bf16(vf, pb, st.o[dt], 0, 0, 0);
    }
}
__device__ __forceinline__ void att_finish(const AttSt& st, f32x4 (&acc)[4], float gate) {
    float l = st.l; l += __shfl_xor(l, 16); l += __shfl_xor(l, 32);
    const float sc = (st.m > -1e29f) ? gate / l : 0.f;
#pragma unroll
    for (int dt = 0; dt < 4; ++dt) acc[dt] += st.o[dt] * sc;
}
__device__ __forceinline__ unsigned wave_max_u32_dpp(unsigned v) {
    unsigned w;
    w = (unsigned)__builtin_amdgcn_update_dpp((int)v, (int)v, 0xB1, 0xF, 0xF, false); v = v > w ? v : w;
    w = (unsigned)__builtin_amdgcn_update_dpp((int)v, (int)v, 0x4E, 0xF, 0xF, false); v = v > w ? v : w;
    w = (unsigned)__builtin_amdgcn_update_dpp((int)v, (int)v, 0x141, 0xF, 0xF, false); v = v > w ? v : w;
    w = (unsigned)__builtin_amdgcn_update_dpp((int)v, (int)v, 0x140, 0xF, 0xF, false); v = v > w ? v : w;
    w = (unsigned)__builtin_amdgcn_update_dpp((int)v, (int)v, 0x142, 0xA, 0xF, false); v = v > w ? v : w;
    w = (unsigned)__builtin_amdgcn_update_dpp((int)v, (int)v, 0x143, 0xC, 0xF, false); v = v > w ? v : w;
    return (unsigned)__builtin_amdgcn_readlane((int)v, 63);
}
__device__ __forceinline__ unsigned wave_max_u32(unsigned v) {
#pragma unroll
    for (int o = 1; o < 64; o <<= 1) { const unsigned w = (unsigned)__shfl_xor((int)v, o); v = v > w ? v : w; }
    return v;
}

struct AttnPtrs { const gbf *Q, *KC, *VCT, *KSEL, *VSELT, *KWIN, *VWINT; const gfl* GL; gbf* A; };

__device__ __forceinline__ void attn_setup_tables(Frame& F, const gfl* rel_bias) {
    LAS unsigned char* bkt = F.lds + ATT_BKT_OFF; LAS float* tab = (LAS float*)(F.lds + ATT_TAB_OFF);
    for (int i = F.tid; i < 2048; i += NWAVES * 64) bkt[i] = (unsigned char)t5_bucket(i);
    for (int i = F.tid; i < 512; i += NWAVES * 64) tab[i] = rel_bias[i] * LOG2E;
    LDS_WAIT(); __syncthreads();
}

__device__ __forceinline__ void nsa_unit_v1(Frame& F, const AttnPtrs& P, int qt, int g) {
    const int lane = F.lane, i16 = lane & 15, gq = lane >> 4, ql = i16 >> 2, hl = i16 & 3;
    const LAS unsigned char* bkt = F.lds + ATT_BKT_OFF; const LAS float* tab = (const LAS float*)(F.lds + ATT_TAB_OFF);
    LAS float* impA = (LAS float*)(F.lds + ATT_WAVE_OFF + F.wave * ATT_WAVE_BYTES); LAS float* impB = impA + 4 * ATT_IMP_STRIDE;
    LAS unsigned* selm = (LAS unsigned*)(impB + 4 * ATT_IMP_STRIDE);
    const int t0 = 4 * qt, t = t0 + ql, head = 4 * g + hl;
    bf16x8 qf[2];
    { const gbf* qp = P.Q + (size_t)t * NSAW + head * 64 + 8 * gq; qf[0] = *(const GAS bf16x8*)qp; qf[1] = *(const GAS bf16x8*)(qp + 32); }
#ifndef MK_BR
#define MK_BR 7
#endif
    const float g_c = (MK_BR & 1) ? P.GL[(size_t)t * 48 + head * 3 + 0] : 0.f, g_s = (MK_BR & 2) ? P.GL[(size_t)t * 48 + head * 3 + 1] : 0.f, g_w = (MK_BR & 4) ? P.GL[(size_t)t * 48 + head * 3 + 2] : 0.f;
    f32x4 acc[4];
#pragma unroll
    for (int i = 0; i < 4; ++i) acc[i] = (f32x4){0.f, 0.f, 0.f, 0.f};
    AttSt st;
    const gbf* KCg = P.KC + (size_t)g * 1024 * 64; const gbf* VCTg = P.VCT + (size_t)g * 64 * 1024;
    const int nlast = (t0 + 3 >= 31) ? (t0 + 3 - 31) / 16 : -1;
    att_reset(st);
    for (int kb = 0; kb <= nlast; kb += 32) att_step<0>(st, qf, KCg, VCTg, 1024, kb, t, head, true, lane, bkt, tab);
    att_finish(st, acc, g_c);
    const int cur_max = (t0 + 3) >> 6;
    if (cur_max >= 16) {
        float lt = st.l; lt += __shfl_xor(lt, 16); lt += __shfl_xor(lt, 32);
        const float inv_l = (st.m > -1e29f) ? 1.f / lt : 0.f; const float mfin = st.m;
        for (int kb = 0; kb <= nlast; kb += 32) {
            float sv[8];
            att_scores<0>(sv, qf, KCg, kb, t, head, true, lane, bkt, tab);
            float ps[8];
#pragma unroll
            for (int e = 0; e < 8; ++e) { float p = (sv[e] > -1e29f) ? __builtin_amdgcn_exp2f(sv[e] - mfin) * inv_l : 0.f; p += __shfl_xor(p, 1); p += __shfl_xor(p, 2); ps[e] = p; }
            const float a0 = ps[0] + ps[1] + ps[2] + 0.5f * ps[3], c0 = 0.5f * ps[3];
            const float a1 = ps[4] + ps[5] + ps[6] + 0.5f * ps[7] + c0, c1 = 0.5f * ps[7];
            const int j0 = (kb + 8 * gq) >> 2;
            if (hl == 0) { impA[ql * ATT_IMP_STRIDE + j0] = a0; impA[ql * ATT_IMP_STRIDE + j0 + 1] = a1; impB[ql * ATT_IMP_STRIDE + j0 + 2] = c1; }
        }
    }
    LDS_WAIT();
#pragma unroll 1
    for (int q = 0; q < 4; ++q) {
        const int tq = t0 + q, cur = tq >> 6;
        unsigned mword = 0u;
        if (cur <= 15) { if (lane == 0) mword = (2u << cur) - 1u; }
        else {
            unsigned key[4];
#pragma unroll
            for (int e = 0; e < 4; ++e) { const int j = 4 * lane + e; float v = impA[q * ATT_IMP_STRIDE + j]; if ((j & 1) == 0 && j > 0) v += impB[q * ATT_IMP_STRIDE + j];
#ifdef MK_CMP_ATT
                ((GAS float*)(F.ws + WS_END + 16 * MiB))[((size_t)(t0 + q) * 4 + g) * 256 + j] = v;
#endif
                const bool cand = (j >= 1) && (j <= cur - 2);
                key[e] = cand ? ((__builtin_bit_cast(unsigned, v) & 0xffffff00u) | (unsigned)(255 - j)) : 0u; }
#pragma unroll 1
            for (int round = 0; round < 13; ++round) {
                unsigned best = key[0] > key[1] ? key[0] : key[1]; const unsigned b2 = key[2] > key[3] ? key[2] : key[3]; best = best > b2 ? best : b2;
                const unsigned wk = (unsigned)__builtin_amdgcn_readfirstlane((int)wave_max_u32(best));
                const int js = 255 - (int)(wk & 255u);
                if (lane == (js >> 2)) {
#pragma unroll
                    for (int e = 0; e < 4; ++e) if ((js & 3) == e) key[e] = 0u;
                }
                if (lane == (js >> 5)) mword |= 1u << (js & 31);
            }
            if (lane == 0) mword |= 1u;
            if (lane == (cur >> 5)) mword |= 1u << (cur & 31);
            if (lane == ((cur - 1) >> 5)) mword |= 1u << ((cur - 1) & 31);
        }
        if (lane < 8) selm[q * 8 + lane] = mword;
#ifdef MK_CMP_ATT
        if (lane < 8) ((GAS unsigned*)(F.ws + WS_END + 400 * MiB))[((size_t)(t0 + q) * 4 + g) * 8 + lane] = mword;
#endif
    }
    LDS_WAIT();
    const gbf* KSg = P.KSEL + (size_t)g * S_ * 64; const gbf* VSTg = P.VSELT + (size_t)g * 64 * S_;
    att_reset(st);
#pragma unroll 1
    for (int w = 0; w < 8; ++w) {
        unsigned U = selm[w] | selm[8 + w] | selm[16 + w] | selm[24 + w];
        U = (unsigned)__builtin_amdgcn_readfirstlane((int)U);
        const unsigned myw = selm[ql * 8 + w];
        while (U) {
            const int b = __builtin_ctz(U); U &= U - 1u;
            const int blk = 32 * w + b; const bool rs = (myw >> b) & 1u;
            att_step<1>(st, qf, KSg, VSTg, S_, blk * 64, t, head, rs, lane, bkt, tab);
            att_step<1>(st, qf, KSg, VSTg, S_, blk * 64 + 32, t, head, rs, lane, bkt, tab);
        }
    }
    att_finish(st, acc, g_s);
    const gbf* KWg = P.KWIN + (size_t)g * S_ * 64; const gbf* VWTg = P.VWINT + (size_t)g * 64 * S_;
    att_reset(st);
    { int kb0 = t0 - 511; kb0 = kb0 < 0 ? 0 : (kb0 & ~31);
      for (int kb = kb0; kb <= t0 + 3; kb += 32) att_step<2>(st, qf, KWg, VWTg, S_, kb, t, head, true, lane, bkt, tab); }
    att_finish(st, acc, g_w);
    gbf* ap = P.A + (size_t)t * NSAW + head * 64 + 4 * gq;
#pragma unroll
    for (int dt = 0; dt < 4; ++dt) { u32x2 w; w.x = pk2(acc[dt][0], acc[dt][1]); w.y = pk2(acc[dt][2], acc[dt][3]); *(GAS u32x2*)(ap + 16 * dt) = w; }
}

__device__ __forceinline__ void xattn_unit_v1(Frame& F, const gbf* Q2, const gbf* KM, const gbf* VMT, gbf* O2, int qt, int h) {
    const int lane = F.lane, i16 = lane & 15, gq = lane >> 4;
    const int t = 16 * qt + i16;
    bf16x8 qf[4];
#pragma unroll
    for (int s = 0; s < 4; ++s) qf[s] = *(const GAS bf16x8*)(Q2 + (size_t)t * XW + h * XHD + 32 * s + 8 * gq);
    f32x4 o[8];
#pragma unroll
    for (int i = 0; i < 8; ++i) o[i] = (f32x4){0.f, 0.f, 0.f, 0.f};
    float m = NEGBIG, l = 0.f;
#pragma unroll 1
    for (int kb = 0; kb < NMEM; kb += 32) {
        f32x4 s[2];
#pragma unroll
        for (int tau = 0; tau < 2; ++tau) {
            const int ko = 8 * (i16 >> 2) + 4 * tau + (i16 & 3);
            const gbf* kp = KM + (size_t)(kb + ko) * XW + h * XHD + 8 * gq;
            s[tau] = (f32x4){0.f, 0.f, 0.f, 0.f};
#pragma unroll
            for (int ks = 0; ks < 4; ++ks) s[tau] = __builtin_amdgcn_mfma_f32_16x16x32_bf16(*(const GAS bf16x8*)(kp + 32 * ks), qf[ks], s[tau], 0, 0, 0);
        }
        float mx = fmaxf(fmaxf(fmaxf(s[0][0], s[0][1]), fmaxf(s[0][2], s[0][3])), fmaxf(fmaxf(s[1][0], s[1][1]), fmaxf(s[1][2], s[1][3])));
        mx = fmaxf(mx, __shfl_xor(mx, 16)); mx = fmaxf(mx, __shfl_xor(mx, 32));
        const float mn = fmaxf(m, mx); const float alpha = __builtin_amdgcn_exp2f(m - mn); m = mn;
        float p[8]; float ps = 0.f;
#pragma unroll
        for (int e = 0; e < 8; ++e) { p[e] = __builtin_amdgcn_exp2f(s[e >> 2][e & 3] - mn); ps += p[e]; }
        l = l * alpha + ps;
        u32x4 pw; pw.x = pk2(p[0], p[1]); pw.y = pk2(p[2], p[3]); pw.z = pk2(p[4], p[5]); pw.w = pk2(p[6], p[7]);
        const bf16x8 pb = __builtin_bit_cast(bf16x8, pw);
#pragma unroll
        for (int dt = 0; dt < 8; ++dt) {
            const bf16x8 vf = *(const GAS bf16x8*)(VMT + (size_t)(h * XHD + 16 * dt + i16) * NMEM + kb + 8 * gq);
            o[dt] = o[dt] * alpha;
            o[dt] = __builtin_amdgcn_mfma_f32_16x16x32_bf16(vf, pb, o[dt], 0, 0, 0);
        }
    }
    l += __shfl_xor(l, 16); l += __shfl_xor(l, 32);
    const float inv = 1.f / l;
    gbf* op = O2 + (size_t)t * XW + h * XHD + 4 * gq;
#pragma unroll
    for (int dt = 0; dt < 8; ++dt) { u32x2 w; w.x = pk2(o[dt][0] * inv, o[dt][1] * inv); w.y = pk2(o[dt][2] * inv, o[dt][3] * inv); *(GAS u32x2*)(op + 16 * dt) = w; }
}

__device__ __forceinline__ void xattn_unit_v2(Frame& F, const gbf* Q2, const gbf* KM, const gbf* VMT, gbf* O2, int q256, int h) {
    const int lane = F.lane, wave = F.wave, i16 = lane & 15, gq = lane >> 4;
    LAS unsigned char* lk = F.lds; LAS unsigned char* lv = F.lds + 65536;
#pragma unroll
    for (int k = 0; k < 8; ++k) { const int i = wave + 8 * k;
        { const int r = 4 * i + (lane >> 4), pph = lane & 15, f = (r & 3) | (((r >> 3) & 1) << 2);
          __builtin_amdgcn_global_load_lds((const GAS unsigned*)(KM + (size_t)r * XW + h * XHD + ((pph ^ f) * 8)), (LAS unsigned*)(lk + i * 1024), 16, 0, 0); }
        { const int r = 2 * i + (lane >> 5), pph = lane & 31;
          __builtin_amdgcn_global_load_lds((const GAS unsigned*)(VMT + (size_t)(h * XHD + r) * NMEM + ((pph ^ (r & 7)) * 8)), (LAS unsigned*)(lv + i * 1024), 16, 0, 0); } }
    const int tb = 256 * q256 + 32 * wave;
    bf16x8 qf[2][4];
#pragma unroll
    for (int rt = 0; rt < 2; ++rt)
#pragma unroll
        for (int s = 0; s < 4; ++s) qf[rt][s] = *(const GAS bf16x8*)(Q2 + (size_t)(tb + 16 * rt + i16) * XW + h * XHD + 32 * s + 8 * gq);
    f32x4 o[2][8];
#pragma unroll
    for (int rt = 0; rt < 2; ++rt)
#pragma unroll
        for (int i = 0; i < 8; ++i) o[rt][i] = (f32x4){0.f, 0.f, 0.f, 0.f};
    float m[2] = {NEGBIG, NEGBIG}, l[2] = {0.f, 0.f};
    asm volatile("s_waitcnt vmcnt(0)" ::: "memory");
    __syncthreads();
    const int ko0 = 8 * (i16 >> 2) + (i16 & 3), fk = i16 & 7;
#pragma unroll 1
    for (int kb = 0; kb < NMEM; kb += 32) {
        bf16x8 kf[2][4], vf[8];
#pragma unroll
        for (int tau = 0; tau < 2; ++tau)
#pragma unroll
            for (int ks = 0; ks < 4; ++ks) kf[tau][ks] = *(const LAS bf16x8*)(lk + (kb + ko0 + 4 * tau) * 256 + (((4 * ks + gq) ^ fk) * 16));
#pragma unroll
        for (int dt = 0; dt < 8; ++dt) { const int row = 16 * dt + i16; vf[dt] = *(const LAS bf16x8*)(lv + row * 512 + ((((kb >> 3) + gq) ^ (row & 7)) * 16)); }
#pragma unroll
        for (int rt = 0; rt < 2; ++rt) {
            f32x4 s[2];
#pragma unroll
            for (int tau = 0; tau < 2; ++tau) { s[tau] = (f32x4){0.f, 0.f, 0.f, 0.f};
#pragma unroll
                for (int ks = 0; ks < 4; ++ks) s[tau] = __builtin_amdgcn_mfma_f32_16x16x32_bf16(kf[tau][ks], qf[rt][ks], s[tau], 0, 0, 0); }
            float x[8];
#pragma unroll
            for (int e = 0; e < 8; ++e) x[e] = s[e >> 2][e & 3] - m[rt];
            const float mloc = fmaxf(fmaxf(fmaxf(x[0], x[1]), fmaxf(x[2], x[3])), fmaxf(fmaxf(x[4], x[5]), fmaxf(x[6], x[7])));
            if (__any(mloc > 8.f)) {
                float mx = fmaxf(fmaxf(fmaxf(s[0][0], s[0][1]), fmaxf(s[0][2], s[0][3])), fmaxf(fmaxf(s[1][0], s[1][1]), fmaxf(s[1][2], s[1][3])));
                mx = fmaxf(mx, __shfl_xor(mx, 16)); mx = fmaxf(mx, __shfl_xor(mx, 32));
                const float mn = fmaxf(m[rt], mx); const float alpha = __builtin_amdgcn_exp2f(m[rt] - mn); m[rt] = mn; l[rt] *= alpha;
#pragma unroll
                for (int dt = 0; dt < 8; ++dt) o[rt][dt] = o[rt][dt] * alpha;
#pragma unroll
                for (int e = 0; e < 8; ++e) x[e] = s[e >> 2][e & 3] - mn;
            }
            float p[8]; float ps = 0.f;
#pragma unroll
            for (int e = 0; e < 8; ++e) { p[e] = __builtin_amdgcn_exp2f(x[e]); ps += p[e]; }
            l[rt] += ps;
            u32x4 pw; pw.x = pk2(p[0], p[1]); pw.y = pk2(p[2], p[3]); pw.z = pk2(p[4], p[5]); pw.w = pk2(p[6], p[7]);
            const bf16x8 pb = __builtin_bit_cast(bf16x8, pw);
#pragma unroll
            for (int dt = 0; dt < 8; ++dt) o[rt][dt] = __builtin_amdgcn_mfma_f32_16x16x32_bf16(vf[dt], pb, o[rt][dt], 0, 0, 0);
        }
    }
#pragma unroll
    for (int rt = 0; rt < 2; ++rt) {
        float lt = l[rt]; lt += __shfl_xor(lt, 16); lt += __shfl_xor(lt, 32);
        const float inv = 1.f / lt;
        gbf* op = O2 + (size_t)(tb + 16 * rt + i16) * XW + h * XHD + 4 * gq;
#pragma unroll
        for (int dt = 0; dt < 8; ++dt) { u32x2 w; w.x = pk2(o[rt][dt][0] * inv, o[rt][dt][1] * inv); w.y = pk2(o[rt][dt][2] * inv, o[rt][dt][3] * inv); *(GAS u32x2*)(op + 16 * dt) = w; }
    }
    __syncthreads();
}
constexpr int A2_BKT_OFF = 0, A2_TAB_OFF = 2048;
constexpr int A2_RING_OFF = 4096, A2_SLOT = 8192, A2_NS = 6;
constexpr int A2_IMP_OFF = A2_RING_OFF + A2_NS * A2_SLOT;
constexpr int A2_SELM_OFF = A2_IMP_OFF + NWAVES * 8192;
constexpr int A2_ORW_OFF = A2_SELM_OFF + 2048;
constexpr int A2_U_OFF = A2_ORW_OFF + 512;
constexpr int A2_LIST_OFF = A2_U_OFF + 64;
constexpr int A2_SELC_OFF = A2_LIST_OFF + 1024;
constexpr int A2_ORC_OFF = A2_SELC_OFF + 2048;
constexpr int A2_END = A2_ORC_OFF + 512;
constexpr int A2_BT_OFF = A2_RING_OFF + 12 * A2_SLOT, A2_BT_N = 1600;
static_assert(A2_BT_OFF + 4 * A2_BT_N * 2 <= A2_SELM_OFF, "bias-by-distance table");
static_assert(A2_END <= RING_BYTES, "attention v2 LDS");

__device__ __forceinline__ int a2_fk(int row) { return ((row >> 1) & 1) | (((row >> 3) & 3) << 1); }
__device__ __forceinline__ int a2_gv(int d) { const int q = (d >> 2) & 3; return (0x1320 >> (4 * q)) & 3; }

__device__ __forceinline__ void a2_stage(LAS unsigned char* slot, const gbf* Kg, const gbf* VTg, int vpitch, int kb, int wave, int lane, bool withV) {
    if (wave < 4) {
        const int row = 8 * wave + (lane >> 3), pp = lane & 7;
        const gbf* src = Kg + (size_t)(kb + row) * 64 + ((pp ^ a2_fk(row)) * 8);
        __builtin_amdgcn_global_load_lds((const GAS unsigned*)src, (LAS unsigned*)(slot + wave * 1024), 16, 0, 0);
    } else if (withV) {
        const int v = wave - 4, d = 16 * v + (lane >> 2), pp = lane & 3;
        const gbf* src = VTg + (size_t)d * vpitch + kb + ((pp ^ a2_gv(d)) * 8);
        __builtin_amdgcn_global_load_lds((const GAS unsigned*)src, (LAS unsigned*)(slot + 4096 + v * 1024), 16, 0, 0);
    }
}
struct A2St { f32x4 o[2][4]; f32x4 lacc[2]; float m[2], l[2]; };
__device__ __forceinline__ void a2_reset(A2St& st) {
#pragma unroll
    for (int r = 0; r < 2; ++r) { st.m[r] = NEGBIG; st.l[r] = 0.f; st.lacc[r] = (f32x4){0.f, 0.f, 0.f, 0.f};
#pragma unroll
        for (int i = 0; i < 4; ++i) st.o[r][i] = (f32x4){0.f, 0.f, 0.f, 0.f}; }
}
__device__ __forceinline__ void a2_kfrags(bf16x8 (&kf)[2][2], const LAS unsigned char* slot, int lane) {
    const int i16 = lane & 15, gq = lane >> 4;
#pragma unroll
    for (int tau = 0; tau < 2; ++tau) { const int row = 8 * (i16 >> 2) + 4 * tau + (i16 & 3), f = a2_fk(row);
#pragma unroll
        for (int s = 0; s < 2; ++s) kf[tau][s] = *(const LAS bf16x8*)(slot + row * 128 + (((gq + 4 * s) ^ f) * 16)); }
}
__device__ __forceinline__ void a2_vfrags(bf16x8 (&vf)[4], const LAS unsigned char* slot, int lane) {
    const int i16 = lane & 15, gq = lane >> 4, pc = (gq ^ a2_gv(i16)) * 16;
#pragma unroll
    for (int dt = 0; dt < 4; ++dt) vf[dt] = *(const LAS bf16x8*)(slot + 4096 + (16 * dt + i16) * 64 + pc);
}
template <int MODE, bool FARB>
__device__ __forceinline__ void a2_scores(float (&sv)[8], const bf16x8 (&kf)[2][2], const bf16x8 (&qf)[2], int kb, int t, int head, bool rowsel, float bfar, int lane, const LAS unsigned char* bkt, const LAS float* tab) {
    const int gq = lane >> 4;
    f32x4 s[2];
#pragma unroll
    for (int tau = 0; tau < 2; ++tau) {
        s[tau] = __builtin_amdgcn_mfma_f32_16x16x32_bf16(kf[tau][0], qf[0], (f32x4){0.f, 0.f, 0.f, 0.f}, 0, 0, 0);
        s[tau] = __builtin_amdgcn_mfma_f32_16x16x32_bf16(kf[tau][1], qf[1], s[tau], 0, 0, 0);
    }
#pragma unroll
    for (int tau = 0; tau < 2; ++tau)
#pragma unroll
        for (int r = 0; r < 4; ++r) {
            if (FARB) { sv[4 * tau + r] = (MODE != 1 || rowsel) ? s[tau][r] + bfar : NEGBIG; }
            else {
                const int idx = kb + 8 * gq + 4 * tau + r;
                int dist; bool valid;
                if (MODE == 0) { dist = t - (16 * idx + 31); valid = dist >= 0; }
                else if (MODE == 1) { dist = t - idx; valid = rowsel && dist >= 0; }
                else { dist = t - idx; valid = (unsigned)dist < 512u; }
                const int dc = dist < 0 ? 0 : (dist > 2047 ? 2047 : dist);
                const float b = tab[head * 32 + bkt[dc]];
                sv[4 * tau + r] = valid ? s[tau][r] + b : NEGBIG;
            }
        }
}
__device__ __forceinline__ void a2_softmax_pv(A2St& st, int rt, const float (&sv)[8], const bf16x8 (&vf)[4]) {
    float mx = fmaxf(fmaxf(fmaxf(sv[0], sv[1]), fmaxf(sv[2], sv[3])), fmaxf(fmaxf(sv[4], sv[5]), fmaxf(sv[6], sv[7])));
    mx = fmaxf(mx, __shfl_xor(mx, 16)); mx = fmaxf(mx, __shfl_xor(mx, 32));
    const float mn = fmaxf(st.m[rt], mx);
    const float alpha = __builtin_amdgcn_exp2f(st.m[rt] - mn);
    st.m[rt] = mn;
    float p[8]; float ps = 0.f;
#pragma unroll
    for (int e = 0; e < 8; ++e) { p[e] = __builtin_amdgcn_exp2f(sv[e] - mn); ps += p[e]; }
    st.l[rt] = st.l[rt] * alpha + ps;
    u32x4 pw; pw.x = pk2(p[0], p[1]); pw.y = pk2(p[2], p[3]); pw.z = pk2(p[4], p[5]); pw.w = pk2(p[6], p[7]);
    const bf16x8 pb = __builtin_bit_cast(bf16x8, pw);
#pragma unroll
    for (int dt = 0; dt < 4; ++dt) { st.o[rt][dt] = st.o[rt][dt] * alpha; st.o[rt][dt] = __builtin_amdgcn_mfma_f32_16x16x32_bf16(vf[dt], pb, st.o[rt][dt], 0, 0, 0); }
}
template <int MODE, bool FARB>
__device__ __forceinline__ void a2_tile(A2St& st, int rt, const bf16x8 (&kf)[2][2], const bf16x8 (&vf)[4], const bf16x8 (&qf)[2], int kb, int t, int head, bool rowsel, float bfar, int lane, const LAS unsigned char* bkt, const LAS float* tab) {
    const int gq = lane >> 4;
    f32x4 s[2];
#pragma unroll
    for (int tau = 0; tau < 2; ++tau) {
        s[tau] = __builtin_amdgcn_mfma_f32_16x16x32_bf16(kf[tau][0], qf[0], (f32x4){0.f, 0.f, 0.f, 0.f}, 0, 0, 0);
        s[tau] = __builtin_amdgcn_mfma_f32_16x16x32_bf16(kf[tau][1], qf[1], s[tau], 0, 0, 0);
    }
    const float m = st.m[rt];
    float x[8], bb[8]; bool vl[8];
    const float bsel = ((MODE != 1) || rowsel) ? bfar : -__builtin_inff();
    if (FARB) { const float c = bsel - m;
#pragma unroll
        for (int e = 0; e < 8; ++e) x[e] = s[e >> 2][e & 3] + c;
    } else {
#pragma unroll
        for (int e = 0; e < 8; ++e) {
            const int idx = kb + 8 * gq + e;
            int dist;
            if (MODE == 0) { dist = t - (16 * idx + 31); vl[e] = dist >= 0; }
            else if (MODE == 1) { dist = t - idx; vl[e] = rowsel && dist >= 0; }
            else { dist = t - idx; vl[e] = (unsigned)dist < 512u; }
            const int dc = dist < 0 ? 0 : (dist > 2047 ? 2047 : dist);
            bb[e] = tab[head * 32 + bkt[dc]];
            x[e] = vl[e] ? s[e >> 2][e & 3] + (bb[e] - m) : NEGBIG;
        }
    }
    const float mloc = fmaxf(fmaxf(fmaxf(x[0], x[1]), fmaxf(x[2], x[3])), fmaxf(fmaxf(x[4], x[5]), fmaxf(x[6], x[7])));
    if (__any(mloc > 8.f)) {
        float sv[8]; float mx = NEGBIG;
#pragma unroll
        for (int e = 0; e < 8; ++e) { sv[e] = FARB ? s[e >> 2][e & 3] + bsel : (vl[e] ? s[e >> 2][e & 3] + bb[e] : NEGBIG); mx = fmaxf(mx, sv[e]); }
        mx = fmaxf(mx, __shfl_xor(mx, 16)); mx = fmaxf(mx, __shfl_xor(mx, 32));
        const float mn = fmaxf(m, mx);
        const float alpha = __builtin_amdgcn_exp2f(m - mn);
        st.m[rt] = mn; st.lacc[rt] = st.lacc[rt] * alpha;
#pragma unroll
        for (int dt = 0; dt < 4; ++dt) st.o[rt][dt] = st.o[rt][dt] * alpha;
#pragma unroll
        for (int e = 0; e < 8; ++e) x[e] = sv[e] - mn;
    }
    float p[8];
#pragma unroll
    for (int e = 0; e < 8; ++e) p[e] = __builtin_amdgcn_exp2f(x[e]);
    u32x4 pw; pw.x = pk2(p[0], p[1]); pw.y = pk2(p[2], p[3]); pw.z = pk2(p[4], p[5]); pw.w = pk2(p[6], p[7]);
    const bf16x8 pb = __builtin_bit_cast(bf16x8, pw);
    const short one = (lane & 15) == 0 ? (short)0x3F80 : (short)0;
    const bf16x8 vones = {one, one, one, one, one, one, one, one};
    st.lacc[rt] = __builtin_amdgcn_mfma_f32_16x16x32_bf16(vones, pb, st.lacc[rt], 0, 0, 0);
#pragma unroll
    for (int dt = 0; dt < 4; ++dt) st.o[rt][dt] = __builtin_amdgcn_mfma_f32_16x16x32_bf16(vf[dt], pb, st.o[rt][dt], 0, 0, 0);
}
template <int MODE, bool FARB>
__device__ __forceinline__ void a2_tile64(A2St& st, int rt, const LAS unsigned char* slot0, const LAS unsigned char* slot1, const bf16x8 (&qf)[2], int kb, int t, int head, bool rowsel, float bfar, int lane, const LAS unsigned char* bkt, const LAS float* tab) {
    const int gq = lane >> 4;
    f32x4 s[4];
    { bf16x8 kf[2][2][2]; a2_kfrags(kf[0], slot0, lane); a2_kfrags(kf[1], slot1, lane);
#pragma unroll
      for (int u = 0; u < 4; ++u) {
        s[u] = __builtin_amdgcn_mfma_f32_16x16x32_bf16(kf[u >> 1][u & 1][0], qf[0], (f32x4){0.f, 0.f, 0.f, 0.f}, 0, 0, 0);
        s[u] = __builtin_amdgcn_mfma_f32_16x16x32_bf16(kf[u >> 1][u & 1][1], qf[1], s[u], 0, 0, 0);
      } }
    const float m = st.m[rt];
    float x[16], bb[16]; bool vl[16];
    const float bsel = ((MODE != 1) || rowsel) ? bfar : -__builtin_inff();
    if (FARB) { const float c = bsel - m;
#pragma unroll
        for (int e = 0; e < 16; ++e) x[e] = s[e >> 2][e & 3] + c;
    } else {
#pragma unroll
        for (int e = 0; e < 16; ++e) {
            const int idx = kb + 32 * (e >> 3) + 8 * gq + (e & 7);
            int dist;
            if (MODE == 0) { dist = t - (16 * idx + 31); vl[e] = dist >= 0; }
            else if (MODE == 1) { dist = t - idx; vl[e] = rowsel && dist >= 0; }
            else { dist = t - idx; vl[e] = (unsigned)dist < 512u; }
            const int dc = dist < 0 ? 0 : (dist > 2047 ? 2047 : dist);
            bb[e] = tab[head * 32 + bkt[dc]];
            x[e] = vl[e] ? s[e >> 2][e & 3] + (bb[e] - m) : NEGBIG;
        }
    }
    float mloc = x[0];
#pragma unroll
    for (int e = 1; e < 16; ++e) mloc = fmaxf(mloc, x[e]);
    if (__any(mloc > 8.f)) {
        float sv[16]; float mx = NEGBIG;
#pragma unroll
        for (int e = 0; e < 16; ++e) { sv[e] = FARB ? s[e >> 2][e & 3] + bsel : (vl[e] ? s[e >> 2][e & 3] + bb[e] : NEGBIG); mx = fmaxf(mx, sv[e]); }
        mx = fmaxf(mx, __shfl_xor(mx, 16)); mx = fmaxf(mx, __shfl_xor(mx, 32));
        const float mn = fmaxf(m, mx);
        const float alpha = __builtin_amdgcn_exp2f(m - mn);
        st.m[rt] = mn; st.lacc[rt] = st.lacc[rt] * alpha;
#pragma unroll
        for (int dt = 0; dt < 4; ++dt) st.o[rt][dt] = st.o[rt][dt] * alpha;
#pragma unroll
        for (int e = 0; e < 16; ++e) x[e] = sv[e] - mn;
    }
    float p[16];
#pragma unroll
    for (int e = 0; e < 16; ++e) p[e] = __builtin_amdgcn_exp2f(x[e]);
    const short one = (lane & 15) == 0 ? (short)0x3F80 : (short)0;
    const bf16x8 vones = {one, one, one, one, one, one, one, one};
#pragma unroll
    for (int hh = 0; hh < 2; ++hh) {
        u32x4 pw; pw.x = pk2(p[8 * hh + 0], p[8 * hh + 1]); pw.y = pk2(p[8 * hh + 2], p[8 * hh + 3]); pw.z = pk2(p[8 * hh + 4], p[8 * hh + 5]); pw.w = pk2(p[8 * hh + 6], p[8 * hh + 7]);
        const bf16x8 pb = __builtin_bit_cast(bf16x8, pw);
        bf16x8 vf[4]; a2_vfrags(vf, hh == 0 ? slot0 : slot1, lane);
        st.lacc[rt] = __builtin_amdgcn_mfma_f32_16x16x32_bf16(vones, pb, st.lacc[rt], 0, 0, 0);
#pragma unroll
        for (int dt = 0; dt < 4; ++dt) st.o[rt][dt] = __builtin_amdgcn_mfma_f32_16x16x32_bf16(vf[dt], pb, st.o[rt][dt], 0, 0, 0);
    }
}
template <int MODE>
__device__ __forceinline__ void a2_tile64b(A2St& st, int rt, const LAS unsigned char* slot0, const LAS unsigned char* slot1, const bf16x8 (&qf)[2], bool rowsel, int lane, const LAS _Float16* bt) {
    f32x4 s[4];
    { bf16x8 kf[2][2][2]; a2_kfrags(kf[0], slot0, lane); a2_kfrags(kf[1], slot1, lane);
#pragma unroll
      for (int u = 0; u < 4; ++u) {
        s[u] = __builtin_amdgcn_mfma_f32_16x16x32_bf16(kf[u >> 1][u & 1][0], qf[0], (f32x4){0.f, 0.f, 0.f, 0.f}, 0, 0, 0);
        s[u] = __builtin_amdgcn_mfma_f32_16x16x32_bf16(kf[u >> 1][u & 1][1], qf[1], s[u], 0, 0, 0);
      } }
    const float m = st.m[rt];
    const float rsel = ((MODE != 1) || rowsel) ? 0.f : -__builtin_inff();
    const float c = rsel - m;
    float x[16];
#pragma unroll
    for (int e = 0; e < 16; ++e) x[e] = s[e >> 2][e & 3] + ((float)bt[(7 - (e & 7)) + 32 * (1 - (e >> 3))] + c);
    const float mloc = fmaxf(fmaxf(fmaxf(fmaxf(x[0], x[1]), fmaxf(x[2], x[3])), fmaxf(fmaxf(x[4], x[5]), fmaxf(x[6], x[7]))), fmaxf(fmaxf(fmaxf(x[8], x[9]), fmaxf(x[10], x[11])), fmaxf(fmaxf(x[12], x[13]), fmaxf(x[14], x[15]))));
    if (__any(mloc > 8.f)) {
        float sv[16]; float mx = NEGBIG;
#pragma unroll
        for (int e = 0; e < 16; ++e) { sv[e] = s[e >> 2][e & 3] + ((float)bt[(7 - (e & 7)) + 32 * (1 - (e >> 3))] + rsel); mx = fmaxf(mx, sv[e]); }
        mx = fmaxf(mx, __shfl_xor(mx, 16)); mx = fmaxf(mx, __shfl_xor(mx, 32));
        const float mn = fmaxf(m, mx);
        const float alpha = __builtin_amdgcn_exp2f(m - mn);
        st.m[rt] = mn; st.lacc[rt] = st.lacc[rt] * alpha;
#pragma unroll
        for (int dt = 0; dt < 4; ++dt) st.o[rt][dt] = st.o[rt][dt] * alpha;
#pragma unroll
        for (int e = 0; e < 16; ++e) x[e] = sv[e] - mn;
    }
    float p[16];
#pragma unroll
    for (int e = 0; e < 16; ++e) p[e] = __builtin_amdgcn_exp2f(x[e]);
    const short one = (lane & 15) == 0 ? (short)0x3F80 : (short)0;
    const bf16x8 vones = {one, one, one, one, one, one, one, one};
#pragma unroll
    for (int hh = 0; hh < 2; ++hh) {
        u32x4 pw; pw.x = pk2(p[8 * hh + 0], p[8 * hh + 1]); pw.y = pk2(p[8 * hh + 2], p[8 * hh + 3]); pw.z = pk2(p[8 * hh + 4], p[8 * hh + 5]); pw.w = pk2(p[8 * hh + 6], p[8 * hh + 7]);
        const bf16x8 pb = __builtin_bit_cast(bf16x8, pw);
        bf16x8 vf[4]; a2_vfrags(vf, hh == 0 ? slot0 : slot1, lane);
        st.lacc[rt] = __builtin_amdgcn_mfma_f32_16x16x32_bf16(vones, pb, st.lacc[rt], 0, 0, 0);
#pragma unroll
        for (int dt = 0; dt < 4; ++dt) st.o[rt][dt] = __builtin_amdgcn_mfma_f32_16x16x32_bf16(vf[dt], pb, st.o[rt][dt], 0, 0, 0);
    }
}
__device__ __forceinline__ void a2_finish(const A2St& st, f32x4 (&acc)[2][4], const float (&gate)[2], int lane_) {
#pragma unroll
    for (int rt = 0; rt < 2; ++rt) {
        const float l = __shfl(st.lacc[rt][0], lane_ & 15);
        const float sc = (st.m[rt] > -1e29f) ? gate[rt] / l : 0.f;
#pragma unroll
        for (int dt = 0; dt < 4; ++dt) acc[rt][dt] += st.o[rt][dt] * sc;
    }
}
#define A2_WAITV(n) asm volatile("s_waitcnt vmcnt(" #n ")" ::: "memory")
__device__ __forceinline__ void a2_stage2(LAS unsigned char* ring, int ps, const gbf* Kg, const gbf* VTg, int vpitch, int kbA, int kbB, int wave, int lane, bool withV) {
    a2_stage(ring + (2 * ps) * A2_SLOT, Kg, VTg, vpitch, kbA, wave, lane, withV);
    a2_stage(ring + (2 * ps + 1) * A2_SLOT, Kg, VTg, vpitch, kbB, wave, lane, withV);
}
__device__ __forceinline__ unsigned a2_voff(int wave, int lane, int vpitch) {
    if (wave < 4) { const int row = 8 * wave + (lane >> 3), pp = lane & 7; return (unsigned)(row * 64 + ((pp ^ a2_fk(row)) * 8)) * 2u; }
    const int v = wave - 4, d = 16 * v + (lane >> 2), pp = lane & 3; return (unsigned)(d * vpitch + ((pp ^ a2_gv(d)) * 8)) * 2u;
}
__device__ __forceinline__ void a2_stage_blk(LAS unsigned char* ring, int bslot, const GAS char* Kb, const GAS char* Vb, int blk, int wave, unsigned voff) {
    LAS unsigned char* s0 = ring + (2 * bslot) * A2_SLOT;
    if (wave < 4) { const GAS char* b = Kb + (size_t)blk * 8192;
        __builtin_amdgcn_global_load_lds((const GAS unsigned*)(b + voff), (LAS unsigned*)(s0 + wave * 1024), 16, 0, 0);
        __builtin_amdgcn_global_load_lds((const GAS unsigned*)(b + 4096 + voff), (LAS unsigned*)(s0 + A2_SLOT + wave * 1024), 16, 0, 0);
    } else { const int v = wave - 4; const GAS char* b = Vb + (size_t)blk * 128;
        __builtin_amdgcn_global_load_lds((const GAS unsigned*)(b + voff), (LAS unsigned*)(s0 + 4096 + v * 1024), 16, 0, 0);
        __builtin_amdgcn_global_load_lds((const GAS unsigned*)(b + 64 + voff), (LAS unsigned*)(s0 + A2_SLOT + 4096 + v * 1024), 16, 0, 0); }
}
#define A2_BARRIER() do { asm volatile("" ::: "memory"); __builtin_amdgcn_s_barrier(); asm volatile("" ::: "memory"); } while (0)

#ifndef MK_REP_P1
#define MK_REP_P1 1
#endif
#ifndef MK_REP_P2
#define MK_REP_P2 1
#endif
#ifndef MK_REP_TK
#define MK_REP_TK 1
#endif
#ifndef MK_REP_SEL
#define MK_REP_SEL 1
#endif
#ifndef MK_REP_WIN
#define MK_REP_WIN 1
#endif
__device__ __forceinline__ void nsa_unit_v2(Frame& F, const AttnPtrs& P, int qt, int g) {
    int lane_l = F.lane; asm volatile("" : "+v"(lane_l));
    const int lane = lane_l, wave = F.wave, i16 = lane & 15, gq = lane >> 4, ql = i16 >> 2, hl = i16 & 3;
    const LAS unsigned char* bkt = F.lds + A2_BKT_OFF; const LAS float* tab = (const LAS float*)(F.lds + A2_TAB_OFF);
    LAS unsigned char* ring = F.lds + A2_RING_OFF;
    LAS float* imp = (LAS float*)(F.lds + A2_IMP_OFF + wave * 8192);
    LAS unsigned* selm = (LAS unsigned*)(F.lds + A2_SELM_OFF) + wave * 64;
    LAS unsigned* orw = (LAS unsigned*)(F.lds + A2_ORW_OFF) + wave * 16;
    LAS unsigned* Uw = (LAS unsigned*)(F.lds + A2_U_OFF);
    LAS unsigned* ulist = (LAS unsigned*)(F.lds + A2_LIST_OFF);
    const int t0 = 64 * qt, tw = t0 + 8 * wave, cur = qt, head = 4 * g + hl;
    int tq[2]; tq[0] = tw + ql; tq[1] = tw + 4 + ql;
    bf16x8 qf[2][2]; float g_c[2], g_s[2], g_w[2];
#pragma unroll
    for (int rt = 0; rt < 2; ++rt) { const gbf* qp = P.Q + (size_t)tq[rt] * NSAW + head * 64 + 8 * gq; qf[rt][0] = *(const GAS bf16x8*)qp; qf[rt][1] = *(const GAS bf16x8*)(qp + 32);
        const gfl* gp = P.GL + (size_t)tq[rt] * 48 + head * 3; g_c[rt] = (MK_BR & 1) ? gp[0] : 0.f; g_s[rt] = (MK_BR & 2) ? gp[1] : 0.f; g_w[rt] = (MK_BR & 4) ? gp[2] : 0.f; }
    const float bfar = tab[head * 32 + 31];
    f32x4 acc[2][4];
#pragma unroll
    for (int r = 0; r < 2; ++r)
#pragma unroll
        for (int i = 0; i < 4; ++i) acc[r][i] = (f32x4){0.f, 0.f, 0.f, 0.f};
    A2St st;
    A2_WAITV(0);
    const gbf* KCg = P.KC + (size_t)g * 1024 * 64; const gbf* VCTg = P.VCT + (size_t)g * 64 * 1024;
    const int nlast = (t0 + 63 - 31) / 16;
    const int Tc = (nlast / 32 + 2) & ~1;
    const int Pc = Tc >> 1;
    a2_reset(st);
#pragma unroll 1
    for (int rep_ = 0; rep_ < MK_REP_P1; ++rep_) { a2_reset(st); A2_BARRIER();
    {
        a2_stage2(ring, 0, KCg, VCTg, 1024, 0, 32, wave, lane, true);
        if (Pc > 1) a2_stage2(ring, 1, KCg, VCTg, 1024, 64, 96, wave, lane, true);
#pragma unroll 1
        for (int j = 0; j < Pc; ++j) {
            if (j + 1 < Pc) A2_WAITV(2); else A2_WAITV(0);
            A2_BARRIER();
            if (j + 2 < Pc) a2_stage2(ring, (j + 2) % 3, KCg, VCTg, 1024, 64 * (j + 2), 64 * (j + 2) + 32, wave, lane, true);
            if (tw - (16 * (64 * j + 63) + 31) >= 1513) {
                const LAS unsigned char* slot0 = ring + (2 * (j % 3)) * A2_SLOT; const LAS unsigned char* slot1 = slot0 + A2_SLOT;
#pragma unroll
                for (int rt = 0; rt < 2; ++rt) a2_tile64<0, true>(st, rt, slot0, slot1, qf[rt], 64 * j, tq[rt], head, true, bfar, lane, bkt, tab);
            } else
#pragma unroll 1
            for (int hh = 0; hh < 2; ++hh) {
                const LAS unsigned char* slot = ring + (2 * (j % 3) + hh) * A2_SLOT; const int kb = 64 * j + 32 * hh;
                bf16x8 kf[2][2], vf[4]; a2_kfrags(kf, slot, lane); a2_vfrags(vf, slot, lane);
                const bool farb = tw - (16 * (kb + 31) + 31) >= 1513;
#pragma unroll
                for (int rt = 0; rt < 2; ++rt) {
                    if (farb) a2_tile<0, true>(st, rt, kf, vf, qf[rt], kb, tq[rt], head, true, bfar, lane, bkt, tab); else a2_tile<0, false>(st, rt, kf, vf, qf[rt], kb, tq[rt], head, true, bfar, lane, bkt, tab); }
            }
        }
    }
    }
    a2_finish(st, acc, g_c, lane);
#pragma unroll 1
    for (int rep_ = 0; rep_ < MK_REP_P2; ++rep_) {
    if (cur >= 16) {
        float inv_l[2], mfin[2], carry[2];
#pragma unroll
        for (int rt = 0; rt < 2; ++rt) { const float lt = __shfl(st.lacc[rt][0], lane & 15); inv_l[rt] = (st.m[rt] > -1e29f) ? 1.f / lt : 0.f; mfin[rt] = st.m[rt]; carry[rt] = 0.f; }
        A2_BARRIER();
        a2_stage2(ring, 0, KCg, VCTg, 1024, 0, 32, wave, lane, false);
        if (Pc > 1) a2_stage2(ring, 1, KCg, VCTg, 1024, 64, 96, wave, lane, false);
#pragma unroll 1
        for (int j = 0; j < Pc; ++j) {
            if (j + 1 < Pc) A2_WAITV(2); else A2_WAITV(0);
            A2_BARRIER();
            if (j + 2 < Pc) a2_stage2(ring, (j + 2) % 3, KCg, VCTg, 1024, 64 * (j + 2), 64 * (j + 2) + 32, wave, lane, false);
#pragma unroll 1
          for (int hh = 0; hh < 2; ++hh) {
            const LAS unsigned char* slot = ring + (2 * (j % 3) + hh) * A2_SLOT; const int kb = 64 * j + 32 * hh;
            bf16x8 kf[2][2]; a2_kfrags(kf, slot, lane);
            const bool farb = tw - (16 * (kb + 31) + 31) >= 1513;
#pragma unroll
            for (int rt = 0; rt < 2; ++rt) { float sv[8];
                if (farb) a2_scores<0, true>(sv, kf, qf[rt], kb, tq[rt], head, true, bfar, lane, bkt, tab); else a2_scores<0, false>(sv, kf, qf[rt], kb, tq[rt], head, true, bfar, lane, bkt, tab);
                float ps[8];
#pragma unroll
                for (int e = 0; e < 8; ++e) ps[e] = (sv[e] > -1e29f) ? __builtin_amdgcn_exp2f(sv[e] - mfin[rt]) : 0.f;
                float a0 = ps[0] + ps[1] + ps[2] + 0.5f * ps[3]; const float c0 = 0.5f * ps[3];
                float a1 = ps[4] + ps[5] + ps[6] + 0.5f * ps[7] + c0, c1 = 0.5f * ps[7];
                a0 *= inv_l[rt]; a1 *= inv_l[rt]; c1 *= inv_l[rt];
                a0 += __builtin_bit_cast(float, __builtin_amdgcn_update_dpp(0, __builtin_bit_cast(int, a0), 0xB1, 0xF, 0xF, true)); a0 += __builtin_bit_cast(float, __builtin_amdgcn_update_dpp(0, __builtin_bit_cast(int, a0), 0x4E, 0xF, 0xF, true));
                a1 += __builtin_bit_cast(float, __builtin_amdgcn_update_dpp(0, __builtin_bit_cast(int, a1), 0xB1, 0xF, 0xF, true)); a1 += __builtin_bit_cast(float, __builtin_amdgcn_update_dpp(0, __builtin_bit_cast(int, a1), 0x4E, 0xF, 0xF, true));
                c1 += __builtin_bit_cast(float, __builtin_amdgcn_update_dpp(0, __builtin_bit_cast(int, c1), 0xB1, 0xF, 0xF, true)); c1 += __builtin_bit_cast(float, __builtin_amdgcn_update_dpp(0, __builtin_bit_cast(int, c1), 0x4E, 0xF, 0xF, true));
                const float sh = __shfl(c1, (lane + 48) & 63);
                a0 += (gq == 0) ? carry[rt] : sh; carry[rt] = sh;
                const int j0 = (kb + 8 * gq) >> 2;
                if (hl == 0) { imp[(4 * rt + ql) * 256 + j0] = a0; imp[(4 * rt + ql) * 256 + j0 + 1] = a1; }
            }
          }
        }
    }
    }
    LDS_WAIT();
    unsigned uacc = 0u;
#pragma unroll 1
    for (int rep_ = 0; rep_ < MK_REP_TK; ++rep_) {
#pragma unroll 1
    for (int q4 = 0; q4 < 8; q4 += 4) {
        unsigned mword[4] = {0u, 0u, 0u, 0u};
        if (cur <= 15) { if (lane == 0) { mword[0] = (2u << cur) - 1u; mword[1] = mword[0]; mword[2] = mword[0]; mword[3] = mword[0]; } }
        else {
            unsigned key[4][4];
#pragma unroll
            for (int qq = 0; qq < 4; ++qq)
#pragma unroll
                for (int e = 0; e < 4; ++e) { const int j = 4 * lane + e; const bool cand = (j >= 1) && (j <= cur - 2); const float v = imp[(q4 + qq) * 256 + j];
                    key[qq][e] = cand ? ((__builtin_bit_cast(unsigned, v) & 0xffffff00u) | (unsigned)(255 - j)) : 0u; }
#pragma unroll 1
            for (int round = 0; round < 13; ++round) {
#pragma unroll
                for (int qq = 0; qq < 4; ++qq) {
                    unsigned best = key[qq][0] > key[qq][1] ? key[qq][0] : key[qq][1]; const unsigned b2 = key[qq][2] > key[qq][3] ? key[qq][2] : key[qq][3]; best = best > b2 ? best : b2;
                    const unsigned wk = wave_max_u32_dpp(best);
                    const int js = 255 - (int)(wk & 255u);
#pragma unroll
                    for (int e = 0; e < 4; ++e) key[qq][e] = (key[qq][e] == wk) ? 0u : key[qq][e];
                    if (lane == (js >> 5)) mword[qq] |= 1u << (js & 31);
                }
            }
#pragma unroll
            for (int qq = 0; qq < 4; ++qq) {
                if (lane == 0) mword[qq] |= 1u;
                if (lane == (cur >> 5)) mword[qq] |= 1u << (cur & 31);
                if (lane == ((cur - 1) >> 5)) mword[qq] |= 1u << ((cur - 1) & 31);
            }
        }
#pragma unroll
        for (int qq = 0; qq < 4; ++qq) { if (lane < 8) selm[(q4 + qq) * 8 + lane] = mword[qq]; uacc |= mword[qq]; }
    }
    }
    LDS_WAIT();
    GAS f32x4* stash = (GAS f32x4*)(F.ws + WS_Y1) + (size_t)(F.vcu * NWAVES + wave) * 512;
#pragma unroll
    for (int rt = 0; rt < 2; ++rt)
#pragma unroll
        for (int dt = 0; dt < 4; ++dt) stash[(rt * 4 + dt) * 64 + lane] = acc[rt][dt];
    if (lane < 16) { const int rt = lane >> 3, w = lane & 7; orw[lane] = selm[(4 * rt) * 8 + w] | selm[(4 * rt + 1) * 8 + w] | selm[(4 * rt + 2) * 8 + w] | selm[(4 * rt + 3) * 8 + w]; }
    if (F.tid < 9) Uw[F.tid] = 0u;
    LDS_WAIT(); A2_BARRIER();
    if (lane < 8) (void)__hip_atomic_fetch_or(Uw + lane, uacc, __ATOMIC_RELAXED, __HIP_MEMORY_SCOPE_WORKGROUP);
    LDS_WAIT(); A2_BARRIER();
    if (wave == 0) {
        int base = 0;
#pragma unroll 1
        for (int c = 0; c < 4; ++c) {
            const unsigned word = Uw[2 * c + (lane >> 5)]; const bool bit = (word >> (lane & 31)) & 1u;
            const unsigned long long bal = __ballot(bit);
            const int pos = base + (int)__builtin_amdgcn_mbcnt_hi((unsigned)(bal >> 32), __builtin_amdgcn_mbcnt_lo((unsigned)bal, 0u));
            if (bit) ulist[pos] = (unsigned)(64 * c + lane);
            base += __popcll(bal);
        }
        if (lane == 0) Uw[8] = (unsigned)base;
    }
    LDS_WAIT(); A2_BARRIER();
    {
        LAS _Float16* btw = (LAS _Float16*)(F.lds + A2_BT_OFF);
#pragma unroll 1
        for (int i = F.tid; i < 4 * A2_BT_N; i += NWAVES * 64) { const int h = i / A2_BT_N, d = i - h * A2_BT_N; btw[i] = (_Float16)tab[(4 * g + h) * 32 + bkt[d]]; }
        LDS_WAIT();
    }
    const LAS _Float16* btl = (const LAS _Float16*)(F.lds + A2_BT_OFF) + hl * A2_BT_N;
    int lanes = lane; asm volatile("" : "+v"(lanes));
    const gbf* KSg = P.KSEL + (size_t)g * S_ * 64; const gbf* VSTg = P.VSELT + (size_t)g * 64 * S_;
    a2_reset(st);
#pragma unroll 1
    for (int rep_ = 0; rep_ < MK_REP_SEL; ++rep_) { a2_reset(st); A2_BARRIER();
    {
        const int Ps = (int)__builtin_amdgcn_readfirstlane((int)Uw[8]);
        const GAS char* KSb = (const GAS char*)KSg; const GAS char* VSb = (const GAS char*)VSTg;
        const unsigned voffS = a2_voff(wave, lanes, S_);
        unsigned ulc = ulist[lanes], uln = ulist[64 + lanes]; int chunk = 0;
#define A2_UL(j) (((j) >> 6) == chunk ? __builtin_amdgcn_readlane((int)ulc, (j) & 63) : __builtin_amdgcn_readlane((int)uln, (j) & 63))
#pragma unroll
        for (int bi = 0; bi < 3; ++bi) if (bi < Ps) a2_stage_blk(ring, bi, KSb, VSb, A2_UL(bi), wave, voffS);
        LAS unsigned* selc = (LAS unsigned*)(F.lds + A2_SELC_OFF) + wave * 64; LAS unsigned* orc = (LAS unsigned*)(F.lds + A2_ORC_OFF) + wave * 16;
        int jfar = 0;
        { const int thr = (tw >= 1576) ? ((tw - 1576) >> 6) : -1;
#pragma unroll 1
          for (int ps = 0; ps < 4 && 64 * ps < Ps; ++ps) { const int jj = 64 * ps + lane; const bool vj = jj < Ps; const int bk = vj ? (int)ulist[jj] : 0; const int w = bk >> 5, b = bk & 31;
              jfar += __popcll(__ballot(vj && bk <= thr));
#pragma unroll
              for (int q = 0; q < 8; ++q) { const unsigned long long bal = __ballot(vj && ((selm[q * 8 + w] >> b) & 1u)); if (lane == 0) { selc[q * 8 + 2 * ps] = (unsigned)bal; selc[q * 8 + 2 * ps + 1] = (unsigned)(bal >> 32); } } }
          LDS_WAIT();
          if (lane < 16) { const int rt = lane >> 3, w = lane & 7; orc[lane] = selc[(4 * rt) * 8 + w] | selc[(4 * rt + 1) * 8 + w] | selc[(4 * rt + 2) * 8 + w] | selc[(4 * rt + 3) * 8 + w]; }
          LDS_WAIT(); }
        unsigned or0 = 0u, or1 = 0u, my0 = 0u, my1 = 0u;
        const int NS3 = (Ps + 2) / 3;
#pragma unroll 1
        for (int sp = 0; sp < NS3; ++sp) {
            const int j0 = 3 * sp;
            if ((j0 >> 6) != chunk) { chunk = j0 >> 6; ulc = uln; if (chunk < 3) uln = ulist[(chunk + 1) * 64 + lanes]; }
            A2_WAITV(0);
            A2_BARRIER();
#pragma unroll
            for (int bi = 0; bi < 3; ++bi) { const int jn = j0 + 3 + bi; if (jn < Ps) a2_stage_blk(ring, ((sp + 1) & 1) * 3 + bi, KSb, VSb, A2_UL(jn), wave, voffS); }
#pragma unroll 1
            for (int bi = 0; bi < 3; ++bi) {
                const int j = j0 + bi; if (j >= Ps) break;
                const int b = j & 31;
                if (b == 0) { const int jw = j >> 5; or0 = (unsigned)__builtin_amdgcn_readfirstlane((int)orc[jw]); or1 = (unsigned)__builtin_amdgcn_readfirstlane((int)orc[8 + jw]); my0 = selc[ql * 8 + jw]; my1 = selc[(4 + ql) * 8 + jw]; }
                const bool need0 = (or0 >> b) & 1u, need1 = (or1 >> b) & 1u;
                if (need0 || need1) {
                    const bool rs0 = (my0 >> b) & 1u, rs1 = (my1 >> b) & 1u;
                    const bool farb = j < jfar;
                    const int blk = farb ? 0 : A2_UL(j);
                    const LAS unsigned char* slot0 = ring + (2 * ((sp & 1) * 3 + bi)) * A2_SLOT; const LAS unsigned char* slot1 = slot0 + A2_SLOT;
#pragma unroll
                    for (int rt = 0; rt < 2; ++rt) {
                        if (rt == 0 ? need0 : need1) { const bool rs = rt == 0 ? rs0 : rs1;
                            if (farb) a2_tile64<1, true>(st, rt, slot0, slot1, qf[rt], blk * 64, tq[rt], head, rs, bfar, lanes, bkt, tab);
                            else if (blk * 64 + 63 <= tw + 4 * rt) a2_tile64b<1>(st, rt, slot0, slot1, qf[rt], rs, lanes, btl + (tq[rt] - (blk * 64 + 32 + 8 * gq + 7)));
                            else {
#pragma unroll 1
                                for (int hh = 0; hh < 2; ++hh) { bf16x8 kf[2][2], vf[4]; a2_kfrags(kf, hh ? slot1 : slot0, lanes); a2_vfrags(vf, hh ? slot1 : slot0, lanes);
                                    a2_tile<1, false>(st, rt, kf, vf, qf[rt], blk * 64 + 32 * hh, tq[rt], head, rs, bfar, lanes, bkt, tab); } } }
                    }
                }
            }
        }
    }
    }
    {
#pragma unroll
        for (int rt = 0; rt < 2; ++rt)
#pragma unroll
            for (int dt = 0; dt < 4; ++dt) acc[rt][dt] = (f32x4){0.f, 0.f, 0.f, 0.f};
        a2_finish(st, acc, g_s, lane);
#pragma unroll
        for (int rt = 0; rt < 2; ++rt)
#pragma unroll
            for (int dt = 0; dt < 4; ++dt) stash[(rt * 4 + dt) * 64 + lane] += acc[rt][dt];
        LDS_WAIT();
    }
    const gbf* KWg = P.KWIN + (size_t)g * S_ * 64; const gbf* VWTg = P.VWINT + (size_t)g * 64 * S_;
    a2_reset(st);
    int lanew = lane; asm volatile("" : "+v"(lanew));
#pragma unroll 1
    for (int rep_ = 0; rep_ < MK_REP_WIN; ++rep_) { a2_reset(st); A2_BARRIER();
    {
        int kb0 = t0 - 511; kb0 = kb0 < 0 ? 0 : (kb0 & ~31);
        const int Pw = ((t0 + 63 - kb0) / 32 + 1) >> 1;
        A2_BARRIER();
        a2_stage2(ring, 0, KWg, VWTg, S_, kb0, kb0 + 32, wave, lanew, true);
        if (Pw > 1) a2_stage2(ring, 1, KWg, VWTg, S_, kb0 + 64, kb0 + 96, wave, lanew, true);
#pragma unroll 1
        for (int j = 0; j < Pw; ++j) {
            if (j + 1 < Pw) A2_WAITV(2); else A2_WAITV(0);
            A2_BARRIER();
            if (j + 2 < Pw) a2_stage2(ring, (j + 2) % 3, KWg, VWTg, S_, kb0 + 64 * (j + 2), kb0 + 64 * (j + 2) + 32, wave, lanew, true);
            const int kbp = kb0 + 64 * j;
            if (kbp + 63 <= tw && tw + 7 - kbp <= 511) {
                const LAS unsigned char* slot0 = ring + (2 * (j % 3)) * A2_SLOT; const LAS unsigned char* slot1 = slot0 + A2_SLOT;
#pragma unroll
                for (int rt = 0; rt < 2; ++rt) a2_tile64b<2>(st, rt, slot0, slot1, qf[rt], true, lanew, btl + (tq[rt] - (kbp + 32 + 8 * gq + 7)));
            } else
#pragma unroll 1
            for (int hh = 0; hh < 2; ++hh) {
                const int kb = kb0 + 64 * j + 32 * hh;
                if (kb <= tw + 7 && kb + 31 >= tw - 511) {
                    const LAS unsigned char* slot = ring + (2 * (j % 3) + hh) * A2_SLOT;
                    bf16x8 kf[2][2], vf[4]; a2_kfrags(kf, slot, lanew); a2_vfrags(vf, slot, lanew);
#pragma unroll
                    for (int rt = 0; rt < 2; ++rt) a2_tile<2, false>(st, rt, kf, vf, qf[rt], kb, tq[rt], head, true, bfar, lanew, bkt, tab);
                }
            }
        }
    }
    }
#pragma unroll
    for (int rt = 0; rt < 2; ++rt)
#pragma unroll
        for (int dt = 0; dt < 4; ++dt) acc[rt][dt] = stash[(rt * 4 + dt) * 64 + lanew];
    a2_finish(st, acc, g_w, lane);
    A2_BARRIER();
#pragma unroll
    for (int rt = 0; rt < 2; ++rt) { gbf* ap = P.A + (size_t)tq[rt] * NSAW + head * 64 + 4 * gq;
#pragma unroll
        for (int dt = 0; dt < 4; ++dt) { u32x2 w; w.x = pk2(acc[rt][dt][0], acc[rt][dt][1]); w.y = pk2(acc[rt][dt][2], acc[rt][dt][3]); *(GAS u32x2*)(ap + 16 * dt) = w; } }
}
__device__ __forceinline__ void pool_item(const gbf* U, gbf* YP, int item, int lane) {
    const int t = item >> 1, half = item & 1, gi = half * 2 + (lane >> 5), w = 2 << gi, col = half * 512 + lane * 8;
    const int cnt = (t + 1) < w ? (t + 1) : w;
    float s[8];
#pragma unroll
    for (int e = 0; e < 8; ++e) s[e] = 0.f;
    float u0[8];
    u32x4 v[16];
    if (half == 0) {
#pragma unroll
        for (int i = 0; i < 4; ++i) { const int r = (i < cnt) ? t - i : t; v[i] = *(const GAS u32x4*)(U + (size_t)r * POOLW + col); }
#pragma unroll
        for (int i = 0; i < 4; ++i) { const float f[8] = {bflo(v[i].x), bfhi(v[i].x), bflo(v[i].y), bfhi(v[i].y), bflo(v[i].z), bfhi(v[i].z), bflo(v[i].w), bfhi(v[i].w)};
#pragma unroll
            for (int e = 0; e < 8; ++e) { if (i < cnt) s[e] += f[e]; if (i == 0) u0[e] = f[e]; } }
    } else {
#pragma unroll
        for (int i = 0; i < 16; ++i) { const int r = (i < cnt) ? t - i : t; v[i] = *(const GAS u32x4*)(U + (size_t)r * POOLW + col); }
#pragma unroll
        for (int i = 0; i < 16; ++i) { const float f[8] = {bflo(v[i].x), bfhi(v[i].x), bflo(v[i].y), bfhi(v[i].y), bflo(v[i].z), bfhi(v[i].z), bflo(v[i].w), bfhi(v[i].w)};
#pragma unroll
            for (int e = 0; e < 8; ++e) { if (i < cnt) s[e] += f[e]; if (i == 0) u0[e] = f[e]; } }
    }
    const float inv = 1.f / (float)cnt;
    u32x4 o; o.x = pk2(s[0] * inv - u0[0], s[1] * inv - u0[1]); o.y = pk2(s[2] * inv - u0[2], s[3] * inv - u0[3]); o.z = pk2(s[4] * inv - u0[4], s[5] * inv - u0[5]); o.w = pk2(s[6] * inv - u0[6], s[7] * inv - u0[7]);
    *(GAS u32x4*)(YP + (size_t)t * POOLW + col) = o;
}
__device__ __forceinline__ void cmp_final_item4(const gfl* PQ, const gfl* PEB, const gfl* w2  , gbf* KC, gbf* VCT, LAS float* hid  , int item, int lane) {
    const int kv = item >> 10, g = (item >> 8) & 3, n0 = (item & 255) * 4;
    float pe[2];
#pragma unroll
    for (int hh = 0; hh < 2; ++hh) { const int j = lane + 64 * hh; pe[hh] = 0.f;
#pragma unroll
        for (int p = 0; p < 8; ++p) pe[hh] += PEB[p * 256 + kv * 128 + j]; }
#pragma unroll
    for (int i = 0; i < 4; ++i) { const int n = n0 + i;
        const gfl* p1 = PQ + ((size_t)kv * 4096 + g * 1024 + n) * 256; const gfl* p2 = p1 + 256 + 128;
#pragma unroll
        for (int hh = 0; hh < 2; ++hh) { const int j = lane + 64 * hh; hid[j * 4 + i] = (n < NCMP) ? gelu_tanh(p1[j] + p2[j] + pe[hh]) : 0.f; } }
    LDS_WAIT(); asm volatile("" ::: "memory");
    const gfl* wp = w2 + (size_t)kv * 128 * 64 + lane;
    float out[4] = {0.f, 0.f, 0.f, 0.f};
#pragma unroll 16
    for (int j = 0; j < 128; ++j) { const float w = wp[j * 64]; const f32x4 h = *(const LAS f32x4*)(hid + 4 * j); out[0] += h.x * w; out[1] += h.y * w; out[2] += h.z * w; out[3] += h.w * w; }
    LDS_WAIT(); asm volatile("" ::: "memory");
    if (kv == 0) {
#pragma unroll
        for (int i = 0; i < 4; ++i) KC[((size_t)g * 1024 + n0 + i) * 64 + lane] = (bf16)f2bf(out[i]);
    } else { u32x2 w; w.x = pk2(out[0], out[1]); w.y = pk2(out[2], out[3]); *(GAS u32x2*)(VCT + ((size_t)g * 64 + lane) * 1024 + n0) = w; }
}

struct Args { const float* in[25]; float* out; unsigned char* ws; int l_lo, l_hi, ph_lo, ph_hi, use_bar, pad; };
enum { I_X = 0, I_MEM, I_RELB, I_LN_MIX_PRE, I_LN_MIX_POST, I_LN_X_PRE, I_LN_X_POST, I_LN_MEM, I_LN_FFN_PRE, I_LN_FFN_POST, I_W_IN, I_CMP_PE, I_CMP_W1, I_CMP_W2, I_W_POOL, I_POOL_SCALE,
       I_W_BR_ATTN, I_W_BR_POOL, I_W_MIX_OUT, I_W_XQ, I_W_XKV, I_W_XO, I_W_GATE, I_W_UP, I_W_DOWN };
constexpr int NPHASE = 17;
constexpr int TR_SCR_STRIDE = 12288, TR_TAB_OFF = 8 * TR_SCR_STRIDE;
__device__ __forceinline__ gby* launder_ptr(gby* p) { asm volatile("" : "+s"(p)); return p; }
__device__ __forceinline__ int launder_int(int v) { asm volatile("" : "+s"(v)); return v; }
template <class T> __device__ __forceinline__ T* uniform_ptr(T* p) { const unsigned long long v = (unsigned long long)p; const unsigned lo = (unsigned)__builtin_amdgcn_readfirstlane((int)(unsigned)v), hi = (unsigned)__builtin_amdgcn_readfirstlane((int)(unsigned)(v >> 32)); return (T*)(((unsigned long long)hi << 32) | lo); }

struct TrCur { const gfl* W; gbf* WT; const gfl* cs; int N, ldk, code, moff, item; };
__device__ __forceinline__ TrCur tr_lookup(const LAS TrDesc* tab, int nd, int it) {
    int d = 0;
#pragma unroll 1
    for (int e = 1; e < nd; ++e) if (tab[e].start <= it) d = e;
    d = __builtin_amdgcn_readfirstlane(d);
    TrCur c; c.W = uniform_ptr(tab[d].W); c.WT = uniform_ptr(tab[d].WT); c.cs = uniform_ptr(tab[d].cs);
    c.N = __builtin_amdgcn_readfirstlane(tab[d].N); c.ldk = __builtin_amdgcn_readfirstlane(tab[d].ldk); c.code = __builtin_amdgcn_readfirstlane(tab[d].code); c.moff = __builtin_amdgcn_readfirstlane(tab[d].moff);
    c.item = it - __builtin_amdgcn_readfirstlane(tab[d].start); return c;
}
__device__ __forceinline__ void tr_run(Frame& F, int nd, int total) {
    const LAS TrDesc* tab = (const LAS TrDesc*)(F.lds + TR_TAB_OFF); LAS float* scr = (LAS float*)(F.lds + F.wave * TR_SCR_STRIDE);
    int it = F.gw;
    if (it >= total) return;
    TrCur A = tr_lookup(tab, nd, it), B = A;
    float wa[32], wb[32], csa, csb; tr_load(wa, csa, A.W, A.N, A.item, F.lane, (A.code & 8) ? (const gfl*)nullptr : A.cs);
#pragma unroll 1
    for (;;) {
        it += F.NGW;
        if (it >= total) { tr_store(wa, csa, A.N, A.WT, A.ldk, scr, A.item, F.lane, A.code & 7, A.moff, (A.code & 8) ? A.cs : (const gfl*)nullptr); break; }
        B = tr_lookup(tab, nd, it); tr_load(wb, csb, B.W, B.N, B.item, F.lane, (B.code & 8) ? (const gfl*)nullptr : B.cs);
        tr_store(wa, csa, A.N, A.WT, A.ldk, scr, A.item, F.lane, A.code & 7, A.moff, (A.code & 8) ? A.cs : (const gfl*)nullptr);
        it += F.NGW;
        if (it >= total) { tr_store(wb, csb, B.N, B.WT, B.ldk, scr, B.item, F.lane, B.code & 7, B.moff, (B.code & 8) ? B.cs : (const gfl*)nullptr); break; }
        A = tr_lookup(tab, nd, it); tr_load(wa, csa, A.W, A.N, A.item, F.lane, (A.code & 8) ? (const gfl*)nullptr : A.cs);
        tr_store(wb, csb, B.N, B.WT, B.ldk, scr, B.item, F.lane, B.code & 7, B.moff, (B.code & 8) ? B.cs : (const gfl*)nullptr);
    }
}
#define TR_PUT(W_, K_, N_, WT_, ldk_, code_, moff_, cs_) do { tab[nd].W = (W_); tab[nd].WT = (WT_); tab[nd].cs = (cs_); tab[nd].K = (K_); tab[nd].N = (N_); tab[nd].ldk = (ldk_); tab[nd].code = (code_); tab[nd].moff = (moff_); \
    tab[nd].start = total; total += ((K_) / 64) * (((N_) + 31) / 32); ++nd; } while (0)

#ifdef MK_TIMING
#define TS0() const unsigned long long ts0_ = __builtin_amdgcn_s_memrealtime()
#define TS1(k) do { const unsigned dt_ = (unsigned)(__builtin_amdgcn_s_memrealtime() - ts0_); if ((MK_T1MASK >> (k)) & 1) tacc1 += dt_; if ((MK_T2MASK >> (k)) & 1) tacc2 += dt_; } while (0)
#else
#define TS0() do {} while (0)
#define TS1(k) do {} while (0)
#endif
#define PHASE_BEGIN() gby* const w_ = launder_ptr(ws_k); const int b_ = launder_int(bid_k); Frame F = F0; \
    { int t_ = launder_int(F0.wave) * 64 + (int)__builtin_amdgcn_mbcnt_hi(~0u, __builtin_amdgcn_mbcnt_lo(~0u, 0u)); asm volatile("" : "+v"(t_)); const int v_ = launder_int(F0.vcu); F.tid = t_; F.lane = t_ & 63; F.wave = __builtin_amdgcn_readfirstlane(t_ >> 6); F.vcu = v_; F.gw = v_ * NWAVES + F.wave; F.ws = w_; }
__global__ void __launch_bounds__(NWAVES * 64, 2) mega_fwd(Args args) {
    extern __shared__ __attribute__((aligned(16))) unsigned char lds_raw[];
    Frame F;
    F.lds = (LAS unsigned char*)lds_raw;
    F.tid = threadIdx.x; F.lane = F.tid & 63; F.wave = __builtin_amdgcn_readfirstlane(F.tid >> 6);
    F.G = gridDim.x; { const int bx = blockIdx.x; F.vcu = (F.G % 8 == 0) ? (bx % 8) * (F.G / 8) + bx / 8 : bx; }
    F.gw = F.vcu * NWAVES + F.wave; F.NGW = F.G * NWAVES; F.ws = (gby*)args.ws;
    gby* const ws = (gby*)args.ws; gby* const ws_k = ws;
#define INP(i) ((const gfl*)args.in[i])
    volatile LAS unsigned* MISC = (volatile LAS unsigned*)(F.lds + MISC_OFF);
    for (int u = F.tid; u < (LDS_BYTES - LDSCTL_OFF) / 4; u += NWAVES * 64) ((LAS unsigned*)(F.lds + LDSCTL_OFF))[u] = 0u;
    __syncthreads();
    XcdBarrier bar; bar.bar = (GAS unsigned*)(ws + WS_CTL) + CW_BAR; bar.x = 0; bar.st = nullptr;
    const bool use_bar = args.use_bar != 0;
    if (use_bar) bar = xcd_barrier_post((GAS unsigned*)(ws + WS_CTL) + CW_BAR, MISC + 8);
#define SEAM() do { if (use_bar) xcd_barrier(bar, F.tid == 0); } while (0)
    const int phmask = (int)(((1u << args.ph_hi) - 1u) & ~((1u << args.ph_lo) - 1u));
#ifndef PHMASK
#define PHMASK 0x1ffff
#endif
#define IN(k) (((PHMASK >> (k)) & 1) && ((launder_int(phmask) >> (k)) & 1))
    gfl* const X = (gfl*)args.out;
    gbf* const H = (gbf*)(ws + WS_H);
    const int bid = (int)blockIdx.x; const int bid_k = bid;
    LAS int* const trn = (LAS int*)(F.lds + TR_TAB_OFF + 32 * 48);
    unsigned tacc1 = 0u, tacc2 = 0u; (void)tacc1; (void)tacc2;

    if (args.l_lo == 0 && IN(0)) { TS0();
        if (F.tid == 0) { LAS TrDesc* tab = (LAS TrDesc*)(F.lds + TR_TAB_OFF); int nd = launder_int(0), total = launder_int(0);
            for (int l = 0; l < NL; ++l) TR_PUT(INP(I_W_XKV) + (size_t)l * DM * 1024, DM, 1024, (gbf*)(ws + WS_WXKV2) + (size_t)l * 1024 * DM, DM, 0, 0, (const gfl*)nullptr);
            trn[0] = nd; trn[1] = total; }
        LDS_WAIT(); __syncthreads();
        tr_run(F, trn[0], trn[1]);
        for (int it = F.gw; it < 4 * NMEM; it += F.NGW) { const int l = it >> 8, r = it & 255;
            rms_row_to_bf16(INP(I_MEM) + (size_t)r * DM, INP(I_LN_MEM) + (size_t)l * DM, (gbf*)(ws + WS_MEMN2) + ((size_t)l * NMEM + r) * DM, F.lane); }
        for (int m = F.gw; m < S_; m += F.NGW) {
            const gfl* xr = INP(I_X) + (size_t)m * DM; gbf* xo = (gbf*)(ws + WS_XB) + (size_t)m * DM;
#pragma unroll
            for (int j = 0; j < 4; ++j) { const int c = F.lane + 64 * j; const f32x4 a = *(const GAS f32x4*)(xr + 8 * c), b = *(const GAS f32x4*)(xr + 8 * c + 4);
                u32x4 w; w.x = pk2(a.x, a.y); w.y = pk2(a.z, a.w); w.z = pk2(b.x, b.y); w.w = pk2(b.z, b.w); *(GAS u32x4*)(xo + 8 * c) = w; }
            rms_row_r(xr, (gfl*)(ws + WS_R) + m, F.lane);
        }
        __syncthreads();
        SEAM(); TS1(0);
    }
    const Frame F0 = F;
    const int l_lo = args.l_lo, l_hi = args.l_hi;

    if (launder_int(l_lo) <= 0 && 0 < launder_int(l_hi)) { constexpr int l = 0;
        if (IN(2)) { PHASE_BEGIN(); TS0();
            if (F.tid == 0) { LAS TrDesc* tab = (LAS TrDesc*)(F.lds + TR_TAB_OFF); int nd = launder_int(0), total = launder_int(0); const gfl* nul = nullptr;
                TR_PUT(INP(I_W_IN) + (size_t)l * DM * INW, DM, INW, (gbf*)(w_ + WS_WIN), DM, 1 | 8, 0, INP(I_LN_MIX_PRE) + (size_t)l * DM);
                for (int q = 0; q < 4; ++q) { const int kv = q >> 1, half = q & 1;
                    TR_PUT(INP(I_CMP_W1) + (((size_t)l * 2 + kv) * 2048 + half * 1024) * 128, 1024, 128, (gbf*)(w_ + WS_WC1) + (size_t)kv * 256 * 1024, 1024, 0, half * 128, nul); }
                for (int gi = 0; gi < 4; ++gi)
                    TR_PUT(INP(I_W_POOL) + ((size_t)l * 4 + gi) * 65536, 256, 256, (gbf*)(w_ + WS_WPOOL) + (size_t)gi * 65536, 256, 0, 0, INP(I_POOL_SCALE) + (size_t)l * POOLW + gi * 256);
                trn[0] = nd; trn[1] = total; }
            LDS_WAIT(); __syncthreads();
            if (F.gw < 32) {
                const int p = F.gw >> 2, kv = (F.gw >> 1) & 1, j = (F.gw & 1) * 64 + F.lane;
                const gfl* pe = INP(I_CMP_PE) + ((size_t)l * 2 + kv) * 2048 + p * 256; const gfl* w1 = INP(I_CMP_W1) + (((size_t)l * 2 + kv) * 2048 + p * 256) * 128 + j;
                float a = 0.f;
#pragma unroll 32
                for (int k = 0; k < 256; ++k) a += pe[k] * w1[(size_t)k * 128];
                ((gfl*)(w_ + WS_PEB))[p * 256 + kv * 128 + j] = a;
            }
            tr_run(F, trn[0], trn[1]);
            __syncthreads();
            SEAM(); TS1(2);
        }
        if (IN(3)) { PHASE_BEGIN(); TS0();
            pg8::Sched<S_ / 256, ZN / 256, 1, false> S; S.init(F.G, b_);
            EpiZ E{w_};
            pg8::gemm_phase<DM, DM, DM, 0, 0>(F.lds, F.tid, (const gbf*)(w_ + WS_XB), (const gbf*)(w_ + WS_WIN), S, E);
            const int c3 = ((S_ / 256) * (ZN / 256)) % F.G;
            if (b_ >= c3) {
                __syncthreads();
                if (F.tid == 0) { LAS TrDesc* tab = (LAS TrDesc*)(F.lds + TR_TAB_OFF); int nd = launder_int(0), total = launder_int(0); const gfl* nul = nullptr;
                    TR_PUT(INP(I_W_BR_ATTN) + (size_t)l * NSAW * DM, NSAW, DM, (gbf*)(w_ + WS_WBRA), NSAW, 0, 0, nul);
                    TR_PUT(INP(I_W_BR_POOL) + (size_t)l * POOLW * DM, POOLW, DM, (gbf*)(w_ + WS_WBRP), POOLW, 0, 0, nul);
                    TR_PUT(INP(I_W_MIX_OUT) + (size_t)l * DM * DM, DM, DM, (gbf*)(w_ + WS_WMIX), DM, 0, 0, nul);
                    TR_PUT(INP(I_W_XQ) + (size_t)l * DM * XW, DM, XW, (gbf*)(w_ + WS_WXQ), DM, 0 | 8, 0, INP(I_LN_X_PRE) + (size_t)l * DM);
                    TR_PUT(INP(I_W_XO) + (size_t)l * XW * DM, XW, DM, (gbf*)(w_ + WS_WXO), XW, 0, 0, nul);
                    trn[0] = nd; trn[1] = total; }
                LDS_WAIT(); __syncthreads();
                Frame F2 = F; F2.gw = (b_ - c3) * NWAVES + F.wave; F2.NGW = (F.G - c3) * NWAVES;
                tr_run(F2, trn[0], trn[1]);
                __syncthreads();
            }
            SEAM(); TS1(3);
        }
        if (IN(4)) { PHASE_BEGIN(); TS0();
            if (F.G <= 64) {
#pragma unroll 1
                for (int it = F.gw; it < 2 * S_; it += F.NGW) pool_item((const gbf*)(w_ + WS_U), (gbf*)(w_ + WS_YP), it, F.lane);
                __syncthreads();
            } else if (b_ >= 32) {
#pragma unroll 1
                for (int it = (b_ - 32) * NWAVES + F.wave; it < 2 * S_; it += (F.G - 32) * NWAVES) pool_item((const gbf*)(w_ + WS_U), (gbf*)(w_ + WS_YP), it, F.lane);
                if (F.tid == 0) { LAS TrDesc* tab = (LAS TrDesc*)(F.lds + TR_TAB_OFF); int nd = launder_int(0), total = launder_int(0); const gfl* nul = nullptr;
                    TR_PUT(INP(I_W_DOWN) + ((size_t)l * DFF + DFF / 2) * DM, DFF / 2, DM, (gbf*)(w_ + WS_WDN) + DFF / 2, DFF, 0, 0, nul);
                    trn[0] = nd; trn[1] = total; }
                LDS_WAIT(); __syncthreads();
                Frame F2 = F; F2.gw = (b_ - 32) * NWAVES + F.wave; F2.NGW = (F.G - 32) * NWAVES;
                tr_run(F2, trn[0], trn[1]);
                __syncthreads();
            }
            pg8::Sched<16, 1, 2, false> S; S.init(F.G, b_);
            EpiF32 E{(gfl*)(w_ + WS_PQ), 256, (size_t)4096 * 256};
            pg8::gemm_phase<1024, 1024, 1024, (long)(WS_VCR - WS_KCR) / 2, (long)256 * 1024>(F.lds, F.tid, (const gbf*)(w_ + WS_KCR), (const gbf*)(w_ + WS_WC1), S, E);
            SEAM(); TS1(4);
        }
        if (IN(5)) { PHASE_BEGIN(); TS0();
            LAS float* hid = (LAS float*)(F.lds + F.wave * 2048);
#pragma unroll 1
            for (int it = F.gw; it < 2048; it += F.NGW) cmp_final_item4((const gfl*)(w_ + WS_PQ), (const gfl*)(w_ + WS_PEB), INP(I_CMP_W2) + (size_t)l * 2 * 128 * 64, (gbf*)(w_ + WS_KC), (gbf*)(w_ + WS_VCT), hid, it, F.lane);
            __syncthreads();
            pg8::Sched<S_ / 256, 1, 4, false> S; S.init(F.G, b_);
            EpiBf16 E{(gbf*)(w_ + WS_P), POOLW, 256, 1.f};
            pg8::gemm_phase<POOLW, 256, 256, 256, 65536>(F.lds, F.tid, (const gbf*)(w_ + WS_YP), (const gbf*)(w_ + WS_WPOOL), S, E);
            SEAM(); TS1(5);
        }
        if (IN(6)) { PHASE_BEGIN(); TS0();
            attn_setup_tables(F, INP(I_RELB));
            const AttnPtrs P{(const gbf*)(w_ + WS_Q), (const gbf*)(w_ + WS_KC), (const gbf*)(w_ + WS_VCT), (const gbf*)(w_ + WS_KSEL), (const gbf*)(w_ + WS_VSELT), (const gbf*)(w_ + WS_KWIN), (const gbf*)(w_ + WS_VWINT),
                             (const gfl*)(w_ + WS_GL), (gbf*)(w_ + WS_A)};
#ifdef MK_CMP_ATT
            {
                gbf* A2 = (gbf*)(w_ + WS_YP);
#pragma unroll 1
                for (int it = F.gw; it < (S_ / 4) * NGRP; it += F.NGW) nsa_unit_v1(F, P, it >> 2, it & 3);
                __syncthreads();
                const AttnPtrs P2{P.Q, P.KC, P.VCT, P.KSEL, P.VSELT, P.KWIN, P.VWINT, P.GL, A2};
#pragma unroll 1
                for (int u = b_; u < (S_ / 64) * NGRP; u += F.G) { const int c = u & 255, r = u >> 8; nsa_unit_v2(F, P2, (r < 2) ? 255 - (c >> 1) : (c >> 1), (c & 1) * 2 + (r & 1)); }
                __syncthreads();
                SEAM();
                GAS unsigned* dbg = (GAS unsigned*)(w_ + WS_CTL) + 64;
                float mx = 0.f; unsigned mi = 0u;
                for (unsigned i = (unsigned)b_ * 512u + (unsigned)F.tid; i < (unsigned)S_ * NSAW; i += (unsigned)F.G * 512u) { const float d = fabsf(bf2f(P.A[i]) - bf2f(A2[i])); if (d > mx) { mx = d; mi = i; } }
                if (MK_CMP_ATT == 7 || MK_CMP_ATT == 8) { mx = 0.f; mi = 0u; const GAS float* i1 = (const GAS float*)(w_ + WS_END + 16 * MiB); const GAS float* i2 = (const GAS float*)(w_ + WS_END + 96 * MiB);
                    for (unsigned i = (unsigned)b_ * 512u + (unsigned)F.tid; i < (unsigned)S_ * 4 * 256; i += (unsigned)F.G * 512u) { const int j = i & 255, t = i >> 10, cur = t >> 6; if (cur >= 16 && j >= 1 && j <= cur - 2) { const float d = fabsf(i1[i] - i2[i]) / (MK_CMP_ATT == 8 ? fmaxf(fabsf(i1[i]), 1e-12f) : 1.f); if (d > mx) { mx = d; mi = i; } } } }
                if (MK_CMP_ATT == 12 || MK_CMP_ATT == 13) { unsigned cnt = 0u; const GAS unsigned* sm = (const GAS unsigned*)(w_ + WS_END + (MK_CMP_ATT == 12 ? 400 : 404) * MiB); const GAS float* im = (const GAS float*)(w_ + WS_END + 16 * MiB);
                    for (unsigned i = (unsigned)b_ * 512u + (unsigned)F.tid; i < (unsigned)S_ * 4; i += (unsigned)F.G * 512u) { const int t = i >> 2, cur = t >> 6; if (cur < 16) continue;
                        float mins = 1e30f, maxu = -1.f;
                        for (int j = 1; j <= cur - 2; ++j) { const float v = im[(size_t)i * 256 + j]; const bool s = (sm[i * 8 + (j >> 5)] >> (j & 31)) & 1u; if (s) mins = fminf(mins, v); else maxu = fmaxf(maxu, v); }
                        if (mins < maxu) ++cnt; }
                    (void)__hip_atomic_fetch_add(dbg + 192, cnt, __ATOMIC_RELAXED, __HIP_MEMORY_SCOPE_AGENT); }
                if (MK_CMP_ATT == 9 || MK_CMP_ATT == 10 || MK_CMP_ATT == 11) { unsigned cnt = 0u; const GAS unsigned* s1 = (const GAS unsigned*)(w_ + WS_END + 400 * MiB); const GAS unsigned* s2 = (const GAS unsigned*)(w_ + WS_END + 404 * MiB);
                    for (unsigned i = (unsigned)b_ * 512u + (unsigned)F.tid; i < (unsigned)S_ * 4; i += (unsigned)F.G * 512u) { unsigned x = 0u; bool df = false; for (int w = 0; w < 8; ++w) { df |= (s1[i * 8 + w] != s2[i * 8 + w]); x += __builtin_popcount(MK_CMP_ATT == 10 ? s1[i * 8 + w] : s2[i * 8 + w]); } cnt += (MK_CMP_ATT == 9) ? (df ? 1u : 0u) : x; }
                    (void)__hip_atomic_fetch_add(dbg + 192, cnt, __ATOMIC_RELAXED, __HIP_MEMORY_SCOPE_AGENT); }
                if (MK_CMP_ATT == 5) { unsigned cnt = 0u; const GAS unsigned* s1 = (const GAS unsigned*)(w_ + WS_END + 400 * MiB); const GAS unsigned* s2 = (const GAS unsigned*)(w_ + WS_END + 404 * MiB);
                    for (unsigned i = (unsigned)b_ * 512u + (unsigned)F.tid; i < (unsigned)S_ * 4; i += (unsigned)F.G * 512u) { bool df = false; for (int w = 0; w < 8; ++w) df |= (s1[i * 8 + w] != s2[i * 8 + w]); if (df) ++cnt; }
                    (void)__hip_atomic_fetch_add(dbg + 128, cnt, __ATOMIC_RELAXED, __HIP_MEMORY_SCOPE_AGENT); }
                if (MK_CMP_ATT == 6) { unsigned cnt = 0u; const GAS unsigned* s1 = (const GAS unsigned*)(w_ + WS_END + 400 * MiB); const GAS unsigned* s2 = (const GAS unsigned*)(w_ + WS_END + 404 * MiB);
                    for (unsigned i = (unsigned)b_ * 512u + (unsigned)F.tid; i < (unsigned)S_ * 4; i += (unsigned)F.G * 512u) { for (int w = 0; w < 8; ++w) cnt += __builtin_popcount(s1[i * 8 + w] ^ s2[i * 8 + w]); }
                    (void)__hip_atomic_fetch_add(dbg + 128, cnt, __ATOMIC_RELAXED, __HIP_MEMORY_SCOPE_AGENT); }
                if (MK_CMP_ATT >= 4) { unsigned cnt = 0u; for (unsigned i = (unsigned)b_ * 512u + (unsigned)F.tid; i < (unsigned)S_ * NSAW; i += (unsigned)F.G * 512u) { const float d = fabsf(bf2f(P.A[i]) - bf2f(A2[i])); if (d > 0.02f) ++cnt; } (void)__hip_atomic_fetch_add(dbg + 128, cnt, __ATOMIC_RELAXED, __HIP_MEMORY_SCOPE_AGENT); }
                (void)__hip_atomic_fetch_max(dbg, __builtin_bit_cast(unsigned, mx), __ATOMIC_RELAXED, __HIP_MEMORY_SCOPE_AGENT);
                SEAM();
                const unsigned gm = __hip_atomic_load(dbg, __ATOMIC_RELAXED, __HIP_MEMORY_SCOPE_AGENT);
                if (__builtin_bit_cast(unsigned, mx) == gm && mx > 0.f) __hip_atomic_store(dbg + 64, mi, __ATOMIC_RELAXED, __HIP_MEMORY_SCOPE_AGENT);
                SEAM();
                const unsigned gi = __hip_atomic_load(dbg + 64, __ATOMIC_RELAXED, __HIP_MEMORY_SCOPE_AGENT);
                const float val = (MK_CMP_ATT >= 9) ? 1000.f + (float)__hip_atomic_load(dbg + 192, __ATOMIC_RELAXED, __HIP_MEMORY_SCOPE_AGENT) : (MK_CMP_ATT == 7 || MK_CMP_ATT == 8) ? 1e5f * __builtin_bit_cast(float, gm) : (MK_CMP_ATT >= 4) ? 1000.f + (float)__hip_atomic_load(dbg + 128, __ATOMIC_RELAXED, __HIP_MEMORY_SCOPE_AGENT) : (MK_CMP_ATT == 1) ? 1e5f * __builtin_bit_cast(float, gm) : (MK_CMP_ATT == 2) ? 1000.f + (float)(gi / NSAW) : 1000.f + (float)(gi % NSAW);
                for (size_t i = (size_t)b_ * 512 + F.tid; i < (size_t)S_ * DM; i += (size_t)F.G * 512) X[i] = val;
                return;
            }
#endif
            {
                GAS unsigned* ctr = (GAS unsigned*)(w_ + WS_CTL) + 8192 + 64 * l;
                volatile LAS unsigned* bw = (volatile LAS unsigned*)(F.lds + MISC_OFF) + 4;
#pragma unroll 1
                for (;;) {
                    if (F.tid == 0) bw[0] = __hip_atomic_fetch_add(ctr, 1u, __ATOMIC_RELAXED, __HIP_MEMORY_SCOPE_AGENT);
                    __syncthreads();
                    const int u = __builtin_amdgcn_readfirstlane((int)bw[0]);
                    __syncthreads();
                    if (u >= (S_ / 64) * NGRP) break;
                    nsa_unit_v2(F, P, 255 - (u >> 2), u & 3);
                }
            }
            __syncthreads();
            SEAM(); TS1(6);
        }
        if (IN(7)) { PHASE_BEGIN(); TS0();
            pg8::Sched<S_ / 256, DM / 256, 2, true> S; S.init(F.G, b_);
            EpiMerge E{(gbf*)(w_ + WS_Y1), (const gbf*)(w_ + WS_MG)};
            pg8::gemm_phase<NSAW, NSAW, NSAW, (long)(WS_P - WS_A) / 2, (long)(WS_WBRP - WS_WBRA) / 2>(F.lds, F.tid, (const gbf*)(w_ + WS_A), (const gbf*)(w_ + WS_WBRA), S, E);
            SEAM(); TS1(7);
        }
        if (IN(8)) { PHASE_BEGIN(); TS0();
            pg8::SchedPanel<S_ / 256> S; S.init(F.G, b_);
            EpiBf16 E{(gbf*)(w_ + WS_Y2), DM, 0, 1.f};
            pg8::gemm_phase<DM, DM, DM, 0, 0>(F.lds, F.tid, (const gbf*)(w_ + WS_Y1), (const gbf*)(w_ + WS_WMIX), S, E);
            SEAM(); TS1(8);
        }
        if (IN(9)) { PHASE_BEGIN(); TS0();
#pragma unroll 1
            for (int m = F.gw; m < S_; m += F.NGW) resid_row((const gbf*)(w_ + WS_XB) + (size_t)m * DM, (gbf*)(w_ + WS_XB) + (size_t)m * DM, (gfl*)nullptr, (const gbf*)(w_ + WS_Y2) + (size_t)m * DM, INP(I_LN_MIX_POST) + (size_t)l * DM, (gfl*)(w_ + WS_R) + m, F.lane);
            SEAM(); TS1(9);
        }
        if (IN(10)) { PHASE_BEGIN(); TS0();
            pg8::Sched<S_ / 256, XW / 256, 1, false> S; S.init(F.G, b_);
            EpiBf16 E{(gbf*)(w_ + WS_Q2), XW, 0, 1.f, (const gfl*)(w_ + WS_R)};
            pg8::gemm_phase<DM, DM, DM, 0, 0>(F.lds, F.tid, (const gbf*)(w_ + WS_XB), (const gbf*)(w_ + WS_WXQ), S, E);
            if (l == 0 && b_ >= 128) {
                pg8::Sched<1, 4, 4, false> S2; S2.init(F.G - 128, b_ - 128);
                EpiKVmem E2{(gbf*)(w_ + WS_KM), (gbf*)(w_ + WS_VMT)};
                pg8::gemm_phase<DM, DM, DM, (long)NMEM * DM, (long)1024 * DM>(F.lds, F.tid, (const gbf*)(w_ + WS_MEMN2), (const gbf*)(w_ + WS_WXKV2), S2, E2);
            }
            const int c10 = F.G > 144 ? (l == 0 ? 144 : 128) : 0;
            if (b_ >= c10) {
                __syncthreads();
                if (F.tid == 0) { LAS TrDesc* tab = (LAS TrDesc*)(F.lds + TR_TAB_OFF); int nd = launder_int(0), total = launder_int(0); const gfl* nul = nullptr;
                    TR_PUT(INP(I_W_GATE) + (size_t)l * DM * DFF, DM, DFF, (gbf*)(w_ + WS_WGU), DM, 2 | 8, 0, INP(I_LN_FFN_PRE) + (size_t)l * DM);
                    TR_PUT(INP(I_W_UP) + (size_t)l * DM * DFF, DM, DFF, (gbf*)(w_ + WS_WGU), DM, 2 | 8, 128, INP(I_LN_FFN_PRE) + (size_t)l * DM);
                    TR_PUT(INP(I_W_DOWN) + (size_t)l * DFF * DM, (F.G > 64) ? DFF / 2 : DFF, DM, (gbf*)(w_ + WS_WDN), DFF, 0, 0, nul);
                    trn[0] = nd; trn[1] = total; }
                LDS_WAIT(); __syncthreads();
                Frame F2 = F; F2.gw = (b_ - c10) * NWAVES + F.wave; F2.NGW = (F.G - c10) * NWAVES;
                tr_run(F2, trn[0], trn[1]);
                __syncthreads();
            }
            SEAM(); TS1(10);
        }
        if (IN(11)) { PHASE_BEGIN(); TS0();
#pragma unroll 1
            for (int u = b_; u < (S_ / 256) * 4; u += F.G) xattn_unit_v2(F, (const gbf*)(w_ + WS_Q2), (const gbf*)(w_ + WS_KM) + (size_t)l * NMEM * XW, (const gbf*)(w_ + WS_VMT) + (size_t)l * XW * NMEM, (gbf*)(w_ + WS_O2), u >> 2, u & 3);
            SEAM(); TS1(11);
        }
        if (IN(12)) { PHASE_BEGIN(); TS0();
            pg8::SchedPanel<S_ / 256> S; S.init(F.G, b_);
            EpiBf16 E{(gbf*)(w_ + WS_Y2), DM, 0, 1.f};
            pg8::gemm_phase<XW, XW, XW, 0, 0>(F.lds, F.tid, (const gbf*)(w_ + WS_O2), (const gbf*)(w_ + WS_WXO), S, E);
            SEAM(); TS1(12);
        }
        if (IN(13)) { PHASE_BEGIN(); TS0();
#pragma unroll 1
            for (int m = F.gw; m < S_; m += F.NGW) resid_row((const gbf*)(w_ + WS_XB) + (size_t)m * DM, (gbf*)(w_ + WS_XB) + (size_t)m * DM, (gfl*)nullptr, (const gbf*)(w_ + WS_Y2) + (size_t)m * DM, INP(I_LN_X_POST) + (size_t)l * DM, (gfl*)(w_ + WS_R) + m, F.lane);
            SEAM(); TS1(13);
        }
        if (IN(14)) { PHASE_BEGIN(); TS0();
            pg8::Sched<S_ / 256, 2 * DFF / 256, 1, false> S; S.init(F.G, b_);
            EpiSwiGLU E{(gbf*)(w_ + WS_HID), (const gfl*)(w_ + WS_R)};
            pg8::gemm_phase<DM, DM, DM, 0, 0>(F.lds, F.tid, (const gbf*)(w_ + WS_XB), (const gbf*)(w_ + WS_WGU), S, E);
            SEAM(); TS1(14);
        }
        if (IN(15)) { PHASE_BEGIN(); TS0();
            pg8::SchedPanel<S_ / 256> S; S.init(F.G, b_);
            EpiBf16 E{(gbf*)(w_ + WS_Y2), DM, 0, 1.f};
            pg8::gemm_phase<DFF, DFF, DFF, 0, 0>(F.lds, F.tid, (const gbf*)(w_ + WS_HID), (const gbf*)(w_ + WS_WDN), S, E);
            SEAM(); TS1(15);
        }
        if (IN(16)) { PHASE_BEGIN(); TS0();
#pragma unroll 1
            for (int m = F.gw; m < S_; m += F.NGW) resid_row((const gbf*)(w_ + WS_XB) + (size_t)m * DM, (gbf*)(w_ + WS_XB) + (size_t)m * DM, (l + 1 < NL) ? (gfl*)nullptr : X + (size_t)m * DM, (const gbf*)(w_ + WS_Y2) + (size_t)m * DM, INP(I_LN_FFN_POST) + (size_t)l * DM, (l + 1 < NL) ? (gfl*)(w_ + WS_R) + m : (gfl*)nullptr, F.lane);
            if (l + 1 < launder_int(l_hi)) SEAM(); TS1(16);
        }
    }

    if (launder_int(l_lo) <= 1 && 1 < launder_int(l_hi)) { constexpr int l = 1;
        if (IN(2)) { PHASE_BEGIN(); TS0();
            if (F.tid == 0) { LAS TrDesc* tab = (LAS TrDesc*)(F.lds + TR_TAB_OFF); int nd = launder_int(0), total = launder_int(0); const gfl* nul = nullptr;
                TR_PUT(INP(I_W_IN) + (size_t)l * DM * INW, DM, INW, (gbf*)(w_ + WS_WIN), DM, 1 | 8, 0, INP(I_LN_MIX_PRE) + (size_t)l * DM);
                for (int q = 0; q < 4; ++q) { const int kv = q >> 1, half = q & 1;
                    TR_PUT(INP(I_CMP_W1) + (((size_t)l * 2 + kv) * 2048 + half * 1024) * 128, 1024, 128, (gbf*)(w_ + WS_WC1) + (size_t)kv * 256 * 1024, 1024, 0, half * 128, nul); }
                for (int gi = 0; gi < 4; ++gi)
                    TR_PUT(INP(I_W_POOL) + ((size_t)l * 4 + gi) * 65536, 256, 256, (gbf*)(w_ + WS_WPOOL) + (size_t)gi * 65536, 256, 0, 0, INP(I_POOL_SCALE) + (size_t)l * POOLW + gi * 256);
                trn[0] = nd; trn[1] = total; }
            LDS_WAIT(); __syncthreads();
            if (F.gw < 32) {
                const int p = F.gw >> 2, kv = (F.gw >> 1) & 1, j = (F.gw & 1) * 64 + F.lane;
                const gfl* pe = INP(I_CMP_PE) + ((size_t)l * 2 + kv) * 2048 + p * 256; const gfl* w1 = INP(I_CMP_W1) + (((size_t)l * 2 + kv) * 2048 + p * 256) * 128 + j;
                float a = 0.f;
#pragma unroll 32
                for (int k = 0; k < 256; ++k) a += pe[k] * w1[(size_t)k * 128];
                ((gfl*)(w_ + WS_PEB))[p * 256 + kv * 128 + j] = a;
            }
            tr_run(F, trn[0], trn[1]);
            __syncthreads();
            SEAM(); TS1(2);
        }
        if (IN(3)) { PHASE_BEGIN(); TS0();
            pg8::Sched<S_ / 256, ZN / 256, 1, false> S; S.init(F.G, b_);
            EpiZ E{w_};
            pg8::gemm_phase<DM, DM, DM, 0, 0>(F.lds, F.tid, (const gbf*)(w_ + WS_XB), (const gbf*)(w_ + WS_WIN), S, E);
            const int c3 = ((S_ / 256) * (ZN / 256)) % F.G;
            if (b_ >= c3) {
                __syncthreads();
                if (F.tid == 0) { LAS TrDesc* tab = (LAS TrDesc*)(F.lds + TR_TAB_OFF); int nd = launder_int(0), total = launder_int(0); const gfl* nul = nullptr;
                    TR_PUT(INP(I_W_BR_ATTN) + (size_t)l * NSAW * DM, NSAW, DM, (gbf*)(w_ + WS_WBRA), NSAW, 0, 0, nul);
                    TR_PUT(INP(I_W_BR_POOL) + (size_t)l * POOLW * DM, POOLW, DM, (gbf*)(w_ + WS_WBRP), POOLW, 0, 0, nul);
                    TR_PUT(INP(I_W_MIX_OUT) + (size_t)l * DM * DM, DM, DM, (gbf*)(w_ + WS_WMIX), DM, 0, 0, nul);
                    TR_PUT(INP(I_W_XQ) + (size_t)l * DM * XW, DM, XW, (gbf*)(w_ + WS_WXQ), DM, 0 | 8, 0, INP(I_LN_X_PRE) + (size_t)l * DM);
                    TR_PUT(INP(I_W_XO) + (size_t)l * XW * DM, XW, DM, (gbf*)(w_ + WS_WXO), XW, 0, 0, nul);
                    trn[0] = nd; trn[1] = total; }
                LDS_WAIT(); __syncthreads();
                Frame F2 = F; F2.gw = (b_ - c3) * NWAVES + F.wave; F2.NGW = (F.G - c3) * NWAVES;
                tr_run(F2, trn[0], trn[1]);
                __syncthreads();
            }
            SEAM(); TS1(3);
        }
        if (IN(4)) { PHASE_BEGIN(); TS0();
            if (F.G <= 64) {
#pragma unroll 1
                for (int it = F.gw; it < 2 * S_; it += F.NGW) pool_item((const gbf*)(w_ + WS_U), (gbf*)(w_ + WS_YP), it, F.lane);
                __syncthreads();
            } else if (b_ >= 32) {
#pragma unroll 1
                for (int it = (b_ - 32) * NWAVES + F.wave; it < 2 * S_; it += (F.G - 32) * NWAVES) pool_item((const gbf*)(w_ + WS_U), (gbf*)(w_ + WS_YP), it, F.lane);
                if (F.tid == 0) { LAS TrDesc* tab = (LAS TrDesc*)(F.lds + TR_TAB_OFF); int nd = launder_int(0), total = launder_int(0); const gfl* nul = nullptr;
                    TR_PUT(INP(I_W_DOWN) + ((size_t)l * DFF + DFF / 2) * DM, DFF / 2, DM, (gbf*)(w_ + WS_WDN) + DFF / 2, DFF, 0, 0, nul);
                    trn[0] = nd; trn[1] = total; }
                LDS_WAIT(); __syncthreads();
                Frame F2 = F; F2.gw = (b_ - 32) * NWAVES + F.wave; F2.NGW = (F.G - 32) * NWAVES;
                tr_run(F2, trn[0], trn[1]);
                __syncthreads();
            }
            pg8::Sched<16, 1, 2, false> S; S.init(F.G, b_);
            EpiF32 E{(gfl*)(w_ + WS_PQ), 256, (size_t)4096 * 256};
            pg8::gemm_phase<1024, 1024, 1024, (long)(WS_VCR - WS_KCR) / 2, (long)256 * 1024>(F.lds, F.tid, (const gbf*)(w_ + WS_KCR), (const gbf*)(w_ + WS_WC1), S, E);
            SEAM(); TS1(4);
        }
        if (IN(5)) { PHASE_BEGIN(); TS0();
            LAS float* hid = (LAS float*)(F.lds + F.wave * 2048);
#pragma unroll 1
            for (int it = F.gw; it < 2048; it += F.NGW) cmp_final_item4((const gfl*)(w_ + WS_PQ), (const gfl*)(w_ + WS_PEB), INP(I_CMP_W2) + (size_t)l * 2 * 128 * 64, (gbf*)(w_ + WS_KC), (gbf*)(w_ + WS_VCT), hid, it, F.lane);
            __syncthreads();
            pg8::Sched<S_ / 256, 1, 4, false> S; S.init(F.G, b_);
            EpiBf16 E{(gbf*)(w_ + WS_P), POOLW, 256, 1.f};
            pg8::gemm_phase<POOLW, 256, 256, 256, 65536>(F.lds, F.tid, (const gbf*)(w_ + WS_YP), (const gbf*)(w_ + WS_WPOOL), S, E);
            SEAM(); TS1(5);
        }
        if (IN(6)) { PHASE_BEGIN(); TS0();
            attn_setup_tables(F, INP(I_RELB));
            const AttnPtrs P{(const gbf*)(w_ + WS_Q), (const gbf*)(w_ + WS_KC), (const gbf*)(w_ + WS_VCT), (const gbf*)(w_ + WS_KSEL), (const gbf*)(w_ + WS_VSELT), (const gbf*)(w_ + WS_KWIN), (const gbf*)(w_ + WS_VWINT),
                             (const gfl*)(w_ + WS_GL), (gbf*)(w_ + WS_A)};
#ifdef MK_CMP_ATT
            {
                gbf* A2 = (gbf*)(w_ + WS_YP);
#pragma unroll 1
                for (int it = F.gw; it < (S_ / 4) * NGRP; it += F.NGW) nsa_unit_v1(F, P, it >> 2, it & 3);
                __syncthreads();
                const AttnPtrs P2{P.Q, P.KC, P.VCT, P.KSEL, P.VSELT, P.KWIN, P.VWINT, P.GL, A2};
#pragma unroll 1
                for (int u = b_; u < (S_ / 64) * NGRP; u += F.G) { const int c = u & 255, r = u >> 8; nsa_unit_v2(F, P2, (r < 2) ? 255 - (c >> 1) : (c >> 1), (c & 1) * 2 + (r & 1)); }
                __syncthreads();
                SEAM();
                GAS unsigned* dbg = (GAS unsigned*)(w_ + WS_CTL) + 64;
                float mx = 0.f; unsigned mi = 0u;
                for (unsigned i = (unsigned)b_ * 512u + (unsigned)F.tid; i < (unsigned)S_ * NSAW; i += (unsigned)F.G * 512u) { const float d = fabsf(bf2f(P.A[i]) - bf2f(A2[i])); if (d > mx) { mx = d; mi = i; } }
                if (MK_CMP_ATT == 7 || MK_CMP_ATT == 8) { mx = 0.f; mi = 0u; const GAS float* i1 = (const GAS float*)(w_ + WS_END + 16 * MiB); const GAS float* i2 = (const GAS float*)(w_ + WS_END + 96 * MiB);
                    for (unsigned i = (unsigned)b_ * 512u + (unsigned)F.tid; i < (unsigned)S_ * 4 * 256; i += (unsigned)F.G * 512u) { const int j = i & 255, t = i >> 10, cur = t >> 6; if (cur >= 16 && j >= 1 && j <= cur - 2) { const float d = fabsf(i1[i] - i2[i]) / (MK_CMP_ATT == 8 ? fmaxf(fabsf(i1[i]), 1e-12f) : 1.f); if (d > mx) { mx = d; mi = i; } } } }
                if (MK_CMP_ATT == 12 || MK_CMP_ATT == 13) { unsigned cnt = 0u; const GAS unsigned* sm = (const GAS unsigned*)(w_ + WS_END + (MK_CMP_ATT == 12 ? 400 : 404) * MiB); const GAS float* im = (const GAS float*)(w_ + WS_END + 16 * MiB);
                    for (unsigned i = (unsigned)b_ * 512u + (unsigned)F.tid; i < (unsigned)S_ * 4; i += (unsigned)F.G * 512u) { const int t = i >> 2, cur = t >> 6; if (cur < 16) continue;
                        float mins = 1e30f, maxu = -1.f;
                        for (int j = 1; j <= cur - 2; ++j) { const float v = im[(size_t)i * 256 + j]; const bool s = (sm[i * 8 + (j >> 5)] >> (j & 31)) & 1u; if (s) mins = fminf(mins, v); else maxu = fmaxf(maxu, v); }
                        if (mins < maxu) ++cnt; }
                    (void)__hip_atomic_fetch_add(dbg + 192, cnt, __ATOMIC_RELAXED, __HIP_MEMORY_SCOPE_AGENT); }
                if (MK_CMP_ATT == 9 || MK_CMP_ATT == 10 || MK_CMP_ATT == 11) { unsigned cnt = 0u; const GAS unsigned* s1 = (const GAS unsigned*)(w_ + WS_END + 400 * MiB); const GAS unsigned* s2 = (const GAS unsigned*)(w_ + WS_END + 404 * MiB);
                    for (unsigned i = (unsigned)b_ * 512u + (unsigned)F.tid; i < (unsigned)S_ * 4; i += (unsigned)F.G * 512u) { unsigned x = 0u; bool df = false; for (int w = 0; w < 8; ++w) { df |= (s1[i * 8 + w] != s2[i * 8 + w]); x += __builtin_popcount(MK_CMP_ATT == 10 ? s1[i * 8 + w] : s2[i * 8 + w]); } cnt += (MK_CMP_ATT == 9) ? (df ? 1u : 0u) : x; }
                    (void)__hip_atomic_fetch_add(dbg + 192, cnt, __ATOMIC_RELAXED, __HIP_MEMORY_SCOPE_AGENT); }
                if (MK_CMP_ATT == 5) { unsigned cnt = 0u; const GAS unsigned* s1 = (const GAS unsigned*)(w_ + WS_END + 400 * MiB); const GAS unsigned* s2 = (const GAS unsigned*)(w_ + WS_END + 404 * MiB);
                    for (unsigned i = (unsigned)b_ * 512u + (unsigned)F.tid; i < (unsigned)S_ * 4; i += (unsigned)F.G * 512u) { bool df = false; for (int w = 0; w < 8; ++w) df |= (s1[i * 8 + w] != s2[i * 8 + w]); if (df) ++cnt; }
                    (void)__hip_atomic_fetch_add(dbg + 128, cnt, __ATOMIC_RELAXED, __HIP_MEMORY_SCOPE_AGENT); }
                if (MK_CMP_ATT == 6) { unsigned cnt = 0u; const GAS unsigned* s1 = (const GAS unsigned*)(w_ + WS_END + 400 * MiB); const GAS unsigned* s2 = (const GAS unsigned*)(w_ + WS_END + 404 * MiB);
                    for (unsigned i = (unsigned)b_ * 512u + (unsigned)F.tid; i < (unsigned)S_ * 4; i += (unsigned)F.G * 512u) { for (int w = 0; w < 8; ++w) cnt += __builtin_popcount(s1[i * 8 + w] ^ s2[i * 8 + w]); }
                    (void)__hip_atomic_fetch_add(dbg + 128, cnt, __ATOMIC_RELAXED, __HIP_MEMORY_SCOPE_AGENT); }
                if (MK_CMP_ATT >= 4) { unsigned cnt = 0u; for (unsigned i = (unsigned)b_ * 512u + (unsigned)F.tid; i < (unsigned)S_ * NSAW; i += (unsigned)F.G * 512u) { const float d = fabsf(bf2f(P.A[i]) - bf2f(A2[i])); if (d > 0.02f) ++cnt; } (void)__hip_atomic_fetch_add(dbg + 128, cnt, __ATOMIC_RELAXED, __HIP_MEMORY_SCOPE_AGENT); }
                (void)__hip_atomic_fetch_max(dbg, __builtin_bit_cast(unsigned, mx), __ATOMIC_RELAXED, __HIP_MEMORY_SCOPE_AGENT);
                SEAM();
                const unsigned gm = __hip_atomic_load(dbg, __ATOMIC_RELAXED, __HIP_MEMORY_SCOPE_AGENT);
                if (__builtin_bit_cast(unsigned, mx) == gm && mx > 0.f) __hip_atomic_store(dbg + 64, mi, __ATOMIC_RELAXED, __HIP_MEMORY_SCOPE_AGENT);
                SEAM();
                const unsigned gi = __hip_atomic_load(dbg + 64, __ATOMIC_RELAXED, __HIP_MEMORY_SCOPE_AGENT);
                const float val = (MK_CMP_ATT >= 9) ? 1000.f + (float)__hip_atomic_load(dbg + 192, __ATOMIC_RELAXED, __HIP_MEMORY_SCOPE_AGENT) : (MK_CMP_ATT == 7 || MK_CMP_ATT == 8) ? 1e5f * __builtin_bit_cast(float, gm) : (MK_CMP_ATT >= 4) ? 1000.f + (float)__hip_atomic_load(dbg + 128, __ATOMIC_RELAXED, __HIP_MEMORY_SCOPE_AGENT) : (MK_CMP_ATT == 1) ? 1e5f * __builtin_bit_cast(float, gm) : (MK_CMP_ATT == 2) ? 1000.f + (float)(gi / NSAW) : 1000.f + (float)(gi % NSAW);
                for (size_t i = (size_t)b_ * 512 + F.tid; i < (size_t)S_ * DM; i += (size_t)F.G * 512) X[i] = val;
                return;
            }
#endif
            {
                GAS unsigned* ctr = (GAS unsigned*)(w_ + WS_CTL) + 8192 + 64 * l;
                volatile LAS unsigned* bw = (volatile LAS unsigned*)(F.lds + MISC_OFF) + 4;
#pragma unroll 1
                for (;;) {
                    if (F.tid == 0) bw[0] = __hip_atomic_fetch_add(ctr, 1u, __ATOMIC_RELAXED, __HIP_MEMORY_SCOPE_AGENT);
                    __syncthreads();
                    const int u = __builtin_amdgcn_readfirstlane((int)bw[0]);
                    __syncthreads();
                    if (u >= (S_ / 64) * NGRP) break;
                    nsa_unit_v2(F, P, 255 - (u >> 2), u & 3);
                }
            }
            __syncthreads();
            SEAM(); TS1(6);
        }
        if (IN(7)) { PHASE_BEGIN(); TS0();
            pg8::Sched<S_ / 256, DM / 256, 2, true> S; S.init(F.G, b_);
            EpiMerge E{(gbf*)(w_ + WS_Y1), (const gbf*)(w_ + WS_MG)};
            pg8::gemm_phase<NSAW, NSAW, NSAW, (long)(WS_P - WS_A) / 2, (long)(WS_WBRP - WS_WBRA) / 2>(F.lds, F.tid, (const gbf*)(w_ + WS_A), (const gbf*)(w_ + WS_WBRA), S, E);
            SEAM(); TS1(7);
        }
        if (IN(8)) { PHASE_BEGIN(); TS0();
            pg8::SchedPanel<S_ / 256> S; S.init(F.G, b_);
            EpiBf16 E{(gbf*)(w_ + WS_Y2), DM, 0, 1.f};
            pg8::gemm_phase<DM, DM, DM, 0, 0>(F.lds, F.tid, (const gbf*)(w_ + WS_Y1), (const gbf*)(w_ + WS_WMIX), S, E);
            SEAM(); TS1(8);
        }
        if (IN(9)) { PHASE_BEGIN(); TS0();
#pragma unroll 1
            for (int m = F.gw; m < S_; m += F.NGW) resid_row((const gbf*)(w_ + WS_XB) + (size_t)m * DM, (gbf*)(w_ + WS_XB) + (size_t)m * DM, (gfl*)nullptr, (const gbf*)(w_ + WS_Y2) + (size_t)m * DM, INP(I_LN_MIX_POST) + (size_t)l * DM, (gfl*)(w_ + WS_R) + m, F.lane);
            SEAM(); TS1(9);
        }
        if (IN(10)) { PHASE_BEGIN(); TS0();
            pg8::Sched<S_ / 256, XW / 256, 1, false> S; S.init(F.G, b_);
            EpiBf16 E{(gbf*)(w_ + WS_Q2), XW, 0, 1.f, (const gfl*)(w_ + WS_R)};
            pg8::gemm_phase<DM, DM, DM, 0, 0>(F.lds, F.tid, (const gbf*)(w_ + WS_XB), (const gbf*)(w_ + WS_WXQ), S, E);
            if (l == 0 && b_ >= 128) {
                pg8::Sched<1, 4, 4, false> S2; S2.init(F.G - 128, b_ - 128);
                EpiKVmem E2{(gbf*)(w_ + WS_KM), (gbf*)(w_ + WS_VMT)};
                pg8::gemm_phase<DM, DM, DM, (long)NMEM * DM, (long)1024 * DM>(F.lds, F.tid, (const gbf*)(w_ + WS_MEMN2), (const gbf*)(w_ + WS_WXKV2), S2, E2);
            }
            const int c10 = F.G > 144 ? (l == 0 ? 144 : 128) : 0;
            if (b_ >= c10) {
                __syncthreads();
                if (F.tid == 0) { LAS TrDesc* tab = (LAS TrDesc*)(F.lds + TR_TAB_OFF); int nd = launder_int(0), total = launder_int(0); const gfl* nul = nullptr;
                    TR_PUT(INP(I_W_GATE) + (size_t)l * DM * DFF, DM, DFF, (gbf*)(w_ + WS_WGU), DM, 2 | 8, 0, INP(I_LN_FFN_PRE) + (size_t)l * DM);
                    TR_PUT(INP(I_W_UP) + (size_t)l * DM * DFF, DM, DFF, (gbf*)(w_ + WS_WGU), DM, 2 | 8, 128, INP(I_LN_FFN_PRE) + (size_t)l * DM);
                    TR_PUT(INP(I_W_DOWN) + (size_t)l * DFF * DM, (F.G > 64) ? DFF / 2 : DFF, DM, (gbf*)(w_ + WS_WDN), DFF, 0, 0, nul);
                    trn[0] = nd; trn[1] = total; }
                LDS_WAIT(); __syncthreads();
                Frame F2 = F; F2.gw = (b_ - c10) * NWAVES + F.wave; F2.NGW = (F.G - c10) * NWAVES;
                tr_run(F2, trn[0], trn[1]);
                __syncthreads();
            }
            SEAM(); TS1(10);
        }
        if (IN(11)) { PHASE_BEGIN(); TS0();
#pragma unroll 1
            for (int u = b_; u < (S_ / 256) * 4; u += F.G) xattn_unit_v2(F, (const gbf*)(w_ + WS_Q2), (const gbf*)(w_ + WS_KM) + (size_t)l * NMEM * XW, (const gbf*)(w_ + WS_VMT) + (size_t)l * XW * NMEM, (gbf*)(w_ + WS_O2), u >> 2, u & 3);
            SEAM(); TS1(11);
        }
        if (IN(12)) { PHASE_BEGIN(); TS0();
            pg8::SchedPanel<S_ / 256> S; S.init(F.G, b_);
            EpiBf16 E{(gbf*)(w_ + WS_Y2), DM, 0, 1.f};
            pg8::gemm_phase<XW, XW, XW, 0, 0>(F.lds, F.tid, (const gbf*)(w_ + WS_O2), (const gbf*)(w_ + WS_WXO), S, E);
            SEAM(); TS1(12);
        }
        if (IN(13)) { PHASE_BEGIN(); TS0();
#pragma unroll 1
            for (int m = F.gw; m < S_; m += F.NGW) resid_row((const gbf*)(w_ + WS_XB) + (size_t)m * DM, (gbf*)(w_ + WS_XB) + (size_t)m * DM, (gfl*)nullptr, (const gbf*)(w_ + WS_Y2) + (size_t)m * DM, INP(I_LN_X_POST) + (size_t)l * DM, (gfl*)(w_ + WS_R) + m, F.lane);
            SEAM(); TS1(13);
        }
        if (IN(14)) { PHASE_BEGIN(); TS0();
            pg8::Sched<S_ / 256, 2 * DFF / 256, 1, false> S; S.init(F.G, b_);
            EpiSwiGLU E{(gbf*)(w_ + WS_HID), (const gfl*)(w_ + WS_R)};
            pg8::gemm_phase<DM, DM, DM, 0, 0>(F.lds, F.tid, (const gbf*)(w_ + WS_XB), (const gbf*)(w_ + WS_WGU), S, E);
            SEAM(); TS1(14);
        }
        if (IN(15)) { PHASE_BEGIN(); TS0();
            pg8::SchedPanel<S_ / 256> S; S.init(F.G, b_);
            EpiBf16 E{(gbf*)(w_ + WS_Y2), DM, 0, 1.f};
            pg8::gemm_phase<DFF, DFF, DFF, 0, 0>(F.lds, F.tid, (const gbf*)(w_ + WS_HID), (const gbf*)(w_ + WS_WDN), S, E);
            SEAM(); TS1(15);
        }
        if (IN(16)) { PHASE_BEGIN(); TS0();
#pragma unroll 1
            for (int m = F.gw; m < S_; m += F.NGW) resid_row((const gbf*)(w_ + WS_XB) + (size_t)m * DM, (gbf*)(w_ + WS_XB) + (size_t)m * DM, (l + 1 < NL) ? (gfl*)nullptr : X + (size_t)m * DM, (const gbf*)(w_ + WS_Y2) + (size_t)m * DM, INP(I_LN_FFN_POST) + (size_t)l * DM, (l + 1 < NL) ? (gfl*)(w_ + WS_R) + m : (gfl*)nullptr, F.lane);
            if (l + 1 < launder_int(l_hi)) SEAM(); TS1(16);
        }
    }

    if (launder_int(l_lo) <= 2 && 2 < launder_int(l_hi)) { constexpr int l = 2;
        if (IN(2)) { PHASE_BEGIN(); TS0();
            if (F.tid == 0) { LAS TrDesc* tab = (LAS TrDesc*)(F.lds + TR_TAB_OFF); int nd = launder_int(0), total = launder_int(0); const gfl* nul = nullptr;
                TR_PUT(INP(I_W_IN) + (size_t)l * DM * INW, DM, INW, (gbf*)(w_ + WS_WIN), DM, 1 | 8, 0, INP(I_LN_MIX_PRE) + (size_t)l * DM);
                for (int q = 0; q < 4; ++q) { const int kv = q >> 1, half = q & 1;
                    TR_PUT(INP(I_CMP_W1) + (((size_t)l * 2 + kv) * 2048 + half * 1024) * 128, 1024, 128, (gbf*)(w_ + WS_WC1) + (size_t)kv * 256 * 1024, 1024, 0, half * 128, nul); }
                for (int gi = 0; gi < 4; ++gi)
                    TR_PUT(INP(I_W_POOL) + ((size_t)l * 4 + gi) * 65536, 256, 256, (gbf*)(w_ + WS_WPOOL) + (size_t)gi * 65536, 256, 0, 0, INP(I_POOL_SCALE) + (size_t)l * POOLW + gi * 256);
                trn[0] = nd; trn[1] = total; }
            LDS_WAIT(); __syncthreads();
            if (F.gw < 32) {
                const int p = F.gw >> 2, kv = (F.gw >> 1) & 1, j = (F.gw & 1) * 64 + F.lane;
                const gfl* pe = INP(I_CMP_PE) + ((size_t)l * 2 + kv) * 2048 + p * 256; const gfl* w1 = INP(I_CMP_W1) + (((size_t)l * 2 + kv) * 2048 + p * 256) * 128 + j;
                float a = 0.f;
#pragma unroll 32
                for (int k = 0; k < 256; ++k) a += pe[k] * w1[(size_t)k * 128];
                ((gfl*)(w_ + WS_PEB))[p * 256 + kv * 128 + j] = a;
            }
            tr_run(F, trn[0], trn[1]);
            __syncthreads();
            SEAM(); TS1(2);
        }
        if (IN(3)) { PHASE_BEGIN(); TS0();
            pg8::Sched<S_ / 256, ZN / 256, 1, false> S; S.init(F.G, b_);
            EpiZ E{w_};
            pg8::gemm_phase<DM, DM, DM, 0, 0>(F.lds, F.tid, (const gbf*)(w_ + WS_XB), (const gbf*)(w_ + WS_WIN), S, E);
            const int c3 = ((S_ / 256) * (ZN / 256)) % F.G;
            if (b_ >= c3) {
                __syncthreads();
                if (F.tid == 0) { LAS TrDesc* tab = (LAS TrDesc*)(F.lds + TR_TAB_OFF); int nd = launder_int(0), total = launder_int(0); const gfl* nul = nullptr;
                    TR_PUT(INP(I_W_BR_ATTN) + (size_t)l * NSAW * DM, NSAW, DM, (gbf*)(w_ + WS_WBRA), NSAW, 0, 0, nul);
                    TR_PUT(INP(I_W_BR_POOL) + (size_t)l * POOLW * DM, POOLW, DM, (gbf*)(w_ + WS_WBRP), POOLW, 0, 0, nul);
                    TR_PUT(INP(I_W_MIX_OUT) + (size_t)l * DM * DM, DM, DM, (gbf*)(w_ + WS_WMIX), DM, 0, 0, nul);
                    TR_PUT(INP(I_W_XQ) + (size_t)l * DM * XW, DM, XW, (gbf*)(w_ + WS_WXQ), DM, 0 | 8, 0, INP(I_LN_X_PRE) + (size_t)l * DM);
                    TR_PUT(INP(I_W_XO) + (size_t)l * XW * DM, XW, DM, (gbf*)(w_ + WS_WXO), XW, 0, 0, nul);
                    trn[0] = nd; trn[1] = total; }
                LDS_WAIT(); __syncthreads();
                Frame F2 = F; F2.gw = (b_ - c3) * NWAVES + F.wave; F2.NGW = (F.G - c3) * NWAVES;
                tr_run(F2, trn[0], trn[1]);
                __syncthreads();
            }
            SEAM(); TS1(3);
        }
        if (IN(4)) { PHASE_BEGIN(); TS0();
            if (F.G <= 64) {
#pragma unroll 1
                for (int it = F.gw; it < 2 * S_; it += F.NGW) pool_item((const gbf*)(w_ + WS_U), (gbf*)(w_ + WS_YP), it, F.lane);
                __syncthreads();
            } else if (b_ >= 32) {
#pragma unroll 1
                for (int it = (b_ - 32) * NWAVES + F.wave; it < 2 * S_; it += (F.G - 32) * NWAVES) pool_item((const gbf*)(w_ + WS_U), (gbf*)(w_ + WS_YP), it, F.lane);
                if (F.tid == 0) { LAS TrDesc* tab = (LAS TrDesc*)(F.lds + TR_TAB_OFF); int nd = launder_int(0), total = launder_int(0); const gfl* nul = nullptr;
                    TR_PUT(INP(I_W_DOWN) + ((size_t)l * DFF + DFF / 2) * DM, DFF / 2, DM, (gbf*)(w_ + WS_WDN) + DFF / 2, DFF, 0, 0, nul);
                    trn[0] = nd; trn[1] = total; }
                LDS_WAIT(); __syncthreads();
                Frame F2 = F; F2.gw = (b_ - 32) * NWAVES + F.wave; F2.NGW = (F.G - 32) * NWAVES;
                tr_run(F2, trn[0], trn[1]);
                __syncthreads();
            }
            pg8::Sched<16, 1, 2, false> S; S.init(F.G, b_);
            EpiF32 E{(gfl*)(w_ + WS_PQ), 256, (size_t)4096 * 256};
            pg8::gemm_phase<1024, 1024, 1024, (long)(WS_VCR - WS_KCR) / 2, (long)256 * 1024>(F.lds, F.tid, (const gbf*)(w_ + WS_KCR), (const gbf*)(w_ + WS_WC1), S, E);
            SEAM(); TS1(4);
        }
        if (IN(5)) { PHASE_BEGIN(); TS0();
            LAS float* hid = (LAS float*)(F.lds + F.wave * 2048);
#pragma unroll 1
            for (int it = F.gw; it < 2048; it += F.NGW) cmp_final_item4((const gfl*)(w_ + WS_PQ), (const gfl*)(w_ + WS_PEB), INP(I_CMP_W2) + (size_t)l * 2 * 128 * 64, (gbf*)(w_ + WS_KC), (gbf*)(w_ + WS_VCT), hid, it, F.lane);
            __syncthreads();
            pg8::Sched<S_ / 256, 1, 4, false> S; S.init(F.G, b_);
            EpiBf16 E{(gbf*)(w_ + WS_P), POOLW, 256, 1.f};
            pg8::gemm_phase<POOLW, 256, 256, 256, 65536>(F.lds, F.tid, (const gbf*)(w_ + WS_YP), (const gbf*)(w_ + WS_WPOOL), S, E);
            SEAM(); TS1(5);
        }
        if (IN(6)) { PHASE_BEGIN(); TS0();
            attn_setup_tables(F, INP(I_RELB));
            const AttnPtrs P{(const gbf*)(w_ + WS_Q), (const gbf*)(w_ + WS_KC), (const gbf*)(w_ + WS_VCT), (const gbf*)(w_ + WS_KSEL), (const gbf*)(w_ + WS_VSELT), (const gbf*)(w_ + WS_KWIN), (const gbf*)(w_ + WS_VWINT),
                             (const gfl*)(w_ + WS_GL), (gbf*)(w_ + WS_A)};
#ifdef MK_CMP_ATT
            {
                gbf* A2 = (gbf*)(w_ + WS_YP);
#pragma unroll 1
                for (int it = F.gw; it < (S_ / 4) * NGRP; it += F.NGW) nsa_unit_v1(F, P, it >> 2, it & 3);
                __syncthreads();
                const AttnPtrs P2{P.Q, P.KC, P.VCT, P.KSEL, P.VSELT, P.KWIN, P.VWINT, P.GL, A2};
#pragma unroll 1
                for (int u = b_; u < (S_ / 64) * NGRP; u += F.G) { const int c = u & 255, r = u >> 8; nsa_unit_v2(F, P2, (r < 2) ? 255 - (c >> 1) : (c >> 1), (c & 1) * 2 + (r & 1)); }
                __syncthreads();
                SEAM();
                GAS unsigned* dbg = (GAS unsigned*)(w_ + WS_CTL) + 64;
                float mx = 0.f; unsigned mi = 0u;
                for (unsigned i = (unsigned)b_ * 512u + (unsigned)F.tid; i < (unsigned)S_ * NSAW; i += (unsigned)F.G * 512u) { const float d = fabsf(bf2f(P.A[i]) - bf2f(A2[i])); if (d > mx) { mx = d; mi = i; } }
                if (MK_CMP_ATT == 7 || MK_CMP_ATT == 8) { mx = 0.f; mi = 0u; const GAS float* i1 = (const GAS float*)(w_ + WS_END + 16 * MiB); const GAS float* i2 = (const GAS float*)(w_ + WS_END + 96 * MiB);
                    for (unsigned i = (unsigned)b_ * 512u + (unsigned)F.tid; i < (unsigned)S_ * 4 * 256; i += (unsigned)F.G * 512u) { const int j = i & 255, t = i >> 10, cur = t >> 6; if (cur >= 16 && j >= 1 && j <= cur - 2) { const float d = fabsf(i1[i] - i2[i]) / (MK_CMP_ATT == 8 ? fmaxf(fabsf(i1[i]), 1e-12f) : 1.f); if (d > mx) { mx = d; mi = i; } } } }
                if (MK_CMP_ATT == 12 || MK_CMP_ATT == 13) { unsigned cnt = 0u; const GAS unsigned* sm = (const GAS unsigned*)(w_ + WS_END + (MK_CMP_ATT == 12 ? 400 : 404) * MiB); const GAS float* im = (const GAS float*)(w_ + WS_END + 16 * MiB);
                    for (unsigned i = (unsigned)b_ * 512u + (unsigned)F.tid; i < (unsigned)S_ * 4; i += (unsigned)F.G * 512u) { const int t = i >> 2, cur = t >> 6; if (cur < 16) continue;
                        float mins = 1e30f, maxu = -1.f;
                        for (int j = 1; j <= cur - 2; ++j) { const float v = im[(size_t)i * 256 + j]; const bool s = (sm[i * 8 + (j >> 5)] >> (j & 31)) & 1u; if (s) mins = fminf(mins, v); else maxu = fmaxf(maxu, v); }
                        if (mins < maxu) ++cnt; }
                    (void)__hip_atomic_fetch_add(dbg + 192, cnt, __ATOMIC_RELAXED, __HIP_MEMORY_SCOPE_AGENT); }
                if (MK_CMP_ATT == 9 || MK_CMP_ATT == 10 || MK_CMP_ATT == 11) { unsigned cnt = 0u; const GAS unsigned* s1 = (const GAS unsigned*)(w_ + WS_END + 400 * MiB); const GAS unsigned* s2 = (const GAS unsigned*)(w_ + WS_END + 404 * MiB);
                    for (unsigned i = (unsigned)b_ * 512u + (unsigned)F.tid; i < (unsigned)S_ * 4; i += (unsigned)F.G * 512u) { unsigned x = 0u; bool df = false; for (int w = 0; w < 8; ++w) { df |= (s1[i * 8 + w] != s2[i * 8 + w]); x += __builtin_popcount(MK_CMP_ATT == 10 ? s1[i * 8 + w] : s2[i * 8 + w]); } cnt += (MK_CMP_ATT == 9) ? (df ? 1u : 0u) : x; }
                    (void)__hip_atomic_fetch_add(dbg + 192, cnt, __ATOMIC_RELAXED, __HIP_MEMORY_SCOPE_AGENT); }
                if (MK_CMP_ATT == 5) { unsigned cnt = 0u; const GAS unsigned* s1 = (const GAS unsigned*)(w_ + WS_END + 400 * MiB); const GAS unsigned* s2 = (const GAS unsigned*)(w_ + WS_END + 404 * MiB);
                    for (unsigned i = (unsigned)b_ * 512u + (unsigned)F.tid; i < (unsigned)S_ * 4; i += (unsigned)F.G * 512u) { bool df = false; for (int w = 0; w < 8; ++w) df |= (s1[i * 8 + w] != s2[i * 8 + w]); if (df) ++cnt; }
                    (void)__hip_atomic_fetch_add(dbg + 128, cnt, __ATOMIC_RELAXED, __HIP_MEMORY_SCOPE_AGENT); }
                if (MK_CMP_ATT == 6) { unsigned cnt = 0u; const GAS unsigned* s1 = (const GAS unsigned*)(w_ + WS_END + 400 * MiB); const GAS unsigned* s2 = (const GAS unsigned*)(w_ + WS_END + 404 * MiB);
                    for (unsigned i = (unsigned)b_ * 512u + (unsigned)F.tid; i < (unsigned)S_ * 4; i += (unsigned)F.G * 512u) { for (int w = 0; w < 8; ++w) cnt += __builtin_popcount(s1[i * 8 + w] ^ s2[i * 8 + w]); }
                    (void)__hip_atomic_fetch_add(dbg + 128, cnt, __ATOMIC_RELAXED, __HIP_MEMORY_SCOPE_AGENT); }
                if (MK_CMP_ATT >= 4) { unsigned cnt = 0u; for (unsigned i = (unsigned)b_ * 512u + (unsigned)F.tid; i < (unsigned)S_ * NSAW; i += (unsigned)F.G * 512u) { const float d = fabsf(bf2f(P.A[i]) - bf2f(A2[i])); if (d > 0.02f) ++cnt; } (void)__hip_atomic_fetch_add(dbg + 128, cnt, __ATOMIC_RELAXED, __HIP_MEMORY_SCOPE_AGENT); }
                (void)__hip_atomic_fetch_max(dbg, __builtin_bit_cast(unsigned, mx), __ATOMIC_RELAXED, __HIP_MEMORY_SCOPE_AGENT);
                SEAM();
                const unsigned gm = __hip_atomic_load(dbg, __ATOMIC_RELAXED, __HIP_MEMORY_SCOPE_AGENT);
                if (__builtin_bit_cast(unsigned, mx) == gm && mx > 0.f) __hip_atomic_store(dbg + 64, mi, __ATOMIC_RELAXED, __HIP_MEMORY_SCOPE_AGENT);
                SEAM();
                const unsigned gi = __hip_atomic_load(dbg + 64, __ATOMIC_RELAXED, __HIP_MEMORY_SCOPE_AGENT);
                const float val = (MK_CMP_ATT >= 9) ? 1000.f + (float)__hip_atomic_load(dbg + 192, __ATOMIC_RELAXED, __HIP_MEMORY_SCOPE_AGENT) : (MK_CMP_ATT == 7 || MK_CMP_ATT == 8) ? 1e5f * __builtin_bit_cast(float, gm) : (MK_CMP_ATT >= 4) ? 1000.f + (float)__hip_atomic_load(dbg + 128, __ATOMIC_RELAXED, __HIP_MEMORY_SCOPE_AGENT) : (MK_CMP_ATT == 1) ? 1e5f * __builtin_bit_cast(float, gm) : (MK_CMP_ATT == 2) ? 1000.f + (float)(gi / NSAW) : 1000.f + (float)(gi % NSAW);
                for (size_t i = (size_t)b_ * 512 + F.tid; i < (size_t)S_ * DM; i += (size_t)F.G * 512) X[i] = val;
                return;
            }
#endif
            {
                GAS unsigned* ctr = (GAS unsigned*)(w_ + WS_CTL) + 8192 + 64 * l;
                volatile LAS unsigned* bw = (volatile LAS unsigned*)(F.lds + MISC_OFF) + 4;
#pragma unroll 1
                for (;;) {
                    if (F.tid == 0) bw[0] = __hip_atomic_fetch_add(ctr, 1u, __ATOMIC_RELAXED, __HIP_MEMORY_SCOPE_AGENT);
                    __syncthreads();
                    const int u = __builtin_amdgcn_readfirstlane((int)bw[0]);
                    __syncthreads();
                    if (u >= (S_ / 64) * NGRP) break;
                    nsa_unit_v2(F, P, 255 - (u >> 2), u & 3);
                }
            }
            __syncthreads();
            SEAM(); TS1(6);
        }
        if (IN(7)) { PHASE_BEGIN(); TS0();
            pg8::Sched<S_ / 256, DM / 256, 2, true> S; S.init(F.G, b_);
            EpiMerge E{(gbf*)(w_ + WS_Y1), (const gbf*)(w_ + WS_MG)};
            pg8::gemm_phase<NSAW, NSAW, NSAW, (long)(WS_P - WS_A) / 2, (long)(WS_WBRP - WS_WBRA) / 2>(F.lds, F.tid, (const gbf*)(w_ + WS_A), (const gbf*)(w_ + WS_WBRA), S, E);
            SEAM(); TS1(7);
        }
        if (IN(8)) { PHASE_BEGIN(); TS0();
            pg8::SchedPanel<S_ / 256> S; S.init(F.G, b_);
            EpiBf16 E{(gbf*)(w_ + WS_Y2), DM, 0, 1.f};
            pg8::gemm_phase<DM, DM, DM, 0, 0>(F.lds, F.tid, (const gbf*)(w_ + WS_Y1), (const gbf*)(w_ + WS_WMIX), S, E);
            SEAM(); TS1(8);
        }
        if (IN(9)) { PHASE_BEGIN(); TS0();
#pragma unroll 1
            for (int m = F.gw; m < S_; m += F.NGW) resid_row((const gbf*)(w_ + WS_XB) + (size_t)m * DM, (gbf*)(w_ + WS_XB) + (size_t)m * DM, (gfl*)nullptr, (const gbf*)(w_ + WS_Y2) + (size_t)m * DM, INP(I_LN_MIX_POST) + (size_t)l * DM, (gfl*)(w_ + WS_R) + m, F.lane);
            SEAM(); TS1(9);
        }
        if (IN(10)) { PHASE_BEGIN(); TS0();
            pg8::Sched<S_ / 256, XW / 256, 1, false> S; S.init(F.G, b_);
            EpiBf16 E{(gbf*)(w_ + WS_Q2), XW, 0, 1.f, (const gfl*)(w_ + WS_R)};
            pg8::gemm_phase<DM, DM, DM, 0, 0>(F.lds, F.tid, (const gbf*)(w_ + WS_XB), (const gbf*)(w_ + WS_WXQ), S, E);
            if (l == 0 && b_ >= 128) {
                pg8::Sched<1, 4, 4, false> S2; S2.init(F.G - 128, b_ - 128);
                EpiKVmem E2{(gbf*)(w_ + WS_KM), (gbf*)(w_ + WS_VMT)};
                pg8::gemm_phase<DM, DM, DM, (long)NMEM * DM, (long)1024 * DM>(F.lds, F.tid, (const gbf*)(w_ + WS_MEMN2), (const gbf*)(w_ + WS_WXKV2), S2, E2);
            }
            const int c10 = F.G > 144 ? (l == 0 ? 144 : 128) : 0;
            if (b_ >= c10) {
                __syncthreads();
                if (F.tid == 0) { LAS TrDesc* tab = (LAS TrDesc*)(F.lds + TR_TAB_OFF); int nd = launder_int(0), total = launder_int(0); const gfl* nul = nullptr;
                    TR_PUT(INP(I_W_GATE) + (size_t)l * DM * DFF, DM, DFF, (gbf*)(w_ + WS_WGU), DM, 2 | 8, 0, INP(I_LN_FFN_PRE) + (size_t)l * DM);
                    TR_PUT(INP(I_W_UP) + (size_t)l * DM * DFF, DM, DFF, (gbf*)(w_ + WS_WGU), DM, 2 | 8, 128, INP(I_LN_FFN_PRE) + (size_t)l * DM);
                    TR_PUT(INP(I_W_DOWN) + (size_t)l * DFF * DM, (F.G > 64) ? DFF / 2 : DFF, DM, (gbf*)(w_ + WS_WDN), DFF, 0, 0, nul);
                    trn[0] = nd; trn[1] = total; }
                LDS_WAIT(); __syncthreads();
                Frame F2 = F; F2.gw = (b_ - c10) * NWAVES + F.wave; F2.NGW = (F.G - c10) * NWAVES;
                tr_run(F2, trn[0], trn[1]);
                __syncthreads();
            }
            SEAM(); TS1(10);
        }
        if (IN(11)) { PHASE_BEGIN(); TS0();
#pragma unroll 1
            for (int u = b_; u < (S_ / 256) * 4; u += F.G) xattn_unit_v2(F, (const gbf*)(w_ + WS_Q2), (const gbf*)(w_ + WS_KM) + (size_t)l * NMEM * XW, (const gbf*)(w_ + WS_VMT) + (size_t)l * XW * NMEM, (gbf*)(w_ + WS_O2), u >> 2, u & 3);
            SEAM(); TS1(11);
        }
        if (IN(12)) { PHASE_BEGIN(); TS0();
            pg8::SchedPanel<S_ / 256> S; S.init(F.G, b_);
            EpiBf16 E{(gbf*)(w_ + WS_Y2), DM, 0, 1.f};
            pg8::gemm_phase<XW, XW, XW, 0, 0>(F.lds, F.tid, (const gbf*)(w_ + WS_O2), (const gbf*)(w_ + WS_WXO), S, E);
            SEAM(); TS1(12);
        }
        if (IN(13)) { PHASE_BEGIN(); TS0();
#pragma unroll 1
            for (int m = F.gw; m < S_; m += F.NGW) resid_row((const gbf*)(w_ + WS_XB) + (size_t)m * DM, (gbf*)(w_ + WS_XB) + (size_t)m * DM, (gfl*)nullptr, (const gbf*)(w_ + WS_Y2) + (size_t)m * DM, INP(I_LN_X_POST) + (size_t)l * DM, (gfl*)(w_ + WS_R) + m, F.lane);
            SEAM(); TS1(13);
        }
        if (IN(14)) { PHASE_BEGIN(); TS0();
            pg8::Sched<S_ / 256, 2 * DFF / 256, 1, false> S; S.init(F.G, b_);
            EpiSwiGLU E{(gbf*)(w_ + WS_HID), (const gfl*)(w_ + WS_R)};
            pg8::gemm_phase<DM, DM, DM, 0, 0>(F.lds, F.tid, (const gbf*)(w_ + WS_XB), (const gbf*)(w_ + WS_WGU), S, E);
            SEAM(); TS1(14);
        }
        if (IN(15)) { PHASE_BEGIN(); TS0();
            pg8::SchedPanel<S_ / 256> S; S.init(F.G, b_);
            EpiBf16 E{(gbf*)(w_ + WS_Y2), DM, 0, 1.f};
            pg8::gemm_phase<DFF, DFF, DFF, 0, 0>(F.lds, F.tid, (const gbf*)(w_ + WS_HID), (const gbf*)(w_ + WS_WDN), S, E);
            SEAM(); TS1(15);
        }
        if (IN(16)) { PHASE_BEGIN(); TS0();
#pragma unroll 1
            for (int m = F.gw; m < S_; m += F.NGW) resid_row((const gbf*)(w_ + WS_XB) + (size_t)m * DM, (gbf*)(w_ + WS_XB) + (size_t)m * DM, (l + 1 < NL) ? (gfl*)nullptr : X + (size_t)m * DM, (const gbf*)(w_ + WS_Y2) + (size_t)m * DM, INP(I_LN_FFN_POST) + (size_t)l * DM, (l + 1 < NL) ? (gfl*)(w_ + WS_R) + m : (gfl*)nullptr, F.lane);
            if (l + 1 < launder_int(l_hi)) SEAM(); TS1(16);
        }
    }

    if (launder_int(l_lo) <= 3 && 3 < launder_int(l_hi)) { constexpr int l = 3;
        if (IN(2)) { PHASE_BEGIN(); TS0();
            if (F.tid == 0) { LAS TrDesc* tab = (LAS TrDesc*)(F.lds + TR_TAB_OFF); int nd = launder_int(0), total = launder_int(0); const gfl* nul = nullptr;
                TR_PUT(INP(I_W_IN) + (size_t)l * DM * INW, DM, INW, (gbf*)(w_ + WS_WIN), DM, 1 | 8, 0, INP(I_LN_MIX_PRE) + (size_t)l * DM);
                for (int q = 0; q < 4; ++q) { const int kv = q >> 1, half = q & 1;
                    TR_PUT(INP(I_CMP_W1) + (((size_t)l * 2 + kv) * 2048 + half * 1024) * 128, 1024, 128, (gbf*)(w_ + WS_WC1) + (size_t)kv * 256 * 1024, 1024, 0, half * 128, nul); }
                for (int gi = 0; gi < 4; ++gi)
                    TR_PUT(INP(I_W_POOL) + ((size_t)l * 4 + gi) * 65536, 256, 256, (gbf*)(w_ + WS_WPOOL) + (size_t)gi * 65536, 256, 0, 0, INP(I_POOL_SCALE) + (size_t)l * POOLW + gi * 256);
                trn[0] = nd; trn[1] = total; }
            LDS_WAIT(); __syncthreads();
            if (F.gw < 32) {
                const int p = F.gw >> 2, kv = (F.gw >> 1) & 1, j = (F.gw & 1) * 64 + F.lane;
                const gfl* pe = INP(I_CMP_PE) + ((size_t)l * 2 + kv) * 2048 + p * 256; const gfl* w1 = INP(I_CMP_W1) + (((size_t)l * 2 + kv) * 2048 + p * 256) * 128 + j;
                float a = 0.f;
#pragma unroll 32
                for (int k = 0; k < 256; ++k) a += pe[k] * w1[(size_t)k * 128];
                ((gfl*)(w_ + WS_PEB))[p * 256 + kv * 128 + j] = a;
            }
            tr_run(F, trn[0], trn[1]);
            __syncthreads();
            SEAM(); TS1(2);
        }
        if (IN(3)) { PHASE_BEGIN(); TS0();
            pg8::Sched<S_ / 256, ZN / 256, 1, false> S; S.init(F.G, b_);
            EpiZ E{w_};
            pg8::gemm_phase<DM, DM, DM, 0, 0>(F.lds, F.tid, (const gbf*)(w_ + WS_XB), (const gbf*)(w_ + WS_WIN), S, E);
            const int c3 = ((S_ / 256) * (ZN / 256)) % F.G;
            if (b_ >= c3) {
                __syncthreads();
                if (F.tid == 0) { LAS TrDesc* tab = (LAS TrDesc*)(F.lds + TR_TAB_OFF); int nd = launder_int(0), total = launder_int(0); const gfl* nul = nullptr;
                    TR_PUT(INP(I_W_BR_ATTN) + (size_t)l * NSAW * DM, NSAW, DM, (gbf*)(w_ + WS_WBRA), NSAW, 0, 0, nul);
                    TR_PUT(INP(I_W_BR_POOL) + (size_t)l * POOLW * DM, POOLW, DM, (gbf*)(w_ + WS_WBRP), POOLW, 0, 0, nul);
                    TR_PUT(INP(I_W_MIX_OUT) + (size_t)l * DM * DM, DM, DM, (gbf*)(w_ + WS_WMIX), DM, 0, 0, nul);
                    TR_PUT(INP(I_W_XQ) + (size_t)l * DM * XW, DM, XW, (gbf*)(w_ + WS_WXQ), DM, 0 | 8, 0, INP(I_LN_X_PRE) + (size_t)l * DM);
                    TR_PUT(INP(I_W_XO) + (size_t)l * XW * DM, XW, DM, (gbf*)(w_ + WS_WXO), XW, 0, 0, nul);
                    trn[0] = nd; trn[1] = total; }
                LDS_WAIT(); __syncthreads();
                Frame F2 = F; F2.gw = (b_ - c3) * NWAVES + F.wave; F2.NGW = (F.G - c3) * NWAVES;
                tr_run(F2, trn[0], trn[1]);
                __syncthreads();
            }
            SEAM(); TS1(3);
        }
        if (IN(4)) { PHASE_BEGIN(); TS0();
            if (F.G <= 64) {
#pragma unroll 1
                for (int it = F.gw; it < 2 * S_; it += F.NGW) pool_item((const gbf*)(w_ + WS_U), (gbf*)(w_ + WS_YP), it, F.lane);
                __syncthreads();
            } else if (b_ >= 32) {
#pragma unroll 1
                for (int it = (b_ - 32) * NWAVES + F.wave; it < 2 * S_; it += (F.G - 32) * NWAVES) pool_item((const gbf*)(w_ + WS_U), (gbf*)(w_ + WS_YP), it, F.lane);
                if (F.tid == 0) { LAS TrDesc* tab = (LAS TrDesc*)(F.lds + TR_TAB_OFF); int nd = launder_int(0), total = launder_int(0); const gfl* nul = nullptr;
                    TR_PUT(INP(I_W_DOWN) + ((size_t)l * DFF + DFF / 2) * DM, DFF / 2, DM, (gbf*)(w_ + WS_WDN) + DFF / 2, DFF, 0, 0, nul);
                    trn[0] = nd; trn[1] = total; }
                LDS_WAIT(); __syncthreads();
                Frame F2 = F; F2.gw = (b_ - 32) * NWAVES + F.wave; F2.NGW = (F.G - 32) * NWAVES;
                tr_run(F2, trn[0], trn[1]);
                __syncthreads();
            }
            pg8::Sched<16, 1, 2, false> S; S.init(F.G, b_);
            EpiF32 E{(gfl*)(w_ + WS_PQ), 256, (size_t)4096 * 256};
            pg8::gemm_phase<1024, 1024, 1024, (long)(WS_VCR - WS_KCR) / 2, (long)256 * 1024>(F.lds, F.tid, (const gbf*)(w_ + WS_KCR), (const gbf*)(w_ + WS_WC1), S, E);
            SEAM(); TS1(4);
        }
        if (IN(5)) { PHASE_BEGIN(); TS0();
            LAS float* hid = (LAS float*)(F.lds + F.wave * 2048);
#pragma unroll 1
            for (int it = F.gw; it < 2048; it += F.NGW) cmp_final_item4((const gfl*)(w_ + WS_PQ), (const gfl*)(w_ + WS_PEB), INP(I_CMP_W2) + (size_t)l * 2 * 128 * 64, (gbf*)(w_ + WS_KC), (gbf*)(w_ + WS_VCT), hid, it, F.lane);
            __syncthreads();
            pg8::Sched<S_ / 256, 1, 4, false> S; S.init(F.G, b_);
            EpiBf16 E{(gbf*)(w_ + WS_P), POOLW, 256, 1.f};
            pg8::gemm_phase<POOLW, 256, 256, 256, 65536>(F.lds, F.tid, (const gbf*)(w_ + WS_YP), (const gbf*)(w_ + WS_WPOOL), S, E);
            SEAM(); TS1(5);
        }
        if (IN(6)) { PHASE_BEGIN(); TS0();
            attn_setup_tables(F, INP(I_RELB));
            const AttnPtrs P{(const gbf*)(w_ + WS_Q), (const gbf*)(w_ + WS_KC), (const gbf*)(w_ + WS_VCT), (const gbf*)(w_ + WS_KSEL), (const gbf*)(w_ + WS_VSELT), (const gbf*)(w_ + WS_KWIN), (const gbf*)(w_ + WS_VWINT),
                             (const gfl*)(w_ + WS_GL), (gbf*)(w_ + WS_A)};
#ifdef MK_CMP_ATT
            {
                gbf* A2 = (gbf*)(w_ + WS_YP);
#pragma unroll 1
                for (int it = F.gw; it < (S_ / 4) * NGRP; it += F.NGW) nsa_unit_v1(F, P, it >> 2, it & 3);
                __syncthreads();
                const AttnPtrs P2{P.Q, P.KC, P.VCT, P.KSEL, P.VSELT, P.KWIN, P.VWINT, P.GL, A2};
#pragma unroll 1
                for (int u = b_; u < (S_ / 64) * NGRP; u += F.G) { const int c = u & 255, r = u >> 8; nsa_unit_v2(F, P2, (r < 2) ? 255 - (c >> 1) : (c >> 1), (c & 1) * 2 + (r & 1)); }
                __syncthreads();
                SEAM();
                GAS unsigned* dbg = (GAS unsigned*)(w_ + WS_CTL) + 64;
                float mx = 0.f; unsigned mi = 0u;
                for (unsigned i = (unsigned)b_ * 512u + (unsigned)F.tid; i < (unsigned)S_ * NSAW; i += (unsigned)F.G * 512u) { const float d = fabsf(bf2f(P.A[i]) - bf2f(A2[i])); if (d > mx) { mx = d; mi = i; } }
                if (MK_CMP_ATT == 7 || MK_CMP_ATT == 8) { mx = 0.f; mi = 0u; const GAS float* i1 = (const GAS float*)(w_ + WS_END + 16 * MiB); const GAS float* i2 = (const GAS float*)(w_ + WS_END + 96 * MiB);
                    for (unsigned i = (unsigned)b_ * 512u + (unsigned)F.tid; i < (unsigned)S_ * 4 * 256; i += (unsigned)F.G * 512u) { const int j = i & 255, t = i >> 10, cur = t >> 6; if (cur >= 16 && j >= 1 && j <= cur - 2) { const float d = fabsf(i1[i] - i2[i]) / (MK_CMP_ATT == 8 ? fmaxf(fabsf(i1[i]), 1e-12f) : 1.f); if (d > mx) { mx = d; mi = i; } } } }
                if (MK_CMP_ATT == 12 || MK_CMP_ATT == 13) { unsigned cnt = 0u; const GAS unsigned* sm = (const GAS unsigned*)(w_ + WS_END + (MK_CMP_ATT == 12 ? 400 : 404) * MiB); const GAS float* im = (const GAS float*)(w_ + WS_END + 16 * MiB);
                    for (unsigned i = (unsigned)b_ * 512u + (unsigned)F.tid; i < (unsigned)S_ * 4; i += (unsigned)F.G * 512u) { const int t = i >> 2, cur = t >> 6; if (cur < 16) continue;
                        float mins = 1e30f, maxu = -1.f;
                        for (int j = 1; j <= cur - 2; ++j) { const float v = im[(size_t)i * 256 + j]; const bool s = (sm[i * 8 + (j >> 5)] >> (j & 31)) & 1u; if (s) mins = fminf(mins, v); else maxu = fmaxf(maxu, v); }
                        if (mins < maxu) ++cnt; }
                    (void)__hip_atomic_fetch_add(dbg + 192, cnt, __ATOMIC_RELAXED, __HIP_MEMORY_SCOPE_AGENT); }
                if (MK_CMP_ATT == 9 || MK_CMP_ATT == 10 || MK_CMP_ATT == 11) { unsigned cnt = 0u; const GAS unsigned* s1 = (const GAS unsigned*)(w_ + WS_END + 400 * MiB); const GAS unsigned* s2 = (const GAS unsigned*)(w_ + WS_END + 404 * MiB);
                    for (unsigned i = (unsigned)b_ * 512u + (unsigned)F.tid; i < (unsigned)S_ * 4; i += (unsigned)F.G * 512u) { unsigned x = 0u; bool df = false; for (int w = 0; w < 8; ++w) { df |= (s1[i * 8 + w] != s2[i * 8 + w]); x += __builtin_popcount(MK_CMP_ATT == 10 ? s1[i * 8 + w] : s2[i * 8 + w]); } cnt += (MK_CMP_ATT == 9) ? (df ? 1u : 0u) : x; }
                    (void)__hip_atomic_fetch_add(dbg + 192, cnt, __ATOMIC_RELAXED, __HIP_MEMORY_SCOPE_AGENT); }
                if (MK_CMP_ATT == 5) { unsigned cnt = 0u; const GAS unsigned* s1 = (const GAS unsigned*)(w_ + WS_END + 400 * MiB); const GAS unsigned* s2 = (const GAS unsigned*)(w_ + WS_END + 404 * MiB);
                    for (unsigned i = (unsigned)b_ * 512u + (unsigned)F.tid; i < (unsigned)S_ * 4; i += (unsigned)F.G * 512u) { bool df = false; for (int w = 0; w < 8; ++w) df |= (s1[i * 8 + w] != s2[i * 8 + w]); if (df) ++cnt; }
                    (void)__hip_atomic_fetch_add(dbg + 128, cnt, __ATOMIC_RELAXED, __HIP_MEMORY_SCOPE_AGENT); }
                if (MK_CMP_ATT == 6) { unsigned cnt = 0u; const GAS unsigned* s1 = (const GAS unsigned*)(w_ + WS_END + 400 * MiB); const GAS unsigned* s2 = (const GAS unsigned*)(w_ + WS_END + 404 * MiB);
                    for (unsigned i = (unsigned)b_ * 512u + (unsigned)F.tid; i < (unsigned)S_ * 4; i += (unsigned)F.G * 512u) { for (int w = 0; w < 8; ++w) cnt += __builtin_popcount(s1[i * 8 + w] ^ s2[i * 8 + w]); }
                    (void)__hip_atomic_fetch_add(dbg + 128, cnt, __ATOMIC_RELAXED, __HIP_MEMORY_SCOPE_AGENT); }
                if (MK_CMP_ATT >= 4) { unsigned cnt = 0u; for (unsigned i = (unsigned)b_ * 512u + (unsigned)F.tid; i < (unsigned)S_ * NSAW; i += (unsigned)F.G * 512u) { const float d = fabsf(bf2f(P.A[i]) - bf2f(A2[i])); if (d > 0.02f) ++cnt; } (void)__hip_atomic_fetch_add(dbg + 128, cnt, __ATOMIC_RELAXED, __HIP_MEMORY_SCOPE_AGENT); }
                (void)__hip_atomic_fetch_max(dbg, __builtin_bit_cast(unsigned, mx), __ATOMIC_RELAXED, __HIP_MEMORY_SCOPE_AGENT);
                SEAM();
                const unsigned gm = __hip_atomic_load(dbg, __ATOMIC_RELAXED, __HIP_MEMORY_SCOPE_AGENT);
                if (__builtin_bit_cast(unsigned, mx) == gm && mx > 0.f) __hip_atomic_store(dbg + 64, mi, __ATOMIC_RELAXED, __HIP_MEMORY_SCOPE_AGENT);
                SEAM();
                const unsigned gi = __hip_atomic_load(dbg + 64, __ATOMIC_RELAXED, __HIP_MEMORY_SCOPE_AGENT);
                const float val = (MK_CMP_ATT >= 9) ? 1000.f + (float)__hip_atomic_load(dbg + 192, __ATOMIC_RELAXED, __HIP_MEMORY_SCOPE_AGENT) : (MK_CMP_ATT == 7 || MK_CMP_ATT == 8) ? 1e5f * __builtin_bit_cast(float, gm) : (MK_CMP_ATT >= 4) ? 1000.f + (float)__hip_atomic_load(dbg + 128, __ATOMIC_RELAXED, __HIP_MEMORY_SCOPE_AGENT) : (MK_CMP_ATT == 1) ? 1e5f * __builtin_bit_cast(float, gm) : (MK_CMP_ATT == 2) ? 1000.f + (float)(gi / NSAW) : 1000.f + (float)(gi % NSAW);
                for (size_t i = (size_t)b_ * 512 + F.tid; i < (size_t)S_ * DM; i += (size_t)F.G * 512) X[i] = val;
                return;
            }
#endif
            {
                GAS unsigned* ctr = (GAS unsigned*)(w_ + WS_CTL) + 8192 + 64 * l;
                volatile LAS unsigned* bw = (volatile LAS unsigned*)(F.lds + MISC_OFF) + 4;
#pragma unroll 1
                for (;;) {
                    if (F.tid == 0) bw[0] = __hip_atomic_fetch_add(ctr, 1u, __ATOMIC_RELAXED, __HIP_MEMORY_SCOPE_AGENT);
                    __syncthreads();
                    const int u = __builtin_amdgcn_readfirstlane((int)bw[0]);
                    __syncthreads();
                    if (u >= (S_ / 64) * NGRP) break;
                    nsa_unit_v2(F, P, 255 - (u >> 2), u & 3);
                }
            }
            __syncthreads();
            SEAM(); TS1(6);
        }
        if (IN(7)) { PHASE_BEGIN(); TS0();
            pg8::Sched<S_ / 256, DM / 256, 2, true> S; S.init(F.G, b_);
            EpiMerge E{(gbf*)(w_ + WS_Y1), (const gbf*)(w_ + WS_MG)};
            pg8::gemm_phase<NSAW, NSAW, NSAW, (long)(WS_P - WS_A) / 2, (long)(WS_WBRP - WS_WBRA) / 2>(F.lds, F.tid, (const gbf*)(w_ + WS_A), (const gbf*)(w_ + WS_WBRA), S, E);
            SEAM(); TS1(7);
        }
        if (IN(8)) { PHASE_BEGIN(); TS0();
            pg8::SchedPanel<S_ / 256> S; S.init(F.G, b_);
            EpiBf16 E{(gbf*)(w_ + WS_Y2), DM, 0, 1.f};
            pg8::gemm_phase<DM, DM, DM, 0, 0>(F.lds, F.tid, (const gbf*)(w_ + WS_Y1), (const gbf*)(w_ + WS_WMIX), S, E);
            SEAM(); TS1(8);
        }
        if (IN(9)) { PHASE_BEGIN(); TS0();
#pragma unroll 1
            for (int m = F.gw; m < S_; m += F.NGW) resid_row((const gbf*)(w_ + WS_XB) + (size_t)m * DM, (gbf*)(w_ + WS_XB) + (size_t)m * DM, (gfl*)nullptr, (const gbf*)(w_ + WS_Y2) + (size_t)m * DM, INP(I_LN_MIX_POST) + (size_t)l * DM, (gfl*)(w_ + WS_R) + m, F.lane);
            SEAM(); TS1(9);
        }
        if (IN(10)) { PHASE_BEGIN(); TS0();
            pg8::Sched<S_ / 256, XW / 256, 1, false> S; S.init(F.G, b_);
            EpiBf16 E{(gbf*)(w_ + WS_Q2), XW, 0, 1.f, (const gfl*)(w_ + WS_R)};
            pg8::gemm_phase<DM, DM, DM, 0, 0>(F.lds, F.tid, (const gbf*)(w_ + WS_XB), (const gbf*)(w_ + WS_WXQ), S, E);
            if (l == 0 && b_ >= 128) {
                pg8::Sched<1, 4, 4, false> S2; S2.init(F.G - 128, b_ - 128);
                EpiKVmem E2{(gbf*)(w_ + WS_KM), (gbf*)(w_ + WS_VMT)};
                pg8::gemm_phase<DM, DM, DM, (long)NMEM * DM, (long)1024 * DM>(F.lds, F.tid, (const gbf*)(w_ + WS_MEMN2), (const gbf*)(w_ + WS_WXKV2), S2, E2);
            }
            const int c10 = F.G > 144 ? (l == 0 ? 144 : 128) : 0;
            if (b_ >= c10) {
                __syncthreads();
                if (F.tid == 0) { LAS TrDesc* tab = (LAS TrDesc*)(F.lds + TR_TAB_OFF); int nd = launder_int(0), total = launder_int(0); const gfl* nul = nullptr;
                    TR_PUT(INP(I_W_GATE) + (size_t)l * DM * DFF, DM, DFF, (gbf*)(w_ + WS_WGU), DM, 2 | 8, 0, INP(I_LN_FFN_PRE) + (size_t)l * DM);
                    TR_PUT(INP(I_W_UP) + (size_t)l * DM * DFF, DM, DFF, (gbf*)(w_ + WS_WGU), DM, 2 | 8, 128, INP(I_LN_FFN_PRE) + (size_t)l * DM);
                    TR_PUT(INP(I_W_DOWN) + (size_t)l * DFF * DM, (F.G > 64) ? DFF / 2 : DFF, DM, (gbf*)(w_ + WS_WDN), DFF, 0, 0, nul);
                    trn[0] = nd; trn[1] = total; }
                LDS_WAIT(); __syncthreads();
                Frame F2 = F; F2.gw = (b_ - c10) * NWAVES + F.wave; F2.NGW = (F.G - c10) * NWAVES;
                tr_run(F2, trn[0], trn[1]);
                __syncthreads();
            }
            SEAM(); TS1(10);
        }
        if (IN(11)) { PHASE_BEGIN(); TS0();
#pragma unroll 1
            for (int u = b_; u < (S_ / 256) * 4; u += F.G) xattn_unit_v2(F, (const gbf*)(w_ + WS_Q2), (const gbf*)(w_ + WS_KM) + (size_t)l * NMEM * XW, (const gbf*)(w_ + WS_VMT) + (size_t)l * XW * NMEM, (gbf*)(w_ + WS_O2), u >> 2, u & 3);
            SEAM(); TS1(11);
        }
        if (IN(12)) { PHASE_BEGIN(); TS0();
            pg8::SchedPanel<S_ / 256> S; S.init(F.G, b_);
            EpiBf16 E{(gbf*)(w_ + WS_Y2), DM, 0, 1.f};
            pg8::gemm_phase<XW, XW, XW, 0, 0>(F.lds, F.tid, (const gbf*)(w_ + WS_O2), (const gbf*)(w_ + WS_WXO), S, E);
            SEAM(); TS1(12);
        }
        if (IN(13)) { PHASE_BEGIN(); TS0();
#pragma unroll 1
            for (int m = F.gw; m < S_; m += F.NGW) resid_row((const gbf*)(w_ + WS_XB) + (size_t)m * DM, (gbf*)(w_ + WS_XB) + (size_t)m * DM, (gfl*)nullptr, (const gbf*)(w_ + WS_Y2) + (size_t)m * DM, INP(I_LN_X_POST) + (size_t)l * DM, (gfl*)(w_ + WS_R) + m, F.lane);
            SEAM(); TS1(13);
        }
        if (IN(14)) { PHASE_BEGIN(); TS0();
            pg8::Sched<S_ / 256, 2 * DFF / 256, 1, false> S; S.init(F.G, b_);
            EpiSwiGLU E{(gbf*)(w_ + WS_HID), (const gfl*)(w_ + WS_R)};
            pg8::gemm_phase<DM, DM, DM, 0, 0>(F.lds, F.tid, (const gbf*)(w_ + WS_XB), (const gbf*)(w_ + WS_WGU), S, E);
            SEAM(); TS1(14);
        }
        if (IN(15)) { PHASE_BEGIN(); TS0();
            pg8::SchedPanel<S_ / 256> S; S.init(F.G, b_);
            EpiBf16 E{(gbf*)(w_ + WS_Y2), DM, 0, 1.f};
            pg8::gemm_phase<DFF, DFF, DFF, 0, 0>(F.lds, F.tid, (const gbf*)(w_ + WS_HID), (const gbf*)(w_ + WS_WDN), S, E);
            SEAM(); TS1(15);
        }
        if (IN(16)) { PHASE_BEGIN(); TS0();
#pragma unroll 1
            for (int m = F.gw; m < S_; m += F.NGW) resid_row((const gbf*)(w_ + WS_XB) + (size_t)m * DM, (gbf*)(w_ + WS_XB) + (size_t)m * DM, (l + 1 < NL) ? (gfl*)nullptr : X + (size_t)m * DM, (const gbf*)(w_ + WS_Y2) + (size_t)m * DM, INP(I_LN_FFN_POST) + (size_t)l * DM, (l + 1 < NL) ? (gfl*)(w_ + WS_R) + m : (gfl*)nullptr, F.lane);
            if (l + 1 < launder_int(l_hi)) SEAM(); TS1(16);
        }
    }

#ifdef MK_COUNT
    SEAM();
    { const unsigned cv = __hip_atomic_load((GAS unsigned*)(ws + WS_CTL) + 9000, __ATOMIC_RELAXED, __HIP_MEMORY_SCOPE_AGENT);
      const float val = 100.f * (float)cv / (MK_COUNT == 1 ? 4096.f : 32768.f);
      for (size_t i = (size_t)blockIdx.x * 512 + threadIdx.x; i < (size_t)S_ * DM; i += (size_t)gridDim.x * 512) X[i] = val; }
#endif
#ifdef MK_TIMING
    SEAM();
    if (blockIdx.x == 0) { const float a_ = (float)tacc1 * 1e-4f, b_ = (float)tacc2 * 1e-5f;
        if (threadIdx.x == 0) X[0] += a_;
        for (int i = threadIdx.x; i < (1 << 20); i += NWAVES * 64) X[(1 << 20) + i] += b_; }
#endif
#ifdef MK_DEBUG_DUMP
    if (args.pad > 0) {
        const gbf* src = (const gbf*)(ws + (size_t)args.pad * MiB);
        for (size_t i = (size_t)blockIdx.x * 512 + threadIdx.x; i < (size_t)S_ * DM; i += (size_t)gridDim.x * 512) X[i] = bf2f(src[i]);
    }
#endif
#undef IN
#undef SEAM
}

#ifndef MK_PER_PHASE
#define MK_PER_PHASE 0
#endif
extern "C" void kernel_launch(void* const* d_in, const int* in_sizes, int n_in, void* d_out, int out_size, void* d_ws, size_t ws_size, hipStream_t stream) {
    static int grid = 0;
    if (grid == 0) {
        if (n_in != 25 || out_size != S_ * DM || ws_size < WS_END) { fprintf(stderr, "kernel_launch: unexpected shapes (n_in %d, out %d, ws %zu, need %zu)\n", n_in, out_size, ws_size, (size_t)WS_END); grid = -1; return; }
        int dev = 0, cus = 0, per_cu = 0;
        if (hipGetDevice(&dev) != hipSuccess || hipDeviceGetAttribute(&cus, hipDeviceAttributeMultiprocessorCount, dev) != hipSuccess) { grid = -1; return; }
        if (hipFuncSetAttribute((const void*)mega_fwd, hipFuncAttributeMaxDynamicSharedMemorySize, LDS_BYTES) != hipSuccess) { fprintf(stderr, "kernel_launch: hipFuncSetAttribute failed\n"); grid = -1; return; }
        if (hipOccupancyMaxActiveBlocksPerMultiprocessor(&per_cu, (const void*)mega_fwd, NWAVES * 64, LDS_BYTES) != hipSuccess || per_cu < 1) { fprintf(stderr, "kernel_launch: occupancy query says %d\n", per_cu); (void)hipGetLastError(); grid = -1; return; }
        grid = cus;
    }
    if (grid < 0) return;
#ifdef MK_DEBUG_DUMP
    (void)hipMemsetAsync((char*)d_ws, 0xAA, WS_END, stream);
    (void)hipMemsetAsync((char*)d_out, 0xAA, (size_t)out_size * 4, stream);
#endif
    (void)hipMemsetAsync((char*)d_ws + WS_CTL, 0, CTL_ZERO_BYTES, stream);
    Args a{};
    for (int i = 0; i < 25; ++i) a.in[i] = (const float*)d_in[i];
    a.out = (float*)d_out; a.ws = (unsigned char*)d_ws; a.pad = 0;
#ifdef MK_DEBUG_DUMP
    a.use_bar = 0;
    for (int ph = 0; ph < 2; ++ph) { a.l_lo = 0; a.l_hi = 1; a.ph_lo = ph; a.ph_hi = ph + 1; hipLaunchKernelGGL(mega_fwd, dim3(grid), dim3(NWAVES * 64), LDS_BYTES, stream, a); }
    for (int ph = 2; ph <= MK_DEBUG_LASTPH; ++ph) { if (ph == 6) continue; a.l_lo = 0; a.l_hi = 1; a.ph_lo = ph; a.ph_hi = ph + 1; hipLaunchKernelGGL(mega_fwd, dim3(grid), dim3(NWAVES * 64), LDS_BYTES, stream, a); }
    a.l_lo = 0; a.l_hi = 0; a.ph_lo = 30; a.ph_hi = 31; a.pad = MK_DEBUG_DUMP; hipLaunchKernelGGL(mega_fwd, dim3(grid), dim3(NWAVES * 64), LDS_BYTES, stream, a);
#elif MK_PER_PHASE
    a.use_bar = 0;
    for (int ph = 0; ph < 2; ++ph) { a.l_lo = 0; a.l_hi = 1; a.ph_lo = ph; a.ph_hi = ph + 1; hipLaunchKernelGGL(mega_fwd, dim3(grid), dim3(NWAVES * 64), LDS_BYTES, stream, a); }
    for (int l = 0; l < NL; ++l)
        for (int ph = 2; ph < NPHASE; ++ph) { a.l_lo = l; a.l_hi = l + 1; a.ph_lo = ph; a.ph_hi = ph + 1; hipLaunchKernelGGL(mega_fwd, dim3(grid), dim3(NWAVES * 64), LDS_BYTES, stream, a); }
#else
    a.use_bar = 1; a.l_lo = 0; a.l_hi = NL; a.ph_lo = 0; a.ph_hi = NPHASE;
    hipLaunchKernelGGL(mega_fwd, dim3(grid), dim3(NWAVES * 64), LDS_BYTES, stream, a);
#endif
}
```

```cpp
#include <hip/hip_runtime.h>
#include <cstdio>
#include <cstdint>
namespace pg8 {
#define PG8_LAS __attribute__((address_space(3)))
#define PG8_GAS __attribute__((address_space(1)))
typedef unsigned short bf16_t;
typedef short bf16x8 __attribute__((ext_vector_type(8)));
typedef float f32x4 __attribute__((ext_vector_type(4)));
typedef float f32x2 __attribute__((ext_vector_type(2)));
typedef unsigned u32x4 __attribute__((ext_vector_type(4)));
typedef unsigned u32x2 __attribute__((ext_vector_type(2)));
constexpr int BM = 256, BK = 64, HALF = 128, HTB = HALF * BK * 2  , STAGE_BYTES = 8 * HTB, NXCD = 8, WGM = 8;

__host__ __device__ __forceinline__ int lds_byte(int r, int c) { const int st = (r >> 4) * 2 + (c >> 5), rr = r & 15, cc = c & 31, ob = rr * 64 + cc * 2; return st * 1024 + (ob ^ (((ob >> 9) & 1) << 5)); }
__host__ __device__ __forceinline__ void stage_rc(int b, int& R, int& C) { const int st = b / 1024, sb = b % 1024, swz = sb ^ (((sb >> 9) & 1) << 5); R = (st >> 1) * 16 + swz / 64; C = (st & 1) * 32 + (swz % 64) / 2; }
__host__ __device__ __forceinline__ int perm32(int rho) { const int n = rho >> 4, i = rho & 15; return 8 * (i >> 2) + 4 * n + (i & 3); }

struct Unit { int pm, pn, sel; };


template <int NM, int NN, int NSEL, bool INNER>
struct Sched {
    int G, c;
    __device__ __forceinline__ void init(int G_, int c_) { G = G_; c = c_; }
    __device__ __forceinline__ bool next(int i, Unit& u) const {
        constexpr int nwg = NM * NN;
        long L; int sel;
        if (INNER) { L = (long)(i / NSEL) * G + c; sel = i % NSEL; if (L >= nwg) return false; }
        else { const long LL = (long)i * G + c; if (LL >= (long)nwg * NSEL) return false; sel = (int)(LL / nwg); L = LL % nwg; }
        int wgid = (int)L; { constexpr int q = nwg / NXCD, r = nwg % NXCD; const int xcd = wgid % NXCD, off = wgid / NXCD; wgid = (xcd < r ? xcd * (q + 1) : r * (q + 1) + (xcd - r) * q) + off; }
        constexpr int nig = WGM * NN; const int gid = wgid / nig, fm = gid * WGM, gsz = (NM - fm) < WGM ? (NM - fm) : WGM;
        u.pm = fm + ((wgid % nig) % gsz); u.pn = (wgid % nig) / gsz; u.sel = sel; return true;
    }
};

template <int NM>
struct SchedPanel {
    int G, c;
    __device__ __forceinline__ void init(int G_, int c_) { G = G_; c = c_; }
    __device__ __forceinline__ bool next(int i, Unit& u) const {
        const int xcd = c & 7, j = c >> 3, ppx = G >> 6;
        const int pm = i * (G >> 3) + xcd * ppx + (j >> 3);
        if (pm >= NM) return false;
        u.pm = pm; u.pn = j & 7; u.sel = 0; return true;
    }
};

typedef __bf16 bf16x2_t __attribute__((ext_vector_type(2)));
__device__ __forceinline__ unsigned cvt_pk_bf16(float lo, float hi) { const f32x2 v = {lo, hi}; const bf16x2_t b = __builtin_convertvector(v, bf16x2_t); return __builtin_bit_cast(unsigned, b); }

template <int LDA, int LDB, int K, long ASEL, long BSEL, class Epi, class SchedT>
__device__ __forceinline__ void gemm_phase(PG8_LAS unsigned char* lds, int tid, const PG8_GAS bf16_t* gA, const PG8_GAS bf16_t* gBt, const SchedT& S, const Epi& E) {
    const int wid = __builtin_amdgcn_readfirstlane(tid >> 6), lane = tid & 63, wr = wid >> 2, wc = wid & 3, fr = lane & 15, fq = lane >> 4;
    constexpr int nt = K / BK;
    unsigned voffA[2], voffB[2];
#pragma unroll
    for (int i = 0; i < 2; ++i) { int R, C; stage_rc(tid * 16 + i * 8192, R, C); const int Rb = Epi::PERM ? ((R & ~31) + perm32(R & 31)) : R;
        voffA[i] = (unsigned)(R * LDA + C) * 2u; voffB[i] = (unsigned)(Rb * LDB + C) * 2u; }
    constexpr size_t kstep = (size_t)(BK * 2);
    constexpr size_t hstepA = (size_t)HALF * LDA * 2, hstepB = (size_t)HALF * LDB * 2;
    constexpr size_t tstepA = 2 * hstepA, tstepB = 2 * hstepB;
    const unsigned ldsw = (unsigned)wid * 1024u;
    const int aoff = lds_byte(wr * 64 + fr, fq * 8), boff = lds_byte(wc * 32 + fr, fq * 8);
#define PG8_SA(b, h) (((b) * 2 + (h)) * HTB)
#define PG8_SB(b, h) ((4 + (b) * 2 + (h)) * HTB)
#define PG8_STAGE(bufoff, gbase, voff) do { _Pragma("unroll") for (int _i = 0; _i < 2; ++_i) \
        __builtin_amdgcn_global_load_lds((const PG8_GAS unsigned*)((const PG8_GAS char*)(gbase) + (voff)[_i]), (PG8_LAS unsigned*)(lds + (bufoff) + ldsw + _i * 8192), 16, 0, 0); } while (0)
#define PG8_LDA(dst, b, h) do { _Pragma("unroll") for (int m = 0; m < 4; ++m) _Pragma("unroll") for (int k = 0; k < 2; ++k) dst[m][k] = *(const PG8_LAS bf16x8*)(lds + PG8_SA(b, h) + aoff + m * 2048 + k * 1024); } while (0)
#define PG8_LDB(dst, b, h) do { _Pragma("unroll") for (int n = 0; n < 2; ++n) _Pragma("unroll") for (int k = 0; k < 2; ++k) dst[n][k] = *(const PG8_LAS bf16x8*)(lds + PG8_SB(b, h) + boff + n * 2048 + k * 1024); } while (0)
#define PG8_MMA(ai, bj, At, Bt) do { __builtin_amdgcn_s_setprio(1); _Pragma("unroll") for (int m = 0; m < 4; ++m) _Pragma("unroll") for (int n = 0; n < 2; ++n) _Pragma("unroll") for (int k = 0; k < 2; ++k) \
        acc[ai][bj][m][n] = __builtin_amdgcn_mfma_f32_16x16x32_bf16(Bt[n][k], At[m][k], acc[ai][bj][m][n], 0, 0, 0); __builtin_amdgcn_s_setprio(0); } while (0)
#define PG8_WAIT_V(n) asm volatile("s_waitcnt vmcnt(" #n ")" ::: "memory")
#define PG8_WAIT_L(n) asm volatile("s_waitcnt lgkmcnt(" #n ")" ::: "memory")
#define PG8_BAR __builtin_amdgcn_s_barrier()
#define PG8_SCHED __builtin_amdgcn_sched_barrier(0)
    Unit cur, nxt; int ui = 0;
    if (!S.next(0, cur)) return;
    f32x4 acc[2][2][4][2];
#pragma unroll
    for (int a = 0; a < 2; ++a)
#pragma unroll
        for (int b = 0; b < 2; ++b)
#pragma unroll
            for (int m = 0; m < 4; ++m)
#pragma unroll
                for (int n = 0; n < 2; ++n) acc[a][b][m][n] = (f32x4){0.f, 0.f, 0.f, 0.f};
    bf16x8 At[4][2], B0[2][2], B1[2][2];
    const PG8_GAS char* cA = (const PG8_GAS char*)(gA + (size_t)cur.sel * ASEL) + (size_t)cur.pm * tstepA; const PG8_GAS char* cB = (const PG8_GAS char*)(gBt + (size_t)cur.sel * BSEL) + (size_t)cur.pn * tstepB;
    PG8_STAGE(PG8_SB(0, 0), cB, voffB); PG8_STAGE(PG8_SB(0, 1), cB + hstepB, voffB); PG8_STAGE(PG8_SA(0, 0), cA, voffA); PG8_STAGE(PG8_SA(0, 1), cA + hstepA, voffA);
    if (wr == 1) PG8_BAR;
    PG8_WAIT_V(2); PG8_BAR;
    PG8_STAGE(PG8_SB(1, 0), cB + kstep, voffB); PG8_STAGE(PG8_SA(1, 0), cA + kstep, voffA); PG8_STAGE(PG8_SB(1, 1), cB + hstepB + kstep, voffB);
    PG8_WAIT_V(6); PG8_BAR;
    for (;;) {
        const bool has_next = S.next(ui + 1, nxt);
        const PG8_GAS char* nA = has_next ? (const PG8_GAS char*)(gA + (size_t)nxt.sel * ASEL) + (size_t)nxt.pm * tstepA : cA; const PG8_GAS char* nB = has_next ? (const PG8_GAS char*)(gBt + (size_t)nxt.sel * BSEL) + (size_t)nxt.pn * tstepB : cB;
#pragma unroll 1
        for (int t = 0; t < nt; t += 2) {
            const bool last = (t == nt - 2);
            const PG8_GAS char* a1 = cA + (size_t)(t + 1) * kstep;
            const PG8_GAS char* a2 = last ? nA : cA + (size_t)(t + 2) * kstep; const PG8_GAS char* b2 = last ? nB : cB + (size_t)(t + 2) * kstep;
            const PG8_GAS char* a3 = a2 + kstep; const PG8_GAS char* b3 = b2 + kstep;
            PG8_LDB(B0, 0, 0); PG8_LDB(B1, 0, 1); PG8_SCHED; PG8_LDA(At, 0, 0); PG8_STAGE(PG8_SA(1, 1), a1 + hstepA, voffA);
            PG8_WAIT_V(8); PG8_WAIT_L(0); PG8_BAR; PG8_MMA(0, 0, At, B0); PG8_MMA(0, 1, At, B1); PG8_BAR; PG8_SCHED;
            PG8_LDA(At, 0, 1); PG8_STAGE(PG8_SB(0, 0), b2, voffB); PG8_STAGE(PG8_SB(0, 1), b2 + hstepB, voffB); PG8_STAGE(PG8_SA(0, 0), a2, voffA);
            PG8_WAIT_V(8); PG8_WAIT_L(0); PG8_BAR; PG8_MMA(1, 0, At, B0); PG8_MMA(1, 1, At, B1); PG8_BAR; PG8_SCHED;
            PG8_LDB(B0, 1, 0); PG8_LDB(B1, 1, 1); PG8_SCHED; PG8_LDA(At, 1, 0); PG8_STAGE(PG8_SA(0, 1), a2 + hstepA, voffA);
            PG8_WAIT_V(8); PG8_WAIT_L(0); PG8_BAR; PG8_MMA(0, 0, At, B0); PG8_MMA(0, 1, At, B1); PG8_BAR; PG8_SCHED;
            PG8_LDA(At, 1, 1); PG8_STAGE(PG8_SB(1, 0), b3, voffB); PG8_STAGE(PG8_SB(1, 1), b3 + hstepB, voffB); PG8_STAGE(PG8_SA(1, 0), a3, voffA);
            PG8_WAIT_V(8); PG8_WAIT_L(0); PG8_BAR; PG8_MMA(1, 0, At, B0); PG8_MMA(1, 1, At, B1); PG8_BAR; PG8_SCHED;
        }
        if (wr == 0) PG8_BAR;
        E(acc, cur, wr, wc, fr, fq);
        if (!has_next) break;
#pragma unroll
        for (int a = 0; a < 2; ++a)
#pragma unroll
            for (int b = 0; b < 2; ++b)
#pragma unroll
                for (int m = 0; m < 4; ++m)
#pragma unroll
                    for (int n = 0; n < 2; ++n) acc[a][b][m][n] = (f32x4){0.f, 0.f, 0.f, 0.f};
        cur = nxt; cA = nA; cB = nB; ++ui;
        if (wr == 1) PG8_BAR;
    }
    PG8_WAIT_V(0);
    PG8_BAR;
#undef PG8_SA
#undef PG8_SB
#undef PG8_STAGE
#undef PG8_LDA
#undef PG8_LDB
#undef PG8_MMA
#undef PG8_WAIT_V
#undef PG8_WAIT_L
#undef PG8_BAR
#undef PG8_SCHED
}
}
constexpr int S_ = 16384, DM = 2048, NL = 4, NMEM = 256;
constexpr int NSAW = 1024, KVW = 256, HD = 64, NHEAD = 16, NGRP = 4;
constexpr int POOLW = 1024, DFF = 5632, XW = 512, XHD = 128;
constexpr int INW = 7728, ZN = 7936;
constexpr int NCMP = 1023;
constexpr float RMS_EPS = 1e-6f;
constexpr float LOG2E = 1.4426950408889634f;
constexpr float QSCALE = 0.125f * LOG2E;
constexpr float XSCALE = 0.08838834764831845f * LOG2E;

typedef unsigned short bf16;
typedef short bf16x8 __attribute__((ext_vector_type(8)));
typedef float f32x4 __attribute__((ext_vector_type(4)));
typedef float f32x2 __attribute__((ext_vector_type(2)));
typedef unsigned u32x4 __attribute__((ext_vector_type(4)));
typedef unsigned u32x2 __attribute__((ext_vector_type(2)));
#define GAS __attribute__((address_space(1)))
#define LAS __attribute__((address_space(3)))
typedef GAS unsigned short gbf;
typedef GAS float gfl;
typedef GAS unsigned char gby;

__device__ __forceinline__ unsigned f2bf(float f) { unsigned u = __builtin_bit_cast(unsigned, f); return (u + 0x7fffu + ((u >> 16) & 1u)) >> 16; }
__device__ __forceinline__ unsigned pk2(float lo, float hi) { return pg8::cvt_pk_bf16(lo, hi); }
__device__ __forceinline__ float bf2f(unsigned short b) { return __builtin_bit_cast(float, (unsigned)b << 16); }
__device__ __forceinline__ float bflo(unsigned w) { return __builtin_bit_cast(float, w << 16); }
__device__ __forceinline__ float bfhi(unsigned w) { return __builtin_bit_cast(float, w & 0xffff0000u); }
__device__ __forceinline__ float sigmoidf_(float x) { return __builtin_amdgcn_rcpf(1.f + __builtin_amdgcn_exp2f(-x * LOG2E)); }

constexpr size_t MiB = 1u << 20;
constexpr size_t WS_CTL = 0, CTL_ZERO_BYTES = 1 * MiB;
constexpr size_t WS_WIN = 1 * MiB;
constexpr size_t WS_WBRA = WS_WIN + 31 * MiB;
constexpr size_t WS_WBRP = WS_WBRA + 4 * MiB;
constexpr size_t WS_WMIX = WS_WBRP + 4 * MiB;
constexpr size_t WS_WXQ = WS_WMIX + 8 * MiB;
constexpr size_t WS_WXO = WS_WXQ + 2 * MiB;
constexpr size_t WS_WGU = WS_WXO + 2 * MiB;
constexpr size_t WS_WDN = WS_WGU + 44 * MiB;
constexpr size_t WS_WC1 = WS_WDN + 22 * MiB;
constexpr size_t WS_WPOOL = WS_WC1 + 1 * MiB;
constexpr size_t WS_PEB = WS_WPOOL + MiB / 2;
constexpr size_t WS_ACT = WS_PEB + MiB / 2;
constexpr size_t WS_H = WS_ACT;
constexpr size_t WS_Q = WS_H + 64 * MiB;
constexpr size_t WS_KCR = WS_Q + 32 * MiB;
constexpr size_t WS_VCR = WS_KCR + 8 * MiB;
constexpr size_t WS_KSEL = WS_VCR + 8 * MiB;
constexpr size_t WS_VSELT = WS_KSEL + 8 * MiB;
constexpr size_t WS_KWIN = WS_VSELT + 8 * MiB;
constexpr size_t WS_VWINT = WS_KWIN + 8 * MiB;
constexpr size_t WS_GL = WS_VWINT + 8 * MiB;
constexpr size_t WS_PQ = WS_GL + 3 * MiB;
constexpr size_t WS_KC = WS_PQ + 8 * MiB;
constexpr size_t WS_VCT = WS_KC + MiB / 2;
constexpr size_t WS_KM = WS_VCT + MiB / 2;
constexpr size_t WS_VMT = WS_KM + 1 * MiB;
constexpr size_t WS_Y1 = WS_VMT + 1 * MiB;
constexpr size_t WS_Y2 = WS_Y1 + 64 * MiB;
constexpr size_t WS_Q2 = WS_Y2 + 64 * MiB;
constexpr size_t WS_O2 = WS_Q2 + 16 * MiB;
constexpr size_t WS_BIG = WS_O2 + 16 * MiB;
constexpr size_t WS_MG = WS_BIG;
constexpr size_t WS_U = WS_MG + 128 * MiB;
constexpr size_t WS_A = WS_U + 32 * MiB;
constexpr size_t WS_P = WS_A + 32 * MiB;
constexpr size_t WS_YP = WS_P + 32 * MiB;
constexpr size_t WS_HID = WS_BIG;
constexpr size_t WS_WXKV_OLD = WS_BIG;
constexpr size_t WS_MEMN_OLD = WS_BIG + 16 * MiB;
constexpr size_t WS_XB = WS_BIG + 256 * MiB;
constexpr size_t WS_WXKV2 = WS_XB + 64 * MiB;
constexpr size_t WS_MEMN2 = WS_WXKV2 + 16 * MiB;
constexpr size_t WS_R = WS_MEMN2 + 4 * MiB;
constexpr size_t WS_END = WS_R + 1 * MiB;
static_assert(WS_HID + (size_t)S_ * DFF * 2 <= WS_P, "HID overlays MG | U | A only");

constexpr int CW_BAR = 4096;

using pg8::Unit; using pg8::HALF; using pg8::BM;
typedef pg8::f32x4 acc_t[2][2][4][2];

struct EpiBf16 {
    static constexpr bool PERM = true;
    gbf* O; int ldc; int selcol; float scale; const gfl* R = nullptr;
    __device__ __forceinline__ void operator()(const acc_t& acc, const Unit& u, int wr, int wc, int fr, int fq) const {
        const int row0 = u.pm * BM + wr * 64 + fr; const int col0 = u.sel * selcol + u.pn * BM + wc * 32 + 8 * fq;
#pragma unroll
        for (int ai = 0; ai < 2; ++ai)
#pragma unroll
            for (int m = 0; m < 4; ++m) { gbf* rowp = O + (size_t)(row0 + ai * HALF + m * 16) * ldc + col0; const float sc_ = R ? scale * R[row0 + ai * HALF + m * 16] : scale;
#pragma unroll
                for (int bj = 0; bj < 2; ++bj) { const f32x4 v0 = acc[ai][bj][m][0] * sc_, v1 = acc[ai][bj][m][1] * sc_;
                    u32x4 w; w.x = pk2(v0[0], v0[1]); w.y = pk2(v0[2], v0[3]); w.z = pk2(v1[0], v1[1]); w.w = pk2(v1[2], v1[3]);
                    *(GAS u32x4*)(rowp + bj * HALF) = w; } }
    }
};
struct EpiF32 {
    static constexpr bool PERM = false;
    gfl* O; int ldc; size_t selstride;
    __device__ __forceinline__ void operator()(const acc_t& acc, const Unit& u, int wr, int wc, int fr, int fq) const {
        const int row0 = u.pm * BM + wr * 64 + fr; const int col0 = u.pn * BM + wc * 32 + 4 * fq; gfl* base = O + (size_t)u.sel * selstride;
#pragma unroll
        for (int ai = 0; ai < 2; ++ai)
#pragma unroll
            for (int m = 0; m < 4; ++m) { gfl* rowp = base + (size_t)(row0 + ai * HALF + m * 16) * ldc + col0;
#pragma unroll
                for (int bj = 0; bj < 2; ++bj)
#pragma unroll
                    for (int n = 0; n < 2; ++n) *(GAS f32x4*)(rowp + bj * HALF + n * 16) = acc[ai][bj][m][n]; }
    }
};
struct EpiZ {
    static constexpr bool PERM = true;
    gby* ws;
    __device__ __forceinline__ void operator()(const acc_t& acc, const Unit& u, int wr, int wc, int fr, int fq) const {
        const int row0 = u.pm * BM + wr * 64 + fr; const int pn = u.pn;
        float rr[2][4];
#pragma unroll
        for (int ai = 0; ai < 2; ++ai)
#pragma unroll
            for (int m = 0; m < 4; ++m) rr[ai][m] = ((const gfl*)(ws + WS_R))[row0 + ai * HALF + m * 16];
        gbf* const Q = (gbf*)(ws + WS_Q); gbf* const U = (gbf*)(ws + WS_U); gbf* const MG = (gbf*)(ws + WS_MG); gfl* const GL = (gfl*)(ws + WS_GL);
        if (pn < 4 || (pn >= 10 && pn < 14)) {
            const bool isq = pn < 4; gbf* base = isq ? Q : U; const float sc = isq ? QSCALE : 1.f; const int col0 = (isq ? pn : pn - 10) * BM + wc * 32 + 8 * fq;
#pragma unroll
            for (int ai = 0; ai < 2; ++ai)
#pragma unroll
                for (int m = 0; m < 4; ++m) { gbf* rowp = base + (size_t)(row0 + ai * HALF + m * 16) * 1024 + col0;
#pragma unroll
                    for (int bj = 0; bj < 2; ++bj) { const f32x4 v0 = acc[ai][bj][m][0] * (sc * rr[ai][m]), v1 = acc[ai][bj][m][1] * (sc * rr[ai][m]);
                        u32x4 w; w.x = pk2(v0[0], v0[1]); w.y = pk2(v0[2], v0[3]); w.z = pk2(v1[0], v1[1]); w.w = pk2(v1[2], v1[3]);
                        *(GAS u32x4*)(rowp + bj * HALF) = w; } }
        } else if (pn == 4 || pn == 5 || pn == 6 || pn == 8) {
            gbf* base = (gbf*)(ws + (pn == 4 ? WS_KCR : pn == 5 ? WS_VCR : pn == 6 ? WS_KSEL : WS_KWIN));
            const int d0 = 32 * (wc & 1) + 8 * fq;
#pragma unroll
            for (int ai = 0; ai < 2; ++ai)
#pragma unroll
                for (int m = 0; m < 4; ++m) { const int row = row0 + ai * HALF + m * 16;
#pragma unroll
                    for (int bj = 0; bj < 2; ++bj) { const int g = 2 * bj + (wc >> 1); const f32x4 v0 = acc[ai][bj][m][0] * rr[ai][m], v1 = acc[ai][bj][m][1] * rr[ai][m];
                        u32x4 w; w.x = pk2(v0[0], v0[1]); w.y = pk2(v0[2], v0[3]); w.z = pk2(v1[0], v1[1]); w.w = pk2(v1[2], v1[3]);
                        *(GAS u32x4*)(base + ((size_t)g * S_ + row) * 64 + d0) = w; } }
        } else if (pn == 7 || pn == 9) {
            gbf* base = (gbf*)(ws + (pn == 7 ? WS_VSELT : WS_VWINT));
            const int d0 = 32 * (wc & 1) + 8 * fq;
#pragma unroll
            for (int ai = 0; ai < 2; ++ai)
#pragma unroll
                for (int m = 0; m < 4; ++m) { const int row = row0 + ai * HALF + m * 16;
#pragma unroll
                    for (int bj = 0; bj < 2; ++bj) { const int g = 2 * bj + (wc >> 1); gbf* p = base + ((size_t)g * 64 + d0) * S_ + row;
#pragma unroll
                        for (int n = 0; n < 2; ++n)
#pragma unroll
                            for (int e = 0; e < 4; ++e) p[(size_t)(4 * n + e) * S_] = (bf16)f2bf(acc[ai][bj][m][n][e] * rr[ai][m]); } }
        } else if (pn < 30) {
            const int col0 = (pn - 14) * BM + wc * 32 + 8 * fq;
#pragma unroll
            for (int ai = 0; ai < 2; ++ai)
#pragma unroll
                for (int m = 0; m < 4; ++m) { gbf* rowp = MG + (size_t)(row0 + ai * HALF + m * 16) * 4096 + col0;
#pragma unroll
                    for (int bj = 0; bj < 2; ++bj) { const f32x4 a0 = acc[ai][bj][m][0] * rr[ai][m], a1 = acc[ai][bj][m][1] * rr[ai][m];
                        u32x4 w; w.x = pk2(sigmoidf_(a0[0]), sigmoidf_(a0[1])); w.y = pk2(sigmoidf_(a0[2]), sigmoidf_(a0[3])); w.z = pk2(sigmoidf_(a1[0]), sigmoidf_(a1[1])); w.w = pk2(sigmoidf_(a1[2]), sigmoidf_(a1[3]));
                        *(GAS u32x4*)(rowp + bj * HALF) = w; } }
        } else {
            const int col0 = wc * 32 + 8 * fq;
            if (col0 < 48) {
#pragma unroll
                for (int ai = 0; ai < 2; ++ai)
#pragma unroll
                    for (int m = 0; m < 4; ++m) { gfl* rowp = GL + (size_t)(row0 + ai * HALF + m * 16) * 48 + col0;
                        const f32x4 a0 = acc[ai][0][m][0] * rr[ai][m], a1 = acc[ai][0][m][1] * rr[ai][m];
                        *(GAS f32x4*)rowp = (f32x4){sigmoidf_(a0[0]), sigmoidf_(a0[1]), sigmoidf_(a0[2]), sigmoidf_(a0[3])};
                        *(GAS f32x4*)(rowp + 4) = (f32x4){sigmoidf_(a1[0]), sigmoidf_(a1[1]), sigmoidf_(a1[2]), sigmoidf_(a1[3])}; }
            }
        }
    }
};
struct EpiMerge {
    static constexpr bool PERM = true;
    gbf* Y1; const gbf* MG;
    __device__ __forceinline__ void operator()(const acc_t& acc, const Unit& u, int wr, int wc, int fr, int fq) const {
        const int row0 = u.pm * BM + wr * 64 + fr; const int col0 = u.pn * BM + wc * 32 + 8 * fq;
#pragma unroll
        for (int ai = 0; ai < 2; ++ai)
#pragma unroll
            for (int m = 0; m < 4; ++m) { const int row = row0 + ai * HALF + m * 16; gbf* yp = Y1 + (size_t)row * DM + col0; const gbf* gp = MG + (size_t)row * 4096 + u.sel * 2048 + col0;
#pragma unroll
                for (int bj = 0; bj < 2; ++bj) { const u32x4 gw = *(const GAS u32x4*)(gp + bj * HALF); const f32x4 a0 = acc[ai][bj][m][0], a1 = acc[ai][bj][m][1];
                    float v[8] = {a0[0] * bflo(gw.x), a0[1] * bfhi(gw.x), a0[2] * bflo(gw.y), a0[3] * bfhi(gw.y), a1[0] * bflo(gw.z), a1[1] * bfhi(gw.z), a1[2] * bflo(gw.w), a1[3] * bfhi(gw.w)};
                    if (u.sel) { const u32x4 yw = *(const GAS u32x4*)(yp + bj * HALF);
                        v[0] += bflo(yw.x); v[1] += bfhi(yw.x); v[2] += bflo(yw.y); v[3] += bfhi(yw.y); v[4] += bflo(yw.z); v[5] += bfhi(yw.z); v[6] += bflo(yw.w); v[7] += bfhi(yw.w); }
                    u32x4 w; w.x = pk2(v[0], v[1]); w.y = pk2(v[2], v[3]); w.z = pk2(v[4], v[5]); w.w = pk2(v[6], v[7]);
                    *(GAS u32x4*)(yp + bj * HALF) = w; } }
    }
};
struct EpiSwiGLU {
    static constexpr bool PERM = true;
    gbf* Hd; const gfl* R;
    __device__ __forceinline__ void operator()(const acc_t& acc, const Unit& u, int wr, int wc, int fr, int fq) const {
        const int row0 = u.pm * BM + wr * 64 + fr; const int col0 = u.pn * 128 + wc * 32 + 8 * fq;
#pragma unroll
        for (int ai = 0; ai < 2; ++ai)
#pragma unroll
            for (int m = 0; m < 4; ++m) { gbf* rowp = Hd + (size_t)(row0 + ai * HALF + m * 16) * DFF + col0; float v[8]; const float rr = R[row0 + ai * HALF + m * 16];
#pragma unroll
                for (int n = 0; n < 2; ++n)
#pragma unroll
                    for (int e = 0; e < 4; ++e) { const float gx = acc[ai][0][m][n][e] * rr, ux = acc[ai][1][m][n][e] * rr; v[4 * n + e] = gx * sigmoidf_(gx) * ux; }
                u32x4 w; w.x = pk2(v[0], v[1]); w.y = pk2(v[2], v[3]); w.z = pk2(v[4], v[5]); w.w = pk2(v[6], v[7]);
                *(GAS u32x4*)rowp = w; }
    }
};
struct EpiKVmem {
    static constexpr bool PERM = true;
    gbf *KM, *VMT;
    __device__ __forceinline__ void operator()(const acc_t& acc, const Unit& u, int wr, int wc, int fr, int fq) const {
        const int row0 = wr * 64 + fr; const int l = u.sel;
        if (u.pn < 2) {
            const int col0 = u.pn * BM + wc * 32 + 8 * fq;
#pragma unroll
            for (int ai = 0; ai < 2; ++ai)
#pragma unroll
                for (int m = 0; m < 4; ++m) { gbf* rowp = KM + ((size_t)l * NMEM + row0 + ai * HALF + m * 16) * XW + col0;
#pragma unroll
                    for (int bj = 0; bj < 2; ++bj) { const f32x4 v0 = acc[ai][bj][m][0] * XSCALE, v1 = acc[ai][bj][m][1] * XSCALE;
                        u32x4 w; w.x = pk2(v0[0], v0[1]); w.y = pk2(v0[2], v0[3]); w.z = pk2(v1[0], v1[1]); w.w = pk2(v1[2], v1[3]);
                        *(GAS u32x4*)(rowp + bj * HALF) = w; } }
        } else {
            const int col0 = (u.pn - 2) * BM + wc * 32 + 8 * fq;
#pragma unroll
            for (int ai = 0; ai < 2; ++ai)
#pragma unroll
                for (int m = 0; m < 4; ++m) { const int row = row0 + ai * HALF + m * 16;
#pragma unroll
                    for (int bj = 0; bj < 2; ++bj) { gbf* p = VMT + ((size_t)l * XW + col0 + bj * HALF) * NMEM + row;
#pragma unroll
                        for (int n = 0; n < 2; ++n)
#pragma unroll
                            for (int e = 0; e < 4; ++e) p[(size_t)(4 * n + e) * NMEM] = (bf16)f2bf(acc[ai][bj][m][n][e]); } }
        }
    }
};
constexpr int RING_BYTES = 131072;
constexpr int LDSCTL_OFF = RING_BYTES, MISC_OFF = LDSCTL_OFF + 320;
constexpr int LDS_BYTES = 147456;
constexpr int NWAVES = 8;

typedef GAS unsigned gu32;
#define RLX_AGENT __ATOMIC_RELAXED, __HIP_MEMORY_SCOPE_AGENT
#define LDS_WAIT() asm volatile("s_waitcnt lgkmcnt(0)" ::: "memory")
#define VM_WAIT() asm volatile("s_waitcnt vmcnt(0)" ::: "memory")

#define XB_TMO      128
#define XB_XCNT(j)  (256  + 64 * (j))
#define XB_XSUB(j)  (1280 + 64 * (j))
#define XB_XGEN(j)  (2304 + 64 * (j))
#define XB_TOP      3328
#define XB_TOPGEN   3392
#define XCD_BAR_WORDS 3456
#define XB_SPIN_CAP (1u << 22)

__device__ __forceinline__ unsigned xb_ld(GAS unsigned* p)              { return __hip_atomic_load(p, __ATOMIC_RELAXED, __HIP_MEMORY_SCOPE_AGENT); }
__device__ __forceinline__ unsigned xb_add(GAS unsigned* p, unsigned v) { return __hip_atomic_fetch_add(p, v, __ATOMIC_RELAXED, __HIP_MEMORY_SCOPE_AGENT); }
__device__ __forceinline__ unsigned xb_xcc_id() { return (unsigned)__builtin_amdgcn_s_getreg((3 << 11) | 20) & 0xFu; }
#define XB_SPIN(cond, bar) do { unsigned _sp = 0; while (cond) { __builtin_amdgcn_s_sleep(1); \
    if ((++_sp & 255u) == 0u) { if (xb_ld(&(bar)[XB_TMO])) break; if (_sp > XB_SPIN_CAP) { (void)xb_add(&(bar)[XB_TMO], 1u); break; } } } } while (0)

struct XcdBarrier { GAS unsigned* bar; unsigned x; volatile LAS unsigned* st; };

__device__ __forceinline__ XcdBarrier xcd_barrier_post(GAS unsigned* bar, volatile LAS unsigned* st) {
    XcdBarrier b; b.bar = bar; b.x = xb_xcc_id(); b.st = st;
    if (threadIdx.x == 0) (void)xb_add(&bar[XB_XCNT(b.x)], 1u);
    return b;
}
__device__ __forceinline__ void xcd_barrier_complete(GAS unsigned* bar, unsigned x, unsigned& nloc, unsigned& nx) {
    const unsigned G = gridDim.x * gridDim.y * gridDim.z;
    unsigned sum, cnt, mine, sp = 0u;
    for (;;) {
        sum = 0u; cnt = 0u; mine = 0u;
#pragma unroll 1
        for (unsigned j = 0; j < 16; ++j) { const unsigned c = xb_ld(&bar[XB_XCNT(j)]); sum += c; cnt += (c > 0u) ? 1u : 0u; mine = (j == x) ? c : mine; }
        if (sum == G) break;
        __builtin_amdgcn_s_sleep(1);
        if ((++sp & 255u) == 0u) { if (xb_ld(&bar[XB_TMO])) break; if (sp > XB_SPIN_CAP) { (void)xb_add(&bar[XB_TMO], 1u); break; } }
    }
    nloc = mine > 0u ? mine : 1u; nx = cnt > 0u ? cnt : 1u;
}
__device__ __forceinline__ void xcd_barrier(const XcdBarrier& b, bool leader) {
    asm volatile("s_waitcnt vmcnt(0)" ::: "memory");
    __syncthreads();
    if (leader) {
        GAS unsigned* bar = b.bar; unsigned bx = b.x;
        asm volatile("" : "+s"(bar), "+s"(bx));
        __builtin_amdgcn_s_waitcnt(0);
        unsigned nloc = b.st[0], nx = b.st[1];
        if (nloc == 0u) { xcd_barrier_complete(bar, bx, nloc, nx); b.st[0] = nloc; b.st[1] = nx; }
        const unsigned old = xb_add(&bar[XB_XSUB(bx)], 1u);
        const unsigned gen = old / nloc;
        if (old + 1u == (gen + 1u) * nloc) {
            __builtin_amdgcn_fence(__ATOMIC_RELEASE, "agent");
            asm volatile("s_waitcnt vmcnt(0)" ::: "memory");
            const unsigned og = xb_add(&bar[XB_TOP], 1u);
            const unsigned tg = og / nx;
            if (og + 1u == (tg + 1u) * nx) xb_add(&bar[XB_TOPGEN], 1u);
            else XB_SPIN(xb_ld(&bar[XB_TOPGEN]) == tg, bar);
            __builtin_amdgcn_fence(__ATOMIC_ACQUIRE, "agent");
            xb_add(&bar[XB_XGEN(bx)], 1u);
            asm volatile("s_waitcnt vmcnt(0)" ::: "memory");
        } else {
            XB_SPIN(xb_ld(&bar[XB_XGEN(bx)]) == gen, bar);
            __builtin_amdgcn_fence(__ATOMIC_ACQUIRE, "agent");
            asm volatile("s_waitcnt vmcnt(0)" ::: "memory");
        }
    }
    __syncthreads();
}

struct Frame {
    LAS unsigned char* lds;
    int tid, lane, wave, vcu, G, gw, NGW;
    gby* ws;
};

__device__ __forceinline__ float wave_sum(float v) {
#pragma unroll
    for (int o = 1; o < 64; o <<= 1) v += __shfl_xor(v, o);
    return v;
}

__device__ __forceinline__ int tr_map(int code, int moff, int n) {
    if (code == 0) return n + moff;
    if (code == 1) return n < 2560 ? n : (n < 2608 ? 7680 + (n - 2560) : (n < 3632 ? 2560 + (n - 2608) : 3584 + (n - 3632)));
    return (n >> 7) * 256 + moff + (n & 127);
}
struct TrDesc { const gfl* W; gbf* WT; const gfl* cs; int K, N, ldk, code, moff, start; };
__device__ __forceinline__ void tr_load(float (&wv)[32], float& cs, const gfl* W, int N, int item, int lane, const gfl* colscale) {
    const int nblk = (N + 31) / 32, kb = item / nblk, nb = item % nblk, k0 = 64 * kb, n0 = 32 * nb;
    int nl = n0 + (lane & 31); nl = nl < N ? nl : N - 1;
    cs = colscale ? colscale[nl] : 1.f;
    const gfl* wp = W + (size_t)(k0 + (lane >> 5)) * N + nl;
#pragma unroll
    for (int i = 0; i < 32; ++i) wv[i] = wp[(size_t)(2 * i) * N];
}
__device__ __forceinline__ void tr_store(const float (&wv)[32], float cs, int N, gbf* WT, int ldk, LAS float* scr, int item, int lane, int code, int moff, const gfl* rowscale) {
    const int nblk = (N + 31) / 32, kb = item / nblk, nb = item % nblk, k0 = 64 * kb, n0 = 32 * nb;
#pragma unroll
    for (int i = 0; i < 32; ++i) { const int kk = 2 * i + (lane >> 5); scr[kk * 33 + (lane & 31)] = wv[i] * cs; }
    LDS_WAIT(); asm volatile("" ::: "memory");
    const int c = lane & 7;
    f32x4 r0 = {1.f, 1.f, 1.f, 1.f}, r1 = r0;
    if (rowscale) { r0 = *(const GAS f32x4*)(rowscale + k0 + 8 * c); r1 = *(const GAS f32x4*)(rowscale + k0 + 8 * c + 4); }
#pragma unroll
    for (int j = 0; j < 4; ++j) { const int n = (lane >> 3) + 8 * j; const LAS float* s = scr + (8 * c) * 33 + n;
        u32x4 o; o.x = pk2(s[0 * 33] * r0.x, s[1 * 33] * r0.y); o.y = pk2(s[2 * 33] * r0.z, s[3 * 33] * r0.w); o.z = pk2(s[4 * 33] * r1.x, s[5 * 33] * r1.y); o.w = pk2(s[6 * 33] * r1.z, s[7 * 33] * r1.w);
        if (n0 + n < N) *(GAS u32x4*)(WT + (size_t)tr_map(code, moff, n0 + n) * ldk + k0 + 8 * c) = o; }
    LDS_WAIT(); asm volatile("" ::: "memory");
}

__device__ __forceinline__ void rms_row_to_bf16(const gfl* xrow, const gfl* gain, gbf* orow, int lane) {
    f32x4 v[4][2]; float ss = 0.f;
#pragma unroll
    for (int j = 0; j < 4; ++j) { const int c = lane + 64 * j; v[j][0] = *(const GAS f32x4*)(xrow + 8 * c); v[j][1] = *(const GAS f32x4*)(xrow + 8 * c + 4);
        ss += (v[j][0].x * v[j][0].x + v[j][0].y * v[j][0].y) + (v[j][0].z * v[j][0].z + v[j][0].w * v[j][0].w) + (v[j][1].x * v[j][1].x + v[j][1].y * v[j][1].y) + (v[j][1].z * v[j][1].z + v[j][1].w * v[j][1].w); }
    const float r = 1.0f / sqrtf(wave_sum(ss) * (1.f / DM) + RMS_EPS);
#pragma unroll
    for (int j = 0; j < 4; ++j) { const int c = lane + 64 * j; const f32x4 g0 = *(const GAS f32x4*)(gain + 8 * c), g1 = *(const GAS f32x4*)(gain + 8 * c + 4);
        const f32x4 a = v[j][0] * r * g0, b = v[j][1] * r * g1;
        u32x4 w; w.x = pk2(a.x, a.y); w.y = pk2(a.z, a.w); w.z = pk2(b.x, b.y); w.w = pk2(b.z, b.w);
        *(GAS u32x4*)(orow + 8 * c) = w; }
}
__device__ __forceinline__ void rms_row_r(const gfl* xrow, gfl* rout, int lane) {
    float ss = 0.f;
#pragma unroll
    for (int j = 0; j < 4; ++j) { const int c = lane + 64 * j; const f32x4 a = *(const GAS f32x4*)(xrow + 8 * c), b = *(const GAS f32x4*)(xrow + 8 * c + 4);
        ss += (a.x * a.x + a.y * a.y) + (a.z * a.z + a.w * a.w) + (b.x * b.x + b.y * b.y) + (b.z * b.z + b.w * b.w); }
    const float r = 1.0f / sqrtf(wave_sum(ss) * (1.f / DM) + RMS_EPS);
    if (lane == 0) *rout = r;
}
__device__ __forceinline__ void resid_row(const gbf* xin, gbf* xb_out, gfl* xf_out, const gbf* yrow, const gfl* gpost, gfl* rout, int lane) {
    f32x4 y[4][2]; float ss = 0.f;
#pragma unroll
    for (int j = 0; j < 4; ++j) { const int c = lane + 64 * j; const u32x4 w = *(const GAS u32x4*)(yrow + 8 * c);
        y[j][0] = (f32x4){bflo(w.x), bfhi(w.x), bflo(w.y), bfhi(w.y)}; y[j][1] = (f32x4){bflo(w.z), bfhi(w.z), bflo(w.w), bfhi(w.w)};
        ss += (y[j][0].x * y[j][0].x + y[j][0].y * y[j][0].y) + (y[j][0].z * y[j][0].z + y[j][0].w * y[j][0].w) + (y[j][1].x * y[j][1].x + y[j][1].y * y[j][1].y) + (y[j][1].z * y[j][1].z + y[j][1].w * y[j][1].w); }
    u32x4 xw[4];
#pragma unroll
    for (int j = 0; j < 4; ++j) xw[j] = *(const GAS u32x4*)(xin + 8 * (lane + 64 * j));
    const float r = 1.0f / sqrtf(wave_sum(ss) * (1.f / DM) + RMS_EPS);
    float s2 = 0.f;
#pragma unroll
    for (int j = 0; j < 4; ++j) { const int c = lane + 64 * j; const f32x4 g0 = *(const GAS f32x4*)(gpost + 8 * c), g1 = *(const GAS f32x4*)(gpost + 8 * c + 4);
        const f32x4 x0 = (f32x4){bflo(xw[j].x), bfhi(xw[j].x), bflo(xw[j].y), bfhi(xw[j].y)}, x1 = (f32x4){bflo(xw[j].z), bfhi(xw[j].z), bflo(xw[j].w), bfhi(xw[j].w)};
        y[j][0] = x0 + y[j][0] * r * g0; y[j][1] = x1 + y[j][1] * r * g1;
        if (xf_out) { *(GAS f32x4*)(xf_out + 8 * c) = y[j][0]; *(GAS f32x4*)(xf_out + 8 * c + 4) = y[j][1]; }
        else { u32x4 w; w.x = pk2(y[j][0].x, y[j][0].y); w.y = pk2(y[j][0].z, y[j][0].w); w.z = pk2(y[j][1].x, y[j][1].y); w.w = pk2(y[j][1].z, y[j][1].w); *(GAS u32x4*)(xb_out + 8 * c) = w; }
        s2 += (y[j][0].x * y[j][0].x + y[j][0].y * y[j][0].y) + (y[j][0].z * y[j][0].z + y[j][0].w * y[j][0].w) + (y[j][1].x * y[j][1].x + y[j][1].y * y[j][1].y) + (y[j][1].z * y[j][1].z + y[j][1].w * y[j][1].w); }
    if (rout) { const float r2 = 1.0f / sqrtf(wave_sum(s2) * (1.f / DM) + RMS_EPS); if (lane == 0) *rout = r2; }
}
__device__ __forceinline__ float gelu_tanh(float x) {
    const float z = 0.7978845608028654f * (x + 0.044715f * x * x * x);
    const float e = __builtin_amdgcn_exp2f(2.f * z * LOG2E);
    const float th = 1.f - 2.f * __builtin_amdgcn_rcpf(1.f + e);
    return 0.5f * x * (1.f + th);
}
constexpr float NEGBIG = -1e30f;
constexpr int ATT_BKT_OFF = 0;
constexpr int ATT_TAB_OFF = 2048;
constexpr int ATT_WAVE_OFF = 4096;
constexpr int ATT_IMP_STRIDE = 264;
constexpr int ATT_WAVE_BYTES = 2 * 4 * ATT_IMP_STRIDE * 4 + 128;
static_assert(ATT_WAVE_OFF + NWAVES * ATT_WAVE_BYTES <= RING_BYTES, "attention LDS");

__device__ __forceinline__ int t5_bucket(int n) {
    if (n < 16) return n;
    int b = 16;
    b += (n >= 22); b += (n >= 30); b += (n >= 40); b += (n >= 54); b += (n >= 73); b += (n >= 99); b += (n >= 134); b += (n >= 182);
    b += (n >= 246); b += (n >= 332); b += (n >= 450); b += (n >= 609); b += (n >= 825); b += (n >= 1117); b += (n >= 1513);
    return b;
}
struct AttSt { f32x4 o[4]; float m, l; };
__device__ __forceinline__ void att_reset(AttSt& st) {
#pragma unroll
    for (int i = 0; i < 4; ++i) st.o[i] = (f32x4){0.f, 0.f, 0.f, 0.f};
    st.m = NEGBIG; st.l = 0.f;
}
template <int MODE>
__device__ __forceinline__ void att_scores(float (&sv)[8], const bf16x8 (&qf)[2], const gbf* Kg, int kb, int t, int head, bool rowsel, int lane, const LAS unsigned char* bkt, const LAS float* tab) {
    const int i16 = lane & 15, gq = lane >> 4;
    f32x4 s[2];
#pragma unroll
    for (int tau = 0; tau < 2; ++tau) {
        const int ko = 8 * (i16 >> 2) + 4 * tau + (i16 & 3);
        const gbf* kp = Kg + (size_t)(kb + ko) * 64 + 8 * gq;
        const bf16x8 k0 = *(const GAS bf16x8*)kp, k1 = *(const GAS bf16x8*)(kp + 32);
        s[tau] = __builtin_amdgcn_mfma_f32_16x16x32_bf16(k0, qf[0], (f32x4){0.f, 0.f, 0.f, 0.f}, 0, 0, 0);
        s[tau] = __builtin_amdgcn_mfma_f32_16x16x32_bf16(k1, qf[1], s[tau], 0, 0, 0);
    }
#pragma unroll
    for (int tau = 0; tau < 2; ++tau)
#pragma unroll
        for (int r = 0; r < 4; ++r) {
            const int idx = kb + 8 * gq + 4 * tau + r;
            int dist; bool valid;
            if (MODE == 0) { dist = t - (16 * idx + 31); valid = dist >= 0; }
            else if (MODE == 1) { dist = t - idx; valid = rowsel && dist >= 0; }
            else { dist = t - idx; valid = (unsigned)dist < 512u; }
            const int dc = dist < 0 ? 0 : (dist > 2047 ? 2047 : dist);
            const float b = tab[head * 32 + bkt[dc]];
            sv[4 * tau + r] = valid ? s[tau][r] + b : NEGBIG;
        }
}
template <int MODE>
__device__ __forceinline__ void att_step(AttSt& st, const bf16x8 (&qf)[2], const gbf* Kg, const gbf* VTg, int vpitch, int kb, int t, int head, bool rowsel, int lane, const LAS unsigned char* bkt, const LAS float* tab) {
    const int i16 = lane & 15, gq = lane >> 4;
    float sv[8];
    att_scores<MODE>(sv, qf, Kg, kb, t, head, rowsel, lane, bkt, tab);
    float mx = fmaxf(fmaxf(fmaxf(sv[0], sv[1]), fmaxf(sv[2], sv[3])), fmaxf(fmaxf(sv[4], sv[5]), fmaxf(sv[6], sv[7])));
    mx = fmaxf(mx, __shfl_xor(mx, 16)); mx = fmaxf(mx, __shfl_xor(mx, 32));
    const float mn = fmaxf(st.m, mx);
    const float alpha = __builtin_amdgcn_exp2f(st.m - mn);
    st.m = mn;
    float p[8]; float ps = 0.f;
#pragma unroll
    for (int e = 0; e < 8; ++e) { p[e] = __builtin_amdgcn_exp2f(sv[e] - mn); ps += p[e]; }
    st.l = st.l * alpha + ps;
    u32x4 pw; pw.x = pk2(p[0], p[1]); pw.y = pk2(p[2], p[3]); pw.z = pk2(p[4], p[5]); pw.w = pk2(p[6], p[7]);
    const bf16x8 pb = __builtin_bit_cast(bf16x8, pw);
#pragma unroll
    for (int dt = 0; dt < 4; ++dt) {
        const bf16x8 vf = *(const GAS bf16x8*)(VTg + (size_t)(16 * dt + i16) * vpitch + kb + 8 * gq);
        st.o[dt] = st.o[dt] * alpha;
        st.o[dt] = __builtin_amdgcn_mfma_f32_16x16x32_bf16(vf, pb, st.o[dt], 0, 0, 0);
    }
}
__device__ __forceinline__ void att_finish(const AttSt& st, f32x4 (&acc)[4], float gate) {
    float l = st.l; l += __shfl_xor(l, 16); l += __shfl_xor(l, 32);
    const float sc = (st.m > -1e29f) ? gate / l : 0.f;
#pragma unroll
    for (int dt = 0; dt < 4; ++dt) acc[dt] += st.o[dt] * sc;
}
__device__ __forceinline__ unsigned wave_max_u32_dpp(unsigned v) {
    unsigned w;
    w = (unsigned)__builtin_amdgcn_update_dpp((int)v, (int)v, 0xB1, 0xF, 0xF, false); v = v > w ? v : w;
    w = (unsigned)__builtin_amdgcn_update_dpp((int)v, (int)v, 0x4E, 0xF, 0xF, false); v = v > w ? v : w;
    w = (unsigned)__builtin_amdgcn_update_dpp((int)v, (int)v, 0x141, 0xF, 0xF, false); v = v > w ? v : w;
    w = (unsigned)__builtin_amdgcn_update_dpp((int)v, (int)v, 0x140, 0xF, 0xF, false); v = v > w ? v : w;
    w = (unsigned)__builtin_amdgcn_update_dpp((int)v, (int)v, 0x142, 0xA, 0xF, false); v = v > w ? v : w;
    w = (unsigned)__builtin_amdgcn_update_dpp((int)v, (int)v, 0x143, 0xC, 0xF, false); v = v > w ? v : w;
    return (unsigned)__builtin_amdgcn_readlane((int)v, 63);
}
__device__ __forceinline__ unsigned wave_max_u32(unsigned v) {
#pragma unroll
    for (int o = 1; o < 64; o <<= 1) { const unsigned w = (unsigned)__shfl_xor((int)v, o); v = v > w ? v : w; }
    return v;
}

struct AttnPtrs { const gbf *Q, *KC, *VCT, *KSEL, *VSELT, *KWIN, *VWINT; const gfl* GL; gbf* A; };

__device__ __forceinline__ void attn_setup_tables(Frame& F, const gfl* rel_bias) {
    LAS unsigned char* bkt = F.lds + ATT_BKT_OFF; LAS float* tab = (LAS float*)(F.lds + ATT_TAB_OFF);
    for (int i = F.tid; i < 2048; i += NWAVES * 64) bkt[i] = (unsigned char)t5_bucket(i);
    for (int i = F.tid; i < 512; i += NWAVES * 64) tab[i] = rel_bias[i] * LOG2E;
    LDS_WAIT(); __syncthreads();
}

__device__ __forceinline__ void nsa_unit_v1(Frame& F, const AttnPtrs& P, int qt, int g) {
    const int lane = F.lane, i16 = lane & 15, gq = lane >> 4, ql = i16 >> 2, hl = i16 & 3;
    const LAS unsigned char* bkt = F.lds + ATT_BKT_OFF; const LAS float* tab = (const LAS float*)(F.lds + ATT_TAB_OFF);
    LAS float* impA = (LAS float*)(F.lds + ATT_WAVE_OFF + F.wave * ATT_WAVE_BYTES); LAS float* impB = impA + 4 * ATT_IMP_STRIDE;
    LAS unsigned* selm = (LAS unsigned*)(impB + 4 * ATT_IMP_STRIDE);
    const int t0 = 4 * qt, t = t0 + ql, head = 4 * g + hl;
    bf16x8 qf[2];
    { const gbf* qp = P.Q + (size_t)t * NSAW + head * 64 + 8 * gq; qf[0] = *(const GAS bf16x8*)qp; qf[1] = *(const GAS bf16x8*)(qp + 32); }
#ifndef MK_BR
#define MK_BR 7
#endif
    const float g_c = (MK_BR & 1) ? P.GL[(size_t)t * 48 + head * 3 + 0] : 0.f, g_s = (MK_BR & 2) ? P.GL[(size_t)t * 48 + head * 3 + 1] : 0.f, g_w = (MK_BR & 4) ? P.GL[(size_t)t * 48 + head * 3 + 2] : 0.f;
    f32x4 acc[4];
#pragma unroll
    for (int i = 0; i < 4; ++i) acc[i] = (f32x4){0.f, 0.f, 0.f, 0.f};
    AttSt st;
    const gbf* KCg = P.KC + (size_t)g * 1024 * 64; const gbf* VCTg = P.VCT + (size_t)g * 64 * 1024;
    const int nlast = (t0 + 3 >= 31) ? (t0 + 3 - 31) / 16 : -1;
    att_reset(st);
    for (int kb = 0; kb <= nlast; kb += 32) att_step<0>(st, qf, KCg, VCTg, 1024, kb, t, head, true, lane, bkt, tab);
    att_finish(st, acc, g_c);
    const int cur_max = (t0 + 3) >> 6;
    if (cur_max >= 16) {
        float lt = st.l; lt += __shfl_xor(lt, 16); lt += __shfl_xor(lt, 32);
        const float inv_l = (st.m > -1e29f) ? 1.f / lt : 0.f; const float mfin = st.m;
        for (int kb = 0; kb <= nlast; kb += 32) {
            float sv[8];
            att_scores<0>(sv, qf, KCg, kb, t, head, true, lane, bkt, tab);
            float ps[8];
#pragma unroll
            for (int e = 0; e < 8; ++e) { float p = (sv[e] > -1e29f) ? __builtin_amdgcn_exp2f(sv[e] - mfin) * inv_l : 0.f; p += __shfl_xor(p, 1); p += __shfl_xor(p, 2); ps[e] = p; }
            const float a0 = ps[0] + ps[1] + ps[2] + 0.5f * ps[3], c0 = 0.5f * ps[3];
            const float a1 = ps[4] + ps[5] + ps[6] + 0.5f * ps[7] + c0, c1 = 0.5f * ps[7];
            const int j0 = (kb + 8 * gq) >> 2;
            if (hl == 0) { impA[ql * ATT_IMP_STRIDE + j0] = a0; impA[ql * ATT_IMP_STRIDE + j0 + 1] = a1; impB[ql * ATT_IMP_STRIDE + j0 + 2] = c1; }
        }
    }
    LDS_WAIT();
#pragma unroll 1
    for (int q = 0; q < 4; ++q) {
        const int tq = t0 + q, cur = tq >> 6;
        unsigned mword = 0u;
        if (cur <= 15) { if (lane == 0) mword = (2u << cur) - 1u; }
        else {
            unsigned key[4];
#pragma unroll
            for (int e = 0; e < 4; ++e) { const int j = 4 * lane + e; float v = impA[q * ATT_IMP_STRIDE + j]; if ((j & 1) == 0 && j > 0) v += impB[q * ATT_IMP_STRIDE + j];
#ifdef MK_CMP_ATT
                ((GAS float*)(F.ws + WS_END + 16 * MiB))[((size_t)(t0 + q) * 4 + g) * 256 + j] = v;
#endif
                const bool cand = (j >= 1) && (j <= cur - 2);
                key[e] = cand ? ((__builtin_bit_cast(unsigned, v) & 0xffffff00u) | (unsigned)(255 - j)) : 0u; }
#pragma unroll 1
            for (int round = 0; round < 13; ++round) {
                unsigned best = key[0] > key[1] ? key[0] : key[1]; const unsigned b2 = key[2] > key[3] ? key[2] : key[3]; best = best > b2 ? best : b2;
                const unsigned wk = (unsigned)__builtin_amdgcn_readfirstlane((int)wave_max_u32(best));
                const int js = 255 - (int)(wk & 255u);
                if (lane == (js >> 2)) {
#pragma unroll
                    for (int e = 0; e < 4; ++e) if ((js & 3) == e) key[e] = 0u;
                }
                if (lane == (js >> 5)) mword |= 1u << (js & 31);
            }
            if (lane == 0) mword |= 1u;
            if (lane == (cur >> 5)) mword |= 1u << (cur & 31);
            if (lane == ((cur - 1) >> 5)) mword |= 1u << ((cur - 1) & 31);
        }
        if (lane < 8) selm[q * 8 + lane] = mword;
#ifdef MK_CMP_ATT
        if (lane < 8) ((GAS unsigned*)(F.ws + WS_END + 400 * MiB))[((size_t)(t0 + q) * 4 + g) * 8 + lane] = mword;
#endif
    }
    LDS_WAIT();
    const gbf* KSg = P.KSEL + (size_t)g * S_ * 64; const gbf* VSTg = P.VSELT + (size_t)g * 64 * S_;
    att_reset(st);
#pragma unroll 1
    for (int w = 0; w < 8; ++w) {
        unsigned U = selm[w] | selm[8 + w] | selm[16 + w] | selm[24 + w];
        U = (unsigned)__builtin_amdgcn_readfirstlane((int)U);
        const unsigned myw = selm[ql * 8 + w];
        while (U) {
            const int b = __builtin_ctz(U); U &= U - 1u;
            const int blk = 32 * w + b; const bool rs = (myw >> b) & 1u;
            att_step<1>(st, qf, KSg, VSTg, S_, blk * 64, t, head, rs, lane, bkt, tab);
            att_step<1>(st, qf, KSg, VSTg, S_, blk * 64 + 32, t, head, rs, lane, bkt, tab);
        }
    }
    att_finish(st, acc, g_s);
    const gbf* KWg = P.KWIN + (size_t)g * S_ * 64; const gbf* VWTg = P.VWINT + (size_t)g * 64 * S_;
    att_reset(st);
    { int kb0 = t0 - 511; kb0 = kb0 < 0 ? 0 : (kb0 & ~31);
      for (int kb = kb0; kb <= t0 + 3; kb += 32) att_step<2>(st, qf, KWg, VWTg, S_, kb, t, head, true, lane, bkt, tab); }
    att_finish(st, acc, g_w);
    gbf* ap = P.A + (size_t)t * NSAW + head * 64 + 4 * gq;
#pragma unroll
    for (int dt = 0; dt < 4; ++dt) { u32x2 w; w.x = pk2(acc[dt][0], acc[dt][1]); w.y = pk2(acc[dt][2], acc[dt][3]); *(GAS u32x2*)(ap + 16 * dt) = w; }
}

__device__ __forceinline__ void xattn_unit_v1(Frame& F, const gbf* Q2, const gbf* KM, const gbf* VMT, gbf* O2, int qt, int h) {
    const int lane = F.lane, i16 = lane & 15, gq = lane >> 4;
    const int t = 16 * qt + i16;
    bf16x8 qf[4];
#pragma unroll
    for (int s = 0; s < 4; ++s) qf[s] = *(const GAS bf16x8*)(Q2 + (size_t)t * XW + h * XHD + 32 * s + 8 * gq);
    f32x4 o[8];
#pragma unroll
    for (int i = 0; i < 8; ++i) o[i] = (f32x4){0.f, 0.f, 0.f, 0.f};
    float m = NEGBIG, l = 0.f;
#pragma unroll 1
    for (int kb = 0; kb < NMEM; kb += 32) {
        f32x4 s[2];
#pragma unroll
        for (int tau = 0; tau < 2; ++tau) {
            const int ko = 8 * (i16 >> 2) + 4 * tau + (i16 & 3);
            const gbf* kp = KM + (size_t)(kb + ko) * XW + h * XHD + 8 * gq;
            s[tau] = (f32x4){0.f, 0.f, 0.f, 0.f};
#pragma unroll
            for (int ks = 0; ks < 4; ++ks) s[tau] = __builtin_amdgcn_mfma_f32_16x16x32_bf16(*(const GAS bf16x8*)(kp + 32 * ks), qf[ks], s[tau], 0, 0, 0);
        }
        float mx = fmaxf(fmaxf(fmaxf(s[0][0], s[0][1]), fmaxf(s[0][2], s[0][3])), fmaxf(fmaxf(s[1][0], s[1][1]), fmaxf(s[1][2], s[1][3])));
        mx = fmaxf(mx, __shfl_xor(mx, 16)); mx = fmaxf(mx, __shfl_xor(mx, 32));
        const float mn = fmaxf(m, mx); const float alpha = __builtin_amdgcn_exp2f(m - mn); m = mn;
        float p[8]; float ps = 0.f;
#pragma unroll
        for (int e = 0; e < 8; ++e) { p[e] = __builtin_amdgcn_exp2f(s[e >> 2][e & 3] - mn); ps += p[e]; }
        l = l * alpha + ps;
        u32x4 pw; pw.x = pk2(p[0], p[1]); pw.y = pk2(p[2], p[3]); pw.z = pk2(p[4], p[5]); pw.w = pk2(p[6], p[7]);
        const bf16x8 pb = __builtin_bit_cast(bf16x8, pw);
#pragma unroll
        for (int dt = 0; dt < 8; ++dt) {
            const bf16x8 vf = *(const GAS bf16x8*)(VMT + (size_t)(h * XHD + 16 * dt + i16) * NMEM + kb + 8 * gq);
            o[dt] = o[dt] * alpha;
            o[dt] = __builtin_amdgcn_mfma_f32_16x16x32_bf16(vf, pb, o[dt], 0, 0, 0);
        }
    }
    l += __shfl_xor(l, 16); l += __shfl_xor(l, 32);
    const float inv = 1.f / l;
    gbf* op = O2 + (size_t)t * XW + h * XHD + 4 * gq;
#pragma unroll
    for (int dt = 0; dt < 8; ++dt) { u32x2 w; w.x = pk2(o[dt][0] * inv, o[dt][1] * inv); w.y = pk2(o[dt][2] * inv, o[dt][3] * inv); *(GAS u32x2*)(op + 16 * dt) = w; }
}

__device__ __forceinline__ void xattn_unit_v2(Frame& F, const gbf* Q2, const gbf* KM, const gbf* VMT, gbf* O2, int q256, int h) {
    const int lane = F.lane, wave = F.wave, i16 = lane & 15, gq = lane >> 4;
    LAS unsigned char* lk = F.lds; LAS unsigned char* lv = F.lds + 65536;
#pragma unroll
    for (int k = 0; k < 8; ++k) { const int i = wave + 8 * k;
        { const int r = 4 * i + (lane >> 4), pph = lane & 15, f = (r & 3) | (((r >> 3) & 1) << 2);
          __builtin_amdgcn_global_load_lds((const GAS unsigned*)(KM + (size_t)r * XW + h * XHD + ((pph ^ f) * 8)), (LAS unsigned*)(lk + i * 1024), 16, 0, 0); }
        { const int r = 2 * i + (lane >> 5), pph = lane & 31;
          __builtin_amdgcn_global_load_lds((const GAS unsigned*)(VMT + (size_t)(h * XHD + r) * NMEM + ((pph ^ (r & 7)) * 8)), (LAS unsigned*)(lv + i * 1024), 16, 0, 0); } }
    const int tb = 256 * q256 + 32 * wave;
    bf16x8 qf[2][4];
#pragma unroll
    for (int rt = 0; rt < 2; ++rt)
#pragma unroll
        for (int s = 0; s < 4; ++s) qf[rt][s] = *(const GAS bf16x8*)(Q2 + (size_t)(tb + 16 * rt + i16) * XW + h * XHD + 32 * s + 8 * gq);
    f32x4 o[2][8];
#pragma unroll
    for (int rt = 0; rt < 2; ++rt)
#pragma unroll
        for (int i = 0; i < 8; ++i) o[rt][i] = (f32x4){0.f, 0.f, 0.f, 0.f};
    float m[2] = {NEGBIG, NEGBIG}, l[2] = {0.f, 0.f};
    asm volatile("s_waitcnt vmcnt(0)" ::: "memory");
    __syncthreads();
    const int ko0 = 8 * (i16 >> 2) + (i16 & 3), fk = i16 & 7;
#pragma unroll 1
    for (int kb = 0; kb < NMEM; kb += 32) {
        bf16x8 kf[2][4], vf[8];
#pragma unroll
        for (int tau = 0; tau < 2; ++tau)
#pragma unroll
            for (int ks = 0; ks < 4; ++ks) kf[tau][ks] = *(const LAS bf16x8*)(lk + (kb + ko0 + 4 * tau) * 256 + (((4 * ks + gq) ^ fk) * 16));
#pragma unroll
        for (int dt = 0; dt < 8; ++dt) { const int row = 16 * dt + i16; vf[dt] = *(const LAS bf16x8*)(lv + row * 512 + ((((kb >> 3) + gq) ^ (row & 7)) * 16)); }
#pragma unroll
        for (int rt = 0; rt < 2; ++rt) {
            f32x4 s[2];
#pragma unroll
            for (int tau = 0; tau < 2; ++tau) { s[tau] = (f32x4){0.f, 0.f, 0.f, 0.f};
#pragma unroll
                for (int ks = 0; ks < 4; ++ks) s[tau] = __builtin_amdgcn_mfma_f32_16x16x32_bf16(kf[tau][ks], qf[rt][ks], s[tau], 0, 0, 0); }
            float x[8];
#pragma unroll
            for (int e = 0; e < 8; ++e) x[e] = s[e >> 2][e & 3] - m[rt];
            const float mloc = fmaxf(fmaxf(fmaxf(x[0], x[1]), fmaxf(x[2], x[3])), fmaxf(fmaxf(x[4], x[5]), fmaxf(x[6], x[7])));
            if (__any(mloc > 8.f)) {
                float mx = fmaxf(fmaxf(fmaxf(s[0][0], s[0][1]), fmaxf(s[0][2], s[0][3])), fmaxf(fmaxf(s[1][0], s[1][1]), fmaxf(s[1][2], s[1][3])));
                mx = fmaxf(mx, __shfl_xor(mx, 16)); mx = fmaxf(mx, __shfl_xor(mx, 32));
                const float mn = fmaxf(m[rt], mx); const float alpha = __builtin_amdgcn_exp2f(m[rt] - mn); m[rt] = mn; l[rt] *= alpha;
#pragma unroll
                for (int dt = 0; dt < 8; ++dt) o[rt][dt] = o[rt][dt] * alpha;
#pragma unroll
                for (int e = 0; e < 8; ++e) x[e] = s[e >> 2][e & 3] - mn;
            }
            float p[8]; float ps = 0.f;
#pragma unroll
            for (int e = 0; e < 8; ++e) { p[e] = __builtin_amdgcn_exp2f(x[e]); ps += p[e]; }
            l[rt] += ps;
            u32x4 pw; pw.x = pk2(p[0], p[1]); pw.y = pk2(p[2], p[3]); pw.z = pk2(p[4], p[5]); pw.w = pk2(p[6], p[7]);
            const bf16x8 pb = __builtin_bit_cast(bf16x8, pw);
#pragma unroll
            for (int dt = 0; dt < 8; ++dt) o[rt][dt] = __builtin_amdgcn_mfma_f32_16x16x32_bf16(vf[dt], pb, o[rt][dt], 0, 0, 0);
        }
    }
#pragma unroll
    for (int rt = 0; rt < 2; ++rt) {
        float lt = l[rt]; lt += __shfl_xor(lt, 16); lt += __shfl_xor(lt, 32);
        const float inv = 1.f / lt;
        gbf* op = O2 + (size_t)(tb + 16 * rt + i16) * XW + h * XHD + 4 * gq;
#pragma unroll
        for (int dt = 0; dt < 8; ++dt) { u32x2 w; w.x = pk2(o[rt][dt][0] * inv, o[rt][dt][1] * inv); w.y = pk2(o[rt][dt][2] * inv, o[rt][dt][3] * inv); *(GAS u32x2*)(op + 16 * dt) = w; }
    }
    __syncthreads();
}
constexpr int A2_BKT_OFF = 0, A2_TAB_OFF = 2048;
constexpr int A2_RING_OFF = 4096, A2_SLOT = 8192, A2_NS = 6;
constexpr int A2_IMP_OFF = A2_RING_OFF + A2_NS * A2_SLOT;
constexpr int A2_SELM_OFF = A2_IMP_OFF + NWAVES * 8192;
constexpr int A2_ORW_OFF = A2_SELM_OFF + 2048;
constexpr int A2_U_OFF = A2_ORW_OFF + 512;
constexpr int A2_LIST_OFF = A2_U_OFF + 64;
constexpr int A2_SELC_OFF = A2_LIST_OFF + 1024;
constexpr int A2_ORC_OFF = A2_SELC_OFF + 2048;
constexpr int A2_END = A2_ORC_OFF + 512;
constexpr int A2_BT_OFF = A2_RING_OFF + 12 * A2_SLOT, A2_BT_N = 1600;
static_assert(A2_BT_OFF + 4 * A2_BT_N * 2 <= A2_SELM_OFF, "bias-by-distance table");
static_assert(A2_END <= RING_BYTES, "attention v2 LDS");

__device__ __forceinline__ int a2_fk(int row) { return ((row >> 1) & 1) | (((row >> 3) & 3) << 1); }
__device__ __forceinline__ int a2_gv(int d) { const int q = (d >> 2) & 3; return (0x1320 >> (4 * q)) & 3; }

__device__ __forceinline__ void a2_stage(LAS unsigned char* slot, const gbf* Kg, const gbf* VTg, int vpitch, int kb, int wave, int lane, bool withV) {
    if (wave < 4) {
        const int row = 8 * wave + (lane >> 3), pp = lane & 7;
        const gbf* src = Kg + (size_t)(kb + row) * 64 + ((pp ^ a2_fk(row)) * 8);
        __builtin_amdgcn_global_load_lds((const GAS unsigned*)src, (LAS unsigned*)(slot + wave * 1024), 16, 0, 0);
    } else if (withV) {
        const int v = wave - 4, d = 16 * v + (lane >> 2), pp = lane & 3;
        const gbf* src = VTg + (size_t)d * vpitch + kb + ((pp ^ a2_gv(d)) * 8);
        __builtin_amdgcn_global_load_lds((const GAS unsigned*)src, (LAS unsigned*)(slot + 4096 + v * 1024), 16, 0, 0);
    }
}
struct A2St { f32x4 o[2][4]; f32x4 lacc[2]; float m[2], l[2]; };
__device__ __forceinline__ void a2_reset(A2St& st) {
#pragma unroll
    for (int r = 0; r < 2; ++r) { st.m[r] = NEGBIG; st.l[r] = 0.f; st.lacc[r] = (f32x4){0.f, 0.f, 0.f, 0.f};
#pragma unroll
        for (int i = 0; i < 4; ++i) st.o[r][i] = (f32x4){0.f, 0.f, 0.f, 0.f}; }
}
__device__ __forceinline__ void a2_kfrags(bf16x8 (&kf)[2][2], const LAS unsigned char* slot, int lane) {
    const int i16 = lane & 15, gq = lane >> 4;
#pragma unroll
    for (int tau = 0; tau < 2; ++tau) { const int row = 8 * (i16 >> 2) + 4 * tau + (i16 & 3), f = a2_fk(row);
#pragma unroll
        for (int s = 0; s < 2; ++s) kf[tau][s] = *(const LAS bf16x8*)(slot + row * 128 + (((gq + 4 * s) ^ f) * 16)); }
}
__device__ __forceinline__ void a2_vfrags(bf16x8 (&vf)[4], const LAS unsigned char* slot, int lane) {
    const int i16 = lane & 15, gq = lane >> 4, pc = (gq ^ a2_gv(i16)) * 16;
#pragma unroll
    for (int dt = 0; dt < 4; ++dt) vf[dt] = *(const LAS bf16x8*)(slot + 4096 + (16 * dt + i16) * 64 + pc);
}
template <int MODE, bool FARB>
__device__ __forceinline__ void a2_scores(float (&sv)[8], const bf16x8 (&kf)[2][2], const bf16x8 (&qf)[2], int kb, int t, int head, bool rowsel, float bfar, int lane, const LAS unsigned char* bkt, const LAS float* tab) {
    const int gq = lane >> 4;
    f32x4 s[2];
#pragma unroll
    for (int tau = 0; tau < 2; ++tau) {
        s[tau] = __builtin_amdgcn_mfma_f32_16x16x32_bf16(kf[tau][0], qf[0], (f32x4){0.f, 0.f, 0.f, 0.f}, 0, 0, 0);
        s[tau] = __builtin_amdgcn_mfma_f32_16x16x32_bf16(kf[tau][1], qf[1], s[tau], 0, 0, 0);
    }
#pragma unroll
    for (int tau = 0; tau < 2; ++tau)
#pragma unroll
        for (int r = 0; r < 4; ++r) {
            if (FARB) { sv[4 * tau + r] = (MODE != 1 || rowsel) ? s[tau][r] + bfar : NEGBIG; }
            else {
                const int idx = kb + 8 * gq + 4 * tau + r;
                int dist; bool valid;
                if (MODE == 0) { dist = t - (16 * idx + 31); valid = dist >= 0; }
                else if (MODE == 1) { dist = t - idx; valid = rowsel && dist >= 0; }
                else { dist = t - idx; valid = (unsigned)dist < 512u; }
                const int dc = dist < 0 ? 0 : (dist > 2047 ? 2047 : dist);
                const float b = tab[head * 32 + bkt[dc]];
                sv[4 * tau + r] = valid ? s[tau][r] + b : NEGBIG;
            }
        }
}
__device__ __forceinline__ void a2_softmax_pv(A2St& st, int rt, const float (&sv)[8], const bf16x8 (&vf)[4]) {
    float mx = fmaxf(fmaxf(fmaxf(sv[0], sv[1]), fmaxf(sv[2], sv[3])), fmaxf(fmaxf(sv[4], sv[5]), fmaxf(sv[6], sv[7])));
    mx = fmaxf(mx, __shfl_xor(mx, 16)); mx = fmaxf(mx, __shfl_xor(mx, 32));
    const float mn = fmaxf(st.m[rt], mx);
    const float alpha = __builtin_amdgcn_exp2f(st.m[rt] - mn);
    st.m[rt] = mn;
    float p[8]; float ps = 0.f;
#pragma unroll
    for (int e = 0; e < 8; ++e) { p[e] = __builtin_amdgcn_exp2f(sv[e] - mn); ps += p[e]; }
    st.l[rt] = st.l[rt] * alpha + ps;
    u32x4 pw; pw.x = pk2(p[0], p[1]); pw.y = pk2(p[2], p[3]); pw.z = pk2(p[4], p[5]); pw.w = pk2(p[6], p[7]);
    const bf16x8 pb = __builtin_bit_cast(bf16x8, pw);
#pragma unroll
    for (int dt = 0; dt < 4; ++dt) { st.o[rt][dt] = st.o[rt][dt] * alpha; st.o[rt][dt] = __builtin_amdgcn_mfma_f32_16x16x32_bf16(vf[dt], pb, st.o[rt][dt], 0, 0, 0); }
}
template <int MODE, bool FARB>
__device__ __forceinline__ void a2_tile(A2St& st, int rt, const bf16x8 (&kf)[2][2], const bf16x8 (&vf)[4], const bf16x8 (&qf)[2], int kb, int t, int head, bool rowsel, float bfar, int lane, const LAS unsigned char* bkt, const LAS float* tab) {
    const int gq = lane >> 4;
    f32x4 s[2];
#pragma unroll
    for (int tau = 0; tau < 2; ++tau) {
        s[tau] = __builtin_amdgcn_mfma_f32_16x16x32_bf16(kf[tau][0], qf[0], (f32x4){0.f, 0.f, 0.f, 0.f}, 0, 0, 0);
        s[tau] = __builtin_amdgcn_mfma_f32_16x16x32_bf16(kf[tau][1], qf[1], s[tau], 0, 0, 0);
    }
    const float m = st.m[rt];
    float x[8], bb[8]; bool vl[8];
    const float bsel = ((MODE != 1) || rowsel) ? bfar : -__builtin_inff();
    if (FARB) { const float c = bsel - m;
#pragma unroll
        for (int e = 0; e < 8; ++e) x[e] = s[e >> 2][e & 3] + c;
    } else {
#pragma unroll
        for (int e = 0; e < 8; ++e) {
            const int idx = kb + 8 * gq + e;
            int dist;
            if (MODE == 0) { dist = t - (16 * idx + 31); vl[e] = dist >= 0; }
            else if (MODE == 1) { dist = t - idx; vl[e] = rowsel && dist >= 0; }
            else { dist = t - idx; vl[e] = (unsigned)dist < 512u; }
            const int dc = dist < 0 ? 0 : (dist > 2047 ? 2047 : dist);
            bb[e] = tab[head * 32 + bkt[dc]];
            x[e] = vl[e] ? s[e >> 2][e & 3] + (bb[e] - m) : NEGBIG;
        }
    }
    const float mloc = fmaxf(fmaxf(fmaxf(x[0], x[1]), fmaxf(x[2], x[3])), fmaxf(fmaxf(x[4], x[5]), fmaxf(x[6], x[7])));
    if (__any(mloc > 8.f)) {
        float sv[8]; float mx = NEGBIG;
#pragma unroll
        for (int e = 0; e < 8; ++e) { sv[e] = FARB ? s[e >> 2][e & 3] + bsel : (vl[e] ? s[e >> 2][e & 3] + bb[e] : NEGBIG); mx = fmaxf(mx, sv[e]); }
        mx = fmaxf(mx, __shfl_xor(mx, 16)); mx = fmaxf(mx, __shfl_xor(mx, 32));
        const float mn = fmaxf(m, mx);
        const float alpha = __builtin_amdgcn_exp2f(m - mn);
        st.m[rt] = mn; st.lacc[rt] = st.lacc[rt] * alpha;
#pragma unroll
        for (int dt = 0; dt < 4; ++dt) st.o[rt][dt] = st.o[rt][dt] * alpha;
#pragma unroll
        for (int e = 0; e < 8; ++e) x[e] = sv[e] - mn;
    }
    float p[8];
#pragma unroll
    for (int e = 0; e < 8; ++e) p[e] = __builtin_amdgcn_exp2f(x[e]);
    u32x4 pw; pw.x = pk2(p[0], p[1]); pw.y = pk2(p[2], p[3]); pw.z = pk2(p[4], p[5]); pw.w = pk2(p[6], p[7]);
    const bf16x8 pb = __builtin_bit_cast(bf16x8, pw);
    const short one = (lane & 15) == 0 ? (short)0x3F80 : (short)0;
    const bf16x8 vones = {one, one, one, one, one, one, one, one};
    st.lacc[rt] = __builtin_amdgcn_mfma_f32_16x16x32_bf16(vones, pb, st.lacc[rt], 0, 0, 0);
#pragma unroll
    for (int dt = 0; dt < 4; ++dt) st.o[rt][dt] = __builtin_amdgcn_mfma_f32_16x16x32_bf16(vf[dt], pb, st.o[rt][dt], 0, 0, 0);
}
template <int MODE, bool FARB>
__device__ __forceinline__ void a2_tile64(A2St& st, int rt, const LAS unsigned char* slot0, const LAS unsigned char* slot1, const bf16x8 (&qf)[2], int kb, int t, int head, bool rowsel, float bfar, int lane, const LAS unsigned char* bkt, const LAS float* tab) {
    const int gq = lane >> 4;
    f32x4 s[4];
    { bf16x8 kf[2][2][2]; a2_kfrags(kf[0], slot0, lane); a2_kfrags(kf[1], slot1, lane);
#pragma unroll
      for (int u = 0; u < 4; ++u) {
        s[u] = __builtin_amdgcn_mfma_f32_16x16x32_bf16(kf[u >> 1][u & 1][0], qf[0], (f32x4){0.f, 0.f, 0.f, 0.f}, 0, 0, 0);
        s[u] = __builtin_amdgcn_mfma_f32_16x16x32_bf16(kf[u >> 1][u & 1][1], qf[1], s[u], 0, 0, 0);
      } }
    const float m = st.m[rt];
    float x[16], bb[16]; bool vl[16];
    const float bsel = ((MODE != 1) || rowsel) ? bfar : -__builtin_inff();
    if (FARB) { const float c = bsel - m;
#pragma unroll
        for (int e = 0; e < 16; ++e) x[e] = s[e >> 2][e & 3] + c;
    } else {
#pragma unroll
        for (int e = 0; e < 16; ++e) {
            const int idx = kb + 32 * (e >> 3) + 8 * gq + (e & 7);
            int dist;
            if (MODE == 0) { dist = t - (16 * idx + 31); vl[e] = dist >= 0; }
            else if (MODE == 1) { dist = t - idx; vl[e] = rowsel && dist >= 0; }
            else { dist = t - idx; vl[e] = (unsigned)dist < 512u; }
            const int dc = dist < 0 ? 0 : (dist > 2047 ? 2047 : dist);
            bb[e] = tab[head * 32 + bkt[dc]];
            x[e] = vl[e] ? s[e >> 2][e & 3] + (bb[e] - m) : NEGBIG;
        }
    }
    float mloc = x[0];
#pragma unroll
    for (int e = 1; e < 16; ++e) mloc = fmaxf(mloc, x[e]);
    if (__any(mloc > 8.f)) {
        float sv[16]; float mx = NEGBIG;
#pragma unroll
        for (int e = 0; e < 16; ++e) { sv[e] = FARB ? s[e >> 2][e & 3] + bsel : (vl[e] ? s[e >> 2][e & 3] + bb[e] : NEGBIG); mx = fmaxf(mx, sv[e]); }
        mx = fmaxf(mx, __shfl_xor(mx, 16)); mx = fmaxf(mx, __shfl_xor(mx, 32));
        const float mn = fmaxf(m, mx);
        const float alpha = __builtin_amdgcn_exp2f(m - mn);
        st.m[rt] = mn; st.lacc[rt] = st.lacc[rt] * alpha;
#pragma unroll
        for (int dt = 0; dt < 4; ++dt) st.o[rt][dt] = st.o[rt][dt] * alpha;
#pragma unroll
        for (int e = 0; e < 16; ++e) x[e] = sv[e] - mn;
    }
    float p[16];
#pragma unroll
    for (int e = 0; e < 16; ++e) p[e] = __builtin_amdgcn_exp2f(x[e]);
    const short one = (lane & 15) == 0 ? (short)0x3F80 : (short)0;
    const bf16x8 vones = {one, one, one, one, one, one, one, one};
#pragma unroll
    for (int hh = 0; hh < 2; ++hh) {
        u32x4 pw; pw.x = pk2(p[8 * hh + 0], p[8 * hh + 1]); pw.y = pk2(p[8 * hh + 2], p[8 * hh + 3]); pw.z = pk2(p[8 * hh + 4], p[8 * hh + 5]); pw.w = pk2(p[8 * hh + 6], p[8 * hh + 7]);
        const bf16x8 pb = __builtin_bit_cast(bf16x8, pw);
        bf16x8 vf[4]; a2_vfrags(vf, hh == 0 ? slot0 : slot1, lane);
        st.lacc[rt] = __builtin_amdgcn_mfma_f32_16x16x32_bf16(vones, pb, st.lacc[rt], 0, 0, 0);
#pragma unroll
        for (int dt = 0; dt < 4; ++dt) st.o[rt][dt] = __builtin_amdgcn_mfma_f32_16x16x32_bf16(vf[dt], pb, st.o[rt][dt], 0, 0, 0);
    }
}
template <int MODE>
__device__ __forceinline__ void a2_tile64b(A2St& st, int rt, const LAS unsigned char* slot0, const LAS unsigned char* slot1, const bf16x8 (&qf)[2], bool rowsel, int lane, const LAS _Float16* bt) {
    f32x4 s[4];
    { bf16x8 kf[2][2][2]; a2_kfrags(kf[0], slot0, lane); a2_kfrags(kf[1], slot1, lane);
#pragma unroll
      for (int u = 0; u < 4; ++u) {
        s[u] = __builtin_amdgcn_mfma_f32_16x16x32_bf16(kf[u >> 1][u & 1][0], qf[0], (f32x4){0.f, 0.f, 0.f, 0.f}, 0, 0, 0);
        s[u] = __builtin_amdgcn_mfma_f32_16x16x32_bf16(kf[u >> 1][u & 1][1], qf[1], s[u], 0, 0, 0);
      } }
    const float m = st.m[rt];
    const float rsel = ((MODE != 1) || rowsel) ? 0.f : -__builtin_inff();
    const float c = rsel - m;
    float x[16];
#pragma unroll
    for (int e = 0; e < 16; ++e) x[e] = s[e >> 2][e & 3] + ((float)bt[(7 - (e & 7)) + 32 * (1 - (e >> 3))] + c);
    const float mloc = fmaxf(fmaxf(fmaxf(fmaxf(x[0], x[1]), fmaxf(x[2], x[3])), fmaxf(fmaxf(x[4], x[5]), fmaxf(x[6], x[7]))), fmaxf(fmaxf(fmaxf(x[8], x[9]), fmaxf(x[10], x[11])), fmaxf(fmaxf(x[12], x[13]), fmaxf(x[14], x[15]))));
    if (__any(mloc > 8.f)) {
        float sv[16]; float mx = NEGBIG;
#pragma unroll
        for (int e = 0; e < 16; ++e) { sv[e] = s[e >> 2][e & 3] + ((float)bt[(7 - (e & 7)) + 32 * (1 - (e >> 3))] + rsel); mx = fmaxf(mx, sv[e]); }
        mx = fmaxf(mx, __shfl_xor(mx, 16)); mx = fmaxf(mx, __shfl_xor(mx, 32));
        const float mn = fmaxf(m, mx);
        const float alpha = __builtin_amdgcn_exp2f(m - mn);
        st.m[rt] = mn; st.lacc[rt] = st.lacc[rt] * alpha;
#pragma unroll
        for (int dt = 0; dt < 4; ++dt) st.o[rt][dt] = st.o[rt][dt] * alpha;
#pragma unroll
        for (int e = 0; e < 16; ++e) x[e] = sv[e] - mn;
    }
    float p[16];
#pragma unroll
    for (int e = 0; e < 16; ++e) p[e] = __builtin_amdgcn_exp2f(x[e]);
    const short one = (lane & 15) == 0 ? (short)0x3F80 : (short)0;
    const bf16x8 vones = {one, one, one, one, one, one, one, one};
#pragma unroll
    for (int hh = 0; hh < 2; ++hh) {
        u32x4 pw; pw.x = pk2(p[8 * hh + 0], p[8 * hh + 1]); pw.y = pk2(p[8 * hh + 2], p[8 * hh + 3]); pw.z = pk2(p[8 * hh + 4], p[8 * hh + 5]); pw.w = pk2(p[8 * hh + 6], p[8 * hh + 7]);
        const bf16x8 pb = __builtin_bit_cast(bf16x8, pw);
        bf16x8 vf[4]; a2_vfrags(vf, hh == 0 ? slot0 : slot1, lane);
        st.lacc[rt] = __builtin_amdgcn_mfma_f32_16x16x32_bf16(vones, pb, st.lacc[rt], 0, 0, 0);
#pragma unroll
        for (int dt = 0; dt < 4; ++dt) st.o[rt][dt] = __builtin_amdgcn_mfma_f32_16x16x32_bf16(vf[dt], pb, st.o[rt][dt], 0, 0, 0);
    }
}
__device__ __forceinline__ void a2_finish(const A2St& st, f32x4 (&acc)[2][4], const float (&gate)[2], int lane_) {
#pragma unroll
    for (int rt = 0; rt < 2; ++rt) {
        const float l = __shfl(st.lacc[rt][0], lane_ & 15);
        const float sc = (st.m[rt] > -1e29f) ? gate[rt] / l : 0.f;
#pragma unroll
        for (int dt = 0; dt < 4; ++dt) acc[rt][dt] += st.o[rt][dt] * sc;
    }
}
#define A2_WAITV(n) asm volatile("s_waitcnt vmcnt(" #n ")" ::: "memory")
__device__ __forceinline__ void a2_stage2(LAS unsigned char* ring, int ps, const gbf* Kg, const gbf* VTg, int vpitch, int kbA, int kbB, int wave, int lane, bool withV) {
    a2_stage(ring + (2 * ps) * A2_SLOT, Kg, VTg, vpitch, kbA, wave, lane, withV);
    a2_stage(ring + (2 * ps + 1) * A2_SLOT, Kg, VTg, vpitch, kbB, wave, lane, withV);
}
__device__ __forceinline__ unsigned a2_voff(int wave, int lane, int vpitch) {
    if (wave < 4) { const int row = 8 * wave + (lane >> 3), pp = lane & 7; return (unsigned)(row * 64 + ((pp ^ a2_fk(row)) * 8)) * 2u; }
    const int v = wave - 4, d = 16 * v + (lane >> 2), pp = lane & 3; return (unsigned)(d * vpitch + ((pp ^ a2_gv(d)) * 8)) * 2u;
}
__device__ __forceinline__ void a2_stage_blk(LAS unsigned char* ring, int bslot, const GAS char* Kb, const GAS char* Vb, int blk, int wave, unsigned voff) {
    LAS unsigned char* s0 = ring + (2 * bslot) * A2_SLOT;
    if (wave < 4) { const GAS char* b = Kb + (size_t)blk * 8192;
        __builtin_amdgcn_global_load_lds((const GAS unsigned*)(b + voff), (LAS unsigned*)(s0 + wave * 1024), 16, 0, 0);
        __builtin_amdgcn_global_load_lds((const GAS unsigned*)(b + 4096 + voff), (LAS unsigned*)(s0 + A2_SLOT + wave * 1024), 16, 0, 0);
    } else { const int v = wave - 4; const GAS char* b = Vb + (size_t)blk * 128;
        __builtin_amdgcn_global_load_lds((const GAS unsigned*)(b + voff), (LAS unsigned*)(s0 + 4096 + v * 1024), 16, 0, 0);
        __builtin_amdgcn_global_load_lds((const GAS unsigned*)(b + 64 + voff), (LAS unsigned*)(s0 + A2_SLOT + 4096 + v * 1024), 16, 0, 0); }
}
#define A2_BARRIER() do { asm volatile("" ::: "memory"); __builtin_amdgcn_s_barrier(); asm volatile("" ::: "memory"); } while (0)

#ifndef MK_REP_P1
#define MK_REP_P1 1
#endif
#ifndef MK_REP_P2
#define MK_REP_P2 1
#endif
#ifndef MK_REP_TK
#define MK_REP_TK 1
#endif
#ifndef MK_REP_SEL
#define MK_REP_SEL 1
#endif
#ifndef MK_REP_WIN
#define MK_REP_WIN 1
#endif
__device__ __forceinline__ void nsa_unit_v2(Frame& F, const AttnPtrs& P, int qt, int g) {
    int lane_l = F.lane; asm volatile("" : "+v"(lane_l));
    const int lane = lane_l, wave = F.wave, i16 = lane & 15, gq = lane >> 4, ql = i16 >> 2, hl = i16 & 3;
    const LAS unsigned char* bkt = F.lds + A2_BKT_OFF; const LAS float* tab = (const LAS float*)(F.lds + A2_TAB_OFF);
    LAS unsigned char* ring = F.lds + A2_RING_OFF;
    LAS float* imp = (LAS float*)(F.lds + A2_IMP_OFF + wave * 8192);
    LAS unsigned* selm = (LAS unsigned*)(F.lds + A2_SELM_OFF) + wave * 64;
    LAS unsigned* orw = (LAS unsigned*)(F.lds + A2_ORW_OFF) + wave * 16;
    LAS unsigned* Uw = (LAS unsigned*)(F.lds + A2_U_OFF);
    LAS unsigned* ulist = (LAS unsigned*)(F.lds + A2_LIST_OFF);
    const int t0 = 64 * qt, tw = t0 + 8 * wave, cur = qt, head = 4 * g + hl;
    int tq[2]; tq[0] = tw + ql; tq[1] = tw + 4 + ql;
    bf16x8 qf[2][2]; float g_c[2], g_s[2], g_w[2];
#pragma unroll
    for (int rt = 0; rt < 2; ++rt) { const gbf* qp = P.Q + (size_t)tq[rt] * NSAW + head * 64 + 8 * gq; qf[rt][0] = *(const GAS bf16x8*)qp; qf[rt][1] = *(const GAS bf16x8*)(qp + 32);
        const gfl* gp = P.GL + (size_t)tq[rt] * 48 + head * 3; g_c[rt] = (MK_BR & 1) ? gp[0] : 0.f; g_s[rt] = (MK_BR & 2) ? gp[1] : 0.f; g_w[rt] = (MK_BR & 4) ? gp[2] : 0.f; }
    const float bfar = tab[head * 32 + 31];
    f32x4 acc[2][4];
#pragma unroll
    for (int r = 0; r < 2; ++r)
#pragma unroll
        for (int i = 0; i < 4; ++i) acc[r][i] = (f32x4){0.f, 0.f, 0.f, 0.f};
    A2St st;
    A2_WAITV(0);
    const gbf* KCg = P.KC + (size_t)g * 1024 * 64; const gbf* VCTg = P.VCT + (size_t)g * 64 * 1024;
    const int nlast = (t0 + 63 - 31) / 16;
    const int Tc = (nlast / 32 + 2) & ~1;
    const int Pc = Tc >> 1;
    a2_reset(st);
#pragma unroll 1
    for (int rep_ = 0; rep_ < MK_REP_P1; ++rep_) { a2_reset(st); A2_BARRIER();
    {
        a2_stage2(ring, 0, KCg, VCTg, 1024, 0, 32, wave, lane, true);
        if (Pc > 1) a2_stage2(ring, 1, KCg, VCTg, 1024, 64, 96, wave, lane, true);
#pragma unroll 1
        for (int j = 0; j < Pc; ++j) {
            if (j + 1 < Pc) A2_WAITV(2); else A2_WAITV(0);
            A2_BARRIER();
            if (j + 2 < Pc) a2_stage2(ring, (j + 2) % 3, KCg, VCTg, 1024, 64 * (j + 2), 64 * (j + 2) + 32, wave, lane, true);
#pragma unroll 1
            for (int hh = 0; hh < 2; ++hh) {
                const LAS unsigned char* slot = ring + (2 * (j % 3) + hh) * A2_SLOT; const int kb = 64 * j + 32 * hh;
                bf16x8 kf[2][2], vf[4]; a2_kfrags(kf, slot, lane); a2_vfrags(vf, slot, lane);
                const bool farb = tw - (16 * (kb + 31) + 31) >= 1513;
#pragma unroll
                for (int rt = 0; rt < 2; ++rt) {
                    if (farb) a2_tile<0, true>(st, rt, kf, vf, qf[rt], kb, tq[rt], head, true, bfar, lane, bkt, tab); else a2_tile<0, false>(st, rt, kf, vf, qf[rt], kb, tq[rt], head, true, bfar, lane, bkt, tab); }
            }
        }
    }
    }
    a2_finish(st, acc, g_c, lane);
#pragma unroll 1
    for (int rep_ = 0; rep_ < MK_REP_P2; ++rep_) {
    if (cur >= 16) {
        float inv_l[2], mfin[2], carry[2];
#pragma unroll
        for (int rt = 0; rt < 2; ++rt) { const float lt = __shfl(st.lacc[rt][0], lane & 15); inv_l[rt] = (st.m[rt] > -1e29f) ? 1.f / lt : 0.f; mfin[rt] = st.m[rt]; carry[rt] = 0.f; }
        A2_BARRIER();
        a2_stage2(ring, 0, KCg, VCTg, 1024, 0, 32, wave, lane, false);
        if (Pc > 1) a2_stage2(ring, 1, KCg, VCTg, 1024, 64, 96, wave, lane, false);
#pragma unroll 1
        for (int j = 0; j < Pc; ++j) {
            if (j + 1 < Pc) A2_WAITV(2); else A2_WAITV(0);
            A2_BARRIER();
            if (j + 2 < Pc) a2_stage2(ring, (j + 2) % 3, KCg, VCTg, 1024, 64 * (j + 2), 64 * (j + 2) + 32, wave, lane, false);
#pragma unroll 1
          for (int hh = 0; hh < 2; ++hh) {
            const LAS unsigned char* slot = ring + (2 * (j % 3) + hh) * A2_SLOT; const int kb = 64 * j + 32 * hh;
            bf16x8 kf[2][2]; a2_kfrags(kf, slot, lane);
            const bool farb = tw - (16 * (kb + 31) + 31) >= 1513;
#pragma unroll
            for (int rt = 0; rt < 2; ++rt) { float sv[8];
                if (farb) a2_scores<0, true>(sv, kf, qf[rt], kb, tq[rt], head, true, bfar, lane, bkt, tab); else a2_scores<0, false>(sv, kf, qf[rt], kb, tq[rt], head, true, bfar, lane, bkt, tab);
                float ps[8];
#pragma unroll
                for (int e = 0; e < 8; ++e) ps[e] = (sv[e] > -1e29f) ? __builtin_amdgcn_exp2f(sv[e] - mfin[rt]) : 0.f;
                float a0 = ps[0] + ps[1] + ps[2] + 0.5f * ps[3]; const float c0 = 0.5f * ps[3];
                float a1 = ps[4] + ps[5] + ps[6] + 0.5f * ps[7] + c0, c1 = 0.5f * ps[7];
                a0 *= inv_l[rt]; a1 *= inv_l[rt]; c1 *= inv_l[rt];
                a0 += __builtin_bit_cast(float, __builtin_amdgcn_update_dpp(0, __builtin_bit_cast(int, a0), 0xB1, 0xF, 0xF, true)); a0 += __builtin_bit_cast(float, __builtin_amdgcn_update_dpp(0, __builtin_bit_cast(int, a0), 0x4E, 0xF, 0xF, true));
                a1 += __builtin_bit_cast(float, __builtin_amdgcn_update_dpp(0, __builtin_bit_cast(int, a1), 0xB1, 0xF, 0xF, true)); a1 += __builtin_bit_cast(float, __builtin_amdgcn_update_dpp(0, __builtin_bit_cast(int, a1), 0x4E, 0xF, 0xF, true));
                c1 += __builtin_bit_cast(float, __builtin_amdgcn_update_dpp(0, __builtin_bit_cast(int, c1), 0xB1, 0xF, 0xF, true)); c1 += __builtin_bit_cast(float, __builtin_amdgcn_update_dpp(0, __builtin_bit_cast(int, c1), 0x4E, 0xF, 0xF, true));
                const float sh = __shfl(c1, (lane + 48) & 63);
                a0 += (gq == 0) ? carry[rt] : sh; carry[rt] = sh;
                const int j0 = (kb + 8 * gq) >> 2;
                if (hl == 0) { imp[(4 * rt + ql) * 256 + j0] = a0; imp[(4 * rt + ql) * 256 + j0 + 1] = a1; }
            }
          }
        }
    }
    }
    LDS_WAIT();
    unsigned uacc = 0u;
#pragma unroll 1
    for (int rep_ = 0; rep_ < MK_REP_TK; ++rep_) {
#pragma unroll 1
    for (int q4 = 0; q4 < 8; q4 += 4) {
        unsigned mword[4] = {0u, 0u, 0u, 0u};
        if (cur <= 15) { if (lane == 0) { mword[0] = (2u << cur) - 1u; mword[1] = mword[0]; mword[2] = mword[0]; mword[3] = mword[0]; } }
        else {
            unsigned key[4][4];
#pragma unroll
            for (int qq = 0; qq < 4; ++qq)
#pragma unroll
                for (int e = 0; e < 4; ++e) { const int j = 4 * lane + e; const bool cand = (j >= 1) && (j <= cur - 2); const float v = imp[(q4 + qq) * 256 + j];
                    key[qq][e] = cand ? ((__builtin_bit_cast(unsigned, v) & 0xffffff00u) | (unsigned)(255 - j)) : 0u; }
#pragma unroll 1
            for (int round = 0; round < 13; ++round) {
#pragma unroll
                for (int qq = 0; qq < 4; ++qq) {
                    unsigned best = key[qq][0] > key[qq][1] ? key[qq][0] : key[qq][1]; const unsigned b2 = key[qq][2] > key[qq][3] ? key[qq][2] : key[qq][3]; best = best > b2 ? best : b2;
                    const unsigned wk = wave_max_u32_dpp(best);
                    const int js = 255 - (int)(wk & 255u);
#pragma unroll
                    for (int e = 0; e < 4; ++e) key[qq][e] = (key[qq][e] == wk) ? 0u : key[qq][e];
                    if (lane == (js >> 5)) mword[qq] |= 1u << (js & 31);
                }
            }
#pragma unroll
            for (int qq = 0; qq < 4; ++qq) {
                if (lane == 0) mword[qq] |= 1u;
                if (lane == (cur >> 5)) mword[qq] |= 1u << (cur & 31);
                if (lane == ((cur - 1) >> 5)) mword[qq] |= 1u << ((cur - 1) & 31);
            }
        }
#pragma unroll
        for (int qq = 0; qq < 4; ++qq) { if (lane < 8) selm[(q4 + qq) * 8 + lane] = mword[qq]; uacc |= mword[qq]; }
    }
    }
    LDS_WAIT();
    GAS f32x4* stash = (GAS f32x4*)(F.ws + WS_Y1) + (size_t)(F.vcu * NWAVES + wave) * 512;
#pragma unroll
    for (int rt = 0; rt < 2; ++rt)
#pragma unroll
        for (int dt = 0; dt < 4; ++dt) stash[(rt * 4 + dt) * 64 + lane] = acc[rt][dt];
    if (lane < 16) { const int rt = lane >> 3, w = lane & 7; orw[lane] = selm[(4 * rt) * 8 + w] | selm[(4 * rt + 1) * 8 + w] | selm[(4 * rt + 2) * 8 + w] | selm[(4 * rt + 3) * 8 + w]; }
    if (F.tid < 9) Uw[F.tid] = 0u;
    LDS_WAIT(); A2_BARRIER();
    if (lane < 8) (void)__hip_atomic_fetch_or(Uw + lane, uacc, __ATOMIC_RELAXED, __HIP_MEMORY_SCOPE_WORKGROUP);
    LDS_WAIT(); A2_BARRIER();
    if (wave == 0) {
        int base = 0;
#pragma unroll 1
        for (int c = 0; c < 4; ++c) {
            const unsigned word = Uw[2 * c + (lane >> 5)]; const bool bit = (word >> (lane & 31)) & 1u;
            const unsigned long long bal = __ballot(bit);
            const int pos = base + (int)__builtin_amdgcn_mbcnt_hi((unsigned)(bal >> 32), __builtin_amdgcn_mbcnt_lo((unsigned)bal, 0u));
            if (bit) ulist[pos] = (unsigned)(64 * c + lane);
            base += __popcll(bal);
        }
        if (lane == 0) Uw[8] = (unsigned)base;
    }
    LDS_WAIT(); A2_BARRIER();
    {
        LAS _Float16* btw = (LAS _Float16*)(F.lds + A2_BT_OFF);
#pragma unroll 1
        for (int i = F.tid; i < 4 * A2_BT_N; i += NWAVES * 64) { const int h = i / A2_BT_N, d = i - h * A2_BT_N; btw[i] = (_Float16)tab[(4 * g + h) * 32 + bkt[d]]; }
        LDS_WAIT();
    }
    const LAS _Float16* btl = (const LAS _Float16*)(F.lds + A2_BT_OFF) + hl * A2_BT_N;
    int lanes = lane; asm volatile("" : "+v"(lanes));
    const gbf* KSg = P.KSEL + (size_t)g * S_ * 64; const gbf* VSTg = P.VSELT + (size_t)g * 64 * S_;
    a2_reset(st);
#pragma unroll 1
    for (int rep_ = 0; rep_ < MK_REP_SEL; ++rep_) { a2_reset(st); A2_BARRIER();
    {
        const int Ps = (int)__builtin_amdgcn_readfirstlane((int)Uw[8]);
        const GAS char* KSb = (const GAS char*)KSg; const GAS char* VSb = (const GAS char*)VSTg;
        const unsigned voffS = a2_voff(wave, lanes, S_);
        unsigned ulc = ulist[lanes], uln = ulist[64 + lanes]; int chunk = 0;
#define A2_UL(j) (((j) >> 6) == chunk ? __builtin_amdgcn_readlane((int)ulc, (j) & 63) : __builtin_amdgcn_readlane((int)uln, (j) & 63))
#pragma unroll
        for (int bi = 0; bi < 3; ++bi) if (bi < Ps) a2_stage_blk(ring, bi, KSb, VSb, A2_UL(bi), wave, voffS);
        LAS unsigned* selc = (LAS unsigned*)(F.lds + A2_SELC_OFF) + wave * 64; LAS unsigned* orc = (LAS unsigned*)(F.lds + A2_ORC_OFF) + wave * 16;
        int jfar = 0;
        { const int thr = (tw >= 1576) ? ((tw - 1576) >> 6) : -1;
#pragma unroll 1
          for (int ps = 0; ps < 4 && 64 * ps < Ps; ++ps) { const int jj = 64 * ps + lane; const bool vj = jj < Ps; const int bk = vj ? (int)ulist[jj] : 0; const int w = bk >> 5, b = bk & 31;
              jfar += __popcll(__ballot(vj && bk <= thr));
#pragma unroll
              for (int q = 0; q < 8; ++q) { const unsigned long long bal = __ballot(vj && ((selm[q * 8 + w] >> b) & 1u)); if (lane == 0) { selc[q * 8 + 2 * ps] = (unsigned)bal; selc[q * 8 + 2 * ps + 1] = (unsigned)(bal >> 32); } } }
          LDS_WAIT();
          if (lane < 16) { const int rt = lane >> 3, w = lane & 7; orc[lane] = selc[(4 * rt) * 8 + w] | selc[(4 * rt + 1) * 8 + w] | selc[(4 * rt + 2) * 8 + w] | selc[(4 * rt + 3) * 8 + w]; }
          LDS_WAIT(); }
        unsigned or0 = 0u, or1 = 0u, my0 = 0u, my1 = 0u;
        const int NS3 = (Ps + 2) / 3;
#pragma unroll 1
        for (int sp = 0; sp < NS3; ++sp) {
            const int j0 = 3 * sp;
            if ((j0 >> 6) != chunk) { chunk = j0 >> 6; ulc = uln; if (chunk < 3) uln = ulist[(chunk + 1) * 64 + lanes]; }
            A2_WAITV(0);
            A2_BARRIER();
#pragma unroll
            for (int bi = 0; bi < 3; ++bi) { const int jn = j0 + 3 + bi; if (jn < Ps) a2_stage_blk(ring, ((sp + 1) & 1) * 3 + bi, KSb, VSb, A2_UL(jn), wave, voffS); }
#pragma unroll 1
            for (int bi = 0; bi < 3; ++bi) {
                const int j = j0 + bi; if (j >= Ps) break;
                const int b = j & 31;
                if (b == 0) { const int jw = j >> 5; or0 = (unsigned)__builtin_amdgcn_readfirstlane((int)orc[jw]); or1 = (unsigned)__builtin_amdgcn_readfirstlane((int)orc[8 + jw]); my0 = selc[ql * 8 + jw]; my1 = selc[(4 + ql) * 8 + jw]; }
                const bool need0 = (or0 >> b) & 1u, need1 = (or1 >> b) & 1u;
                if (need0 || need1) {
                    const bool rs0 = (my0 >> b) & 1u, rs1 = (my1 >> b) & 1u;
                    const bool farb = j < jfar;
                    const int blk = farb ? 0 : A2_UL(j);
                    const LAS unsigned char* slot0 = ring + (2 * ((sp & 1) * 3 + bi)) * A2_SLOT; const LAS unsigned char* slot1 = slot0 + A2_SLOT;
#pragma unroll
                    for (int rt = 0; rt < 2; ++rt) {
                        if (rt == 0 ? need0 : need1) { const bool rs = rt == 0 ? rs0 : rs1;
                            if (farb) a2_tile64<1, true>(st, rt, slot0, slot1, qf[rt], blk * 64, tq[rt], head, rs, bfar, lanes, bkt, tab);
                            else if (blk * 64 + 63 <= tw + 4 * rt) a2_tile64b<1>(st, rt, slot0, slot1, qf[rt], rs, lanes, btl + (tq[rt] - (blk * 64 + 32 + 8 * gq + 7)));
                            else {
#pragma unroll 1
                                for (int hh = 0; hh < 2; ++hh) { bf16x8 kf[2][2], vf[4]; a2_kfrags(kf, hh ? slot1 : slot0, lanes); a2_vfrags(vf, hh ? slot1 : slot0, lanes);
                                    a2_tile<1, false>(st, rt, kf, vf, qf[rt], blk * 64 + 32 * hh, tq[rt], head, rs, bfar, lanes, bkt, tab); } } }
                    }
                }
            }
        }
    }
    }
    {
#pragma unroll
        for (int rt = 0; rt < 2; ++rt)
#pragma unroll
            for (int dt = 0; dt < 4; ++dt) acc[rt][dt] = (f32x4){0.f, 0.f, 0.f, 0.f};
        a2_finish(st, acc, g_s, lane);
#pragma unroll
        for (int rt = 0; rt < 2; ++rt)
#pragma unroll
            for (int dt = 0; dt < 4; ++dt) stash[(rt * 4 + dt) * 64 + lane] += acc[rt][dt];
        LDS_WAIT();
    }
    const gbf* KWg = P.KWIN + (size_t)g * S_ * 64; const gbf* VWTg = P.VWINT + (size_t)g * 64 * S_;
    a2_reset(st);
    int lanew = lane; asm volatile("" : "+v"(lanew));
#pragma unroll 1
    for (int rep_ = 0; rep_ < MK_REP_WIN; ++rep_) { a2_reset(st); A2_BARRIER();
    {
        int kb0 = t0 - 511; kb0 = kb0 < 0 ? 0 : (kb0 & ~31);
        const int Pw = ((t0 + 63 - kb0) / 32 + 1) >> 1;
        A2_BARRIER();
        a2_stage2(ring, 0, KWg, VWTg, S_, kb0, kb0 + 32, wave, lanew, true);
        if (Pw > 1) a2_stage2(ring, 1, KWg, VWTg, S_, kb0 + 64, kb0 + 96, wave, lanew, true);
#pragma unroll 1
        for (int j = 0; j < Pw; ++j) {
            if (j + 1 < Pw) A2_WAITV(2); else A2_WAITV(0);
            A2_BARRIER();
            if (j + 2 < Pw) a2_stage2(ring, (j + 2) % 3, KWg, VWTg, S_, kb0 + 64 * (j + 2), kb0 + 64 * (j + 2) + 32, wave, lanew, true);
            const int kbp = kb0 + 64 * j;
            if (kbp + 63 <= tw && tw + 7 - kbp <= 511) {
                const LAS unsigned char* slot0 = ring + (2 * (j % 3)) * A2_SLOT; const LAS unsigned char* slot1 = slot0 + A2_SLOT;
#pragma unroll
                for (int rt = 0; rt < 2; ++rt) a2_tile64b<2>(st, rt, slot0, slot1, qf[rt], true, lanew, btl + (tq[rt] - (kbp + 32 + 8 * gq + 7)));
            } else
#pragma unroll 1
            for (int hh = 0; hh < 2; ++hh) {
                const int kb = kb0 + 64 * j + 32 * hh;
                if (kb <= tw + 7 && kb + 31 >= tw - 511) {
                    const LAS unsigned char* slot = ring + (2 * (j % 3) + hh) * A2_SLOT;
                    bf16x8 kf[2][2], vf[4]; a2_kfrags(kf, slot, lanew); a2_vfrags(vf, slot, lanew);
#pragma unroll
                    for (int rt = 0; rt < 2; ++rt) a2_tile<2, false>(st, rt, kf, vf, qf[rt], kb, tq[rt], head, true, bfar, lanew, bkt, tab);
                }
            }
        }
    }
    }
#pragma unroll
    for (int rt = 0; rt < 2; ++rt)
#pragma unroll
        for (int dt = 0; dt < 4; ++dt) acc[rt][dt] = stash[(rt * 4 + dt) * 64 + lanew];
    a2_finish(st, acc, g_w, lane);
    A2_BARRIER();
#pragma unroll
    for (int rt = 0; rt < 2; ++rt) { gbf* ap = P.A + (size_t)tq[rt] * NSAW + head * 64 + 4 * gq;
#pragma unroll
        for (int dt = 0; dt < 4; ++dt) { u32x2 w; w.x = pk2(acc[rt][dt][0], acc[rt][dt][1]); w.y = pk2(acc[rt][dt][2], acc[rt][dt][3]); *(GAS u32x2*)(ap + 16 * dt) = w; } }
}
__device__ __forceinline__ void pool_item(const gbf* U, gbf* YP, int item, int lane) {
    const int t = item >> 1, half = item & 1, gi = half * 2 + (lane >> 5), w = 2 << gi, col = half * 512 + lane * 8;
    const int cnt = (t + 1) < w ? (t + 1) : w;
    float s[8];
#pragma unroll
    for (int e = 0; e < 8; ++e) s[e] = 0.f;
    float u0[8];
    u32x4 v[16];
    if (half == 0) {
#pragma unroll
        for (int i = 0; i < 4; ++i) { const int r = (i < cnt) ? t - i : t; v[i] = *(const GAS u32x4*)(U + (size_t)r * POOLW + col); }
#pragma unroll
        for (int i = 0; i < 4; ++i) { const float f[8] = {bflo(v[i].x), bfhi(v[i].x), bflo(v[i].y), bfhi(v[i].y), bflo(v[i].z), bfhi(v[i].z), bflo(v[i].w), bfhi(v[i].w)};
#pragma unroll
            for (int e = 0; e < 8; ++e) { if (i < cnt) s[e] += f[e]; if (i == 0) u0[e] = f[e]; } }
    } else {
#pragma unroll
        for (int i = 0; i < 16; ++i) { const int r = (i < cnt) ? t - i : t; v[i] = *(const GAS u32x4*)(U + (size_t)r * POOLW + col); }
#pragma unroll
        for (int i = 0; i < 16; ++i) { const float f[8] = {bflo(v[i].x), bfhi(v[i].x), bflo(v[i].y), bfhi(v[i].y), bflo(v[i].z), bfhi(v[i].z), bflo(v[i].w), bfhi(v[i].w)};
#pragma unroll
            for (int e = 0; e < 8; ++e) { if (i < cnt) s[e] += f[e]; if (i == 0) u0[e] = f[e]; } }
    }
    const float inv = 1.f / (float)cnt;
    u32x4 o; o.x = pk2(s[0] * inv - u0[0], s[1] * inv - u0[1]); o.y = pk2(s[2] * inv - u0[2], s[3] * inv - u0[3]); o.z = pk2(s[4] * inv - u0[4], s[5] * inv - u0[5]); o.w = pk2(s[6] * inv - u0[6], s[7] * inv - u0[7]);
    *(GAS u32x4*)(YP + (size_t)t * POOLW + col) = o;
}
__device__ __forceinline__ void cmp_final_item4(const gfl* PQ, const gfl* PEB, const gfl* w2  , gbf* KC, gbf* VCT, LAS float* hid  , int item, int lane) {
    const int kv = item >> 10, g = (item >> 8) & 3, n0 = (item & 255) * 4;
    float pe[2];
#pragma unroll
    for (int hh = 0; hh < 2; ++hh) { const int j = lane + 64 * hh; pe[hh] = 0.f;
#pragma unroll
        for (int p = 0; p < 8; ++p) pe[hh] += PEB[p * 256 + kv * 128 + j]; }
#pragma unroll
    for (int i = 0; i < 4; ++i) { const int n = n0 + i;
        const gfl* p1 = PQ + ((size_t)kv * 4096 + g * 1024 + n) * 256; const gfl* p2 = p1 + 256 + 128;
#pragma unroll
        for (int hh = 0; hh < 2; ++hh) { const int j = lane + 64 * hh; hid[j * 4 + i] = (n < NCMP) ? gelu_tanh(p1[j] + p2[j] + pe[hh]) : 0.f; } }
    LDS_WAIT(); asm volatile("" ::: "memory");
    const gfl* wp = w2 + (size_t)kv * 128 * 64 + lane;
    float out[4] = {0.f, 0.f, 0.f, 0.f};
#pragma unroll 16
    for (int j = 0; j < 128; ++j) { const float w = wp[j * 64]; const f32x4 h = *(const LAS f32x4*)(hid + 4 * j); out[0] += h.x * w; out[1] += h.y * w; out[2] += h.z * w; out[3] += h.w * w; }
    LDS_WAIT(); asm volatile("" ::: "memory");
    if (kv == 0) {
#pragma unroll
        for (int i = 0; i < 4; ++i) KC[((size_t)g * 1024 + n0 + i) * 64 + lane] = (bf16)f2bf(out[i]);
    } else { u32x2 w; w.x = pk2(out[0], out[1]); w.y = pk2(out[2], out[3]); *(GAS u32x2*)(VCT + ((size_t)g * 64 + lane) * 1024 + n0) = w; }
}

struct Args { const float* in[25]; float* out; unsigned char* ws; int l_lo, l_hi, ph_lo, ph_hi, use_bar, pad; };
enum { I_X = 0, I_MEM, I_RELB, I_LN_MIX_PRE, I_LN_MIX_POST, I_LN_X_PRE, I_LN_X_POST, I_LN_MEM, I_LN_FFN_PRE, I_LN_FFN_POST, I_W_IN, I_CMP_PE, I_CMP_W1, I_CMP_W2, I_W_POOL, I_POOL_SCALE,
       I_W_BR_ATTN, I_W_BR_POOL, I_W_MIX_OUT, I_W_XQ, I_W_XKV, I_W_XO, I_W_GATE, I_W_UP, I_W_DOWN };
constexpr int NPHASE = 17;
constexpr int TR_SCR_STRIDE = 12288, TR_TAB_OFF = 8 * TR_SCR_STRIDE;
__device__ __forceinline__ gby* launder_ptr(gby* p) { asm volatile("" : "+s"(p)); return p; }
__device__ __forceinline__ int launder_int(int v) { asm volatile("" : "+s"(v)); return v; }
template <class T> __device__ __forceinline__ T* uniform_ptr(T* p) { const unsigned long long v = (unsigned long long)p; const unsigned lo = (unsigned)__builtin_amdgcn_readfirstlane((int)(unsigned)v), hi = (unsigned)__builtin_amdgcn_readfirstlane((int)(unsigned)(v >> 32)); return (T*)(((unsigned long long)hi << 32) | lo); }

struct TrCur { const gfl* W; gbf* WT; const gfl* cs; int N, ldk, code, moff, item; };
__device__ __forceinline__ TrCur tr_lookup(const LAS TrDesc* tab, int nd, int it) {
    int d = 0;
#pragma unroll 1
    for (int e = 1; e < nd; ++e) if (tab[e].start <= it) d = e;
    d = __builtin_amdgcn_readfirstlane(d);
    TrCur c; c.W = uniform_ptr(tab[d].W); c.WT = uniform_ptr(tab[d].WT); c.cs = uniform_ptr(tab[d].cs);
    c.N = __builtin_amdgcn_readfirstlane(tab[d].N); c.ldk = __builtin_amdgcn_readfirstlane(tab[d].ldk); c.code = __builtin_amdgcn_readfirstlane(tab[d].code); c.moff = __builtin_amdgcn_readfirstlane(tab[d].moff);
    c.item = it - __builtin_amdgcn_readfirstlane(tab[d].start); return c;
}
__device__ __forceinline__ void tr_run(Frame& F, int nd, int total) {
    const LAS TrDesc* tab = (const LAS TrDesc*)(F.lds + TR_TAB_OFF); LAS float* scr = (LAS float*)(F.lds + F.wave * TR_SCR_STRIDE);
    int it = F.gw;
    if (it >= total) return;
    TrCur A = tr_lookup(tab, nd, it), B = A;
    float wa[32], wb[32], csa, csb; tr_load(wa, csa, A.W, A.N, A.item, F.lane, (A.code & 8) ? (const gfl*)nullptr : A.cs);
#pragma unroll 1
    for (;;) {
        it += F.NGW;
        if (it >= total) { tr_store(wa, csa, A.N, A.WT, A.ldk, scr, A.item, F.lane, A.code & 7, A.moff, (A.code & 8) ? A.cs : (const gfl*)nullptr); break; }
        B = tr_lookup(tab, nd, it); tr_load(wb, csb, B.W, B.N, B.item, F.lane, (B.code & 8) ? (const gfl*)nullptr : B.cs);
        tr_store(wa, csa, A.N, A.WT, A.ldk, scr, A.item, F.lane, A.code & 7, A.moff, (A.code & 8) ? A.cs : (const gfl*)nullptr);
        it += F.NGW;
        if (it >= total) { tr_store(wb, csb, B.N, B.WT, B.ldk, scr, B.item, F.lane, B.code & 7, B.moff, (B.code & 8) ? B.cs : (const gfl*)nullptr); break; }
        A = tr_lookup(tab, nd, it); tr_load(wa, csa, A.W, A.N, A.item, F.lane, (A.code & 8) ? (const gfl*)nullptr : A.cs);
        tr_store(wb, csb, B.N, B.WT, B.ldk, scr, B.item, F.lane, B.code & 7, B.moff, (B.code & 8) ? B.cs : (const gfl*)nullptr);
    }
}
#define TR_PUT(W_, K_, N_, WT_, ldk_, code_, moff_, cs_) do { tab[nd].W = (W_); tab[nd].WT = (WT_); tab[nd].cs = (cs_); tab[nd].K = (K_); tab[nd].N = (N_); tab[nd].ldk = (ldk_); tab[nd].code = (code_); tab[nd].moff = (moff_); \
    tab[nd].start = total; total += ((K_) / 64) * (((N_) + 31) / 32); ++nd; } while (0)

#ifdef MK_TIMING
#define TS0() const unsigned long long ts0_ = __builtin_amdgcn_s_memrealtime()
#define TS1(k) do { const unsigned dt_ = (unsigned)(__builtin_amdgcn_s_memrealtime() - ts0_); if ((MK_T1MASK >> (k)) & 1) tacc1 += dt_; if ((MK_T2MASK >> (k)) & 1) tacc2 += dt_; } while (0)
#else
#define TS0() do {} while (0)
#define TS1(k) do {} while (0)
#endif
#define PHASE_BEGIN() gby* const w_ = launder_ptr(ws_k); const int b_ = launder_int(bid_k); Frame F = F0; \
    { int t_ = launder_int(F0.wave) * 64 + (int)__builtin_amdgcn_mbcnt_hi(~0u, __builtin_amdgcn_mbcnt_lo(~0u, 0u)); asm volatile("" : "+v"(t_)); const int v_ = launder_int(F0.vcu); F.tid = t_; F.lane = t_ & 63; F.wave = __builtin_amdgcn_readfirstlane(t_ >> 6); F.vcu = v_; F.gw = v_ * NWAVES + F.wave; F.ws = w_; }
__global__ void __launch_bounds__(NWAVES * 64, 2) mega_fwd(Args args) {
    extern __shared__ __attribute__((aligned(16))) unsigned char lds_raw[];
    Frame F;
    F.lds = (LAS unsigned char*)lds_raw;
    F.tid = threadIdx.x; F.lane = F.tid & 63; F.wave = __builtin_amdgcn_readfirstlane(F.tid >> 6);
    F.G = gridDim.x; { const int bx = blockIdx.x; F.vcu = (F.G % 8 == 0) ? (bx % 8) * (F.G / 8) + bx / 8 : bx; }
    F.gw = F.vcu * NWAVES + F.wave; F.NGW = F.G * NWAVES; F.ws = (gby*)args.ws;
    gby* const ws = (gby*)args.ws; gby* const ws_k = ws;
#define INP(i) ((const gfl*)args.in[i])
    volatile LAS unsigned* MISC = (volatile LAS unsigned*)(F.lds + MISC_OFF);
    for (int u = F.tid; u < (LDS_BYTES - LDSCTL_OFF) / 4; u += NWAVES * 64) ((LAS unsigned*)(F.lds + LDSCTL_OFF))[u] = 0u;
    __syncthreads();
    XcdBarrier bar; bar.bar = (GAS unsigned*)(ws + WS_CTL) + CW_BAR; bar.x = 0; bar.st = nullptr;
    const bool use_bar = args.use_bar != 0;
    if (use_bar) bar = xcd_barrier_post((GAS unsigned*)(ws + WS_CTL) + CW_BAR, MISC + 8);
#define SEAM() do { if (use_bar) xcd_barrier(bar, F.tid == 0); } while (0)
    const int phmask = (int)(((1u << args.ph_hi) - 1u) & ~((1u << args.ph_lo) - 1u));
#ifndef PHMASK
#define PHMASK 0x1ffff
#endif
#define IN(k) (((PHMASK >> (k)) & 1) && ((launder_int(phmask) >> (k)) & 1))
    gfl* const X = (gfl*)args.out;
    gbf* const H = (gbf*)(ws + WS_H);
    const int bid = (int)blockIdx.x; const int bid_k = bid;
    LAS int* const trn = (LAS int*)(F.lds + TR_TAB_OFF + 32 * 48);
    unsigned tacc1 = 0u, tacc2 = 0u; (void)tacc1; (void)tacc2;

    if (args.l_lo == 0 && IN(0)) { TS0();
        if (F.tid == 0) { LAS TrDesc* tab = (LAS TrDesc*)(F.lds + TR_TAB_OFF); int nd = launder_int(0), total = launder_int(0);
            for (int l = 0; l < NL; ++l) TR_PUT(INP(I_W_XKV) + (size_t)l * DM * 1024, DM, 1024, (gbf*)(ws + WS_WXKV2) + (size_t)l * 1024 * DM, DM, 0, 0, (const gfl*)nullptr);
            trn[0] = nd; trn[1] = total; }
        LDS_WAIT(); __syncthreads();
        tr_run(F, trn[0], trn[1]);
        for (int it = F.gw; it < 4 * NMEM; it += F.NGW) { const int l = it >> 8, r = it & 255;
            rms_row_to_bf16(INP(I_MEM) + (size_t)r * DM, INP(I_LN_MEM) + (size_t)l * DM, (gbf*)(ws + WS_MEMN2) + ((size_t)l * NMEM + r) * DM, F.lane); }
        for (int m = F.gw; m < S_; m += F.NGW) {
            const gfl* xr = INP(I_X) + (size_t)m * DM; gbf* xo = (gbf*)(ws + WS_XB) + (size_t)m * DM;
#pragma unroll
            for (int j = 0; j < 4; ++j) { const int c = F.lane + 64 * j; const f32x4 a = *(const GAS f32x4*)(xr + 8 * c), b = *(const GAS f32x4*)(xr + 8 * c + 4);
                u32x4 w; w.x = pk2(a.x, a.y); w.y = pk2(a.z, a.w); w.z = pk2(b.x, b.y); w.w = pk2(b.z, b.w); *(GAS u32x4*)(xo + 8 * c) = w; }
            rms_row_r(xr, (gfl*)(ws + WS_R) + m, F.lane);
        }
        __syncthreads();
        TS1(0);
    }
    const Frame F0 = F;
    const int l_lo = args.l_lo, l_hi = args.l_hi;

    if (launder_int(l_lo) <= 0 && 0 < launder_int(l_hi)) { constexpr int l = 0;
        if (l == 0 && IN(2)) { PHASE_BEGIN(); TS0();
            if (F.tid == 0) { LAS TrDesc* tab = (LAS TrDesc*)(F.lds + TR_TAB_OFF); int nd = launder_int(0), total = launder_int(0); const gfl* nul = nullptr;
                TR_PUT(INP(I_W_IN) + (size_t)l * DM * INW, DM, INW, (gbf*)(w_ + WS_WIN), DM, 1 | 8, 0, INP(I_LN_MIX_PRE) + (size_t)l * DM);
                for (int q = 0; q < 4; ++q) { const int kv = q >> 1, half = q & 1;
                    TR_PUT(INP(I_CMP_W1) + (((size_t)l * 2 + kv) * 2048 + half * 1024) * 128, 1024, 128, (gbf*)(w_ + WS_WC1) + (size_t)kv * 256 * 1024, 1024, 0, half * 128, nul); }
                for (int gi = 0; gi < 4; ++gi)
                    TR_PUT(INP(I_W_POOL) + ((size_t)l * 4 + gi) * 65536, 256, 256, (gbf*)(w_ + WS_WPOOL) + (size_t)gi * 65536, 256, 0, 0, INP(I_POOL_SCALE) + (size_t)l * POOLW + gi * 256);
                trn[0] = nd; trn[1] = total; }
            LDS_WAIT(); __syncthreads();
            if (F.gw < 32) {
                const int p = F.gw >> 2, kv = (F.gw >> 1) & 1, j = (F.gw & 1) * 64 + F.lane;
                const gfl* pe = INP(I_CMP_PE) + ((size_t)l * 2 + kv) * 2048 + p * 256; const gfl* w1 = INP(I_CMP_W1) + (((size_t)l * 2 + kv) * 2048 + p * 256) * 128 + j;
                float a = 0.f;
#pragma unroll 32
                for (int k = 0; k < 256; ++k) a += pe[k] * w1[(size_t)k * 128];
                ((gfl*)(w_ + WS_PEB))[p * 256 + kv * 128 + j] = a;
            }
            tr_run(F, trn[0], trn[1]);
            __syncthreads();
            SEAM(); TS1(2);
        }
        if (IN(3)) { PHASE_BEGIN(); TS0();
            pg8::Sched<S_ / 256, ZN / 256, 1, false> S; S.init(F.G, b_);
            EpiZ E{w_};
            pg8::gemm_phase<DM, DM, DM, 0, 0>(F.lds, F.tid, (const gbf*)(w_ + WS_XB), (const gbf*)(w_ + WS_WIN), S, E);
            const int c3 = ((S_ / 256) * (ZN / 256)) % F.G;
            if (b_ >= c3) {
                __syncthreads();
                if (F.tid == 0) { LAS TrDesc* tab = (LAS TrDesc*)(F.lds + TR_TAB_OFF); int nd = launder_int(0), total = launder_int(0); const gfl* nul = nullptr;
                    TR_PUT(INP(I_W_BR_ATTN) + (size_t)l * NSAW * DM, NSAW, DM, (gbf*)(w_ + WS_WBRA), NSAW, 0, 0, nul);
                    TR_PUT(INP(I_W_BR_POOL) + (size_t)l * POOLW * DM, POOLW, DM, (gbf*)(w_ + WS_WBRP), POOLW, 0, 0, nul);
                    TR_PUT(INP(I_W_MIX_OUT) + (size_t)l * DM * DM, DM, DM, (gbf*)(w_ + WS_WMIX), DM, 0, 0, nul);
                    TR_PUT(INP(I_W_XQ) + (size_t)l * DM * XW, DM, XW, (gbf*)(w_ + WS_WXQ), DM, 0 | 8, 0, INP(I_LN_X_PRE) + (size_t)l * DM);
                    TR_PUT(INP(I_W_XO) + (size_t)l * XW * DM, XW, DM, (gbf*)(w_ + WS_WXO), XW, 0, 0, nul);
                    trn[0] = nd; trn[1] = total; }
                LDS_WAIT(); __syncthreads();
                Frame F2 = F; F2.gw = (b_ - c3) * NWAVES + F.wave; F2.NGW = (F.G - c3) * NWAVES;
                tr_run(F2, trn[0], trn[1]);
                __syncthreads();
            }
            SEAM(); TS1(3);
        }
        if (IN(4)) { PHASE_BEGIN(); TS0();
            if (F.G <= 64) {
#pragma unroll 1
                for (int it = F.gw; it < 2 * S_; it += F.NGW) pool_item((const gbf*)(w_ + WS_U), (gbf*)(w_ + WS_YP), it, F.lane);
                __syncthreads();
            } else if (b_ >= 32) {
#pragma unroll 1
                for (int it = (b_ - 32) * NWAVES + F.wave; it < 2 * S_; it += (F.G - 32) * NWAVES) pool_item((const gbf*)(w_ + WS_U), (gbf*)(w_ + WS_YP), it, F.lane);
                if (F.tid == 0) { LAS TrDesc* tab = (LAS TrDesc*)(F.lds + TR_TAB_OFF); int nd = launder_int(0), total = launder_int(0); const gfl* nul = nullptr;
                    TR_PUT(INP(I_W_DOWN) + ((size_t)l * DFF + DFF / 2) * DM, DFF / 2, DM, (gbf*)(w_ + WS_WDN) + DFF / 2, DFF, 0, 0, nul);
                    trn[0] = nd; trn[1] = total; }
                LDS_WAIT(); __syncthreads();
                Frame F2 = F; F2.gw = (b_ - 32) * NWAVES + F.wave; F2.NGW = (F.G - 32) * NWAVES;
                tr_run(F2, trn[0], trn[1]);
                __syncthreads();
            }
            pg8::Sched<16, 1, 2, false> S; S.init(F.G, b_);
            EpiF32 E{(gfl*)(w_ + WS_PQ), 256, (size_t)4096 * 256};
            pg8::gemm_phase<1024, 1024, 1024, (long)(WS_VCR - WS_KCR) / 2, (long)256 * 1024>(F.lds, F.tid, (const gbf*)(w_ + WS_KCR), (const gbf*)(w_ + WS_WC1), S, E);
            SEAM(); TS1(4);
        }
        if (IN(5)) { PHASE_BEGIN(); TS0();
            LAS float* hid = (LAS float*)(F.lds + F.wave * 2048);
#pragma unroll 1
            for (int it = F.gw; it < 2048; it += F.NGW) cmp_final_item4((const gfl*)(w_ + WS_PQ), (const gfl*)(w_ + WS_PEB), INP(I_CMP_W2) + (size_t)l * 2 * 128 * 64, (gbf*)(w_ + WS_KC), (gbf*)(w_ + WS_VCT), hid, it, F.lane);
            __syncthreads();
            pg8::Sched<S_ / 256, 1, 4, false> S; S.init(F.G, b_);
            EpiBf16 E{(gbf*)(w_ + WS_P), POOLW, 256, 1.f};
            pg8::gemm_phase<POOLW, 256, 256, 256, 65536>(F.lds, F.tid, (const gbf*)(w_ + WS_YP), (const gbf*)(w_ + WS_WPOOL), S, E);
            SEAM(); TS1(5);
        }
        if (IN(6)) { PHASE_BEGIN(); TS0();
            attn_setup_tables(F, INP(I_RELB));
            const AttnPtrs P{(const gbf*)(w_ + WS_Q), (const gbf*)(w_ + WS_KC), (const gbf*)(w_ + WS_VCT), (const gbf*)(w_ + WS_KSEL), (const gbf*)(w_ + WS_VSELT), (const gbf*)(w_ + WS_KWIN), (const gbf*)(w_ + WS_VWINT),
                             (const gfl*)(w_ + WS_GL), (gbf*)(w_ + WS_A)};
#ifdef MK_CMP_ATT
            {
                gbf* A2 = (gbf*)(w_ + WS_YP);
#pragma unroll 1
                for (int it = F.gw; it < (S_ / 4) * NGRP; it += F.NGW) nsa_unit_v1(F, P, it >> 2, it & 3);
                __syncthreads();
                const AttnPtrs P2{P.Q, P.KC, P.VCT, P.KSEL, P.VSELT, P.KWIN, P.VWINT, P.GL, A2};
#pragma unroll 1
                for (int u = b_; u < (S_ / 64) * NGRP; u += F.G) { const int c = u & 255, r = u >> 8; nsa_unit_v2(F, P2, (r < 2) ? 255 - (c >> 1) : (c >> 1), (c & 1) * 2 + (r & 1)); }
                __syncthreads();
                SEAM();
                GAS unsigned* dbg = (GAS unsigned*)(w_ + WS_CTL) + 64;
                float mx = 0.f; unsigned mi = 0u;
                for (unsigned i = (unsigned)b_ * 512u + (unsigned)F.tid; i < (unsigned)S_ * NSAW; i += (unsigned)F.G * 512u) { const float d = fabsf(bf2f(P.A[i]) - bf2f(A2[i])); if (d > mx) { mx = d; mi = i; } }
                if (MK_CMP_ATT == 7 || MK_CMP_ATT == 8) { mx = 0.f; mi = 0u; const GAS float* i1 = (const GAS float*)(w_ + WS_END + 16 * MiB); const GAS float* i2 = (const GAS float*)(w_ + WS_END + 96 * MiB);
                    for (unsigned i = (unsigned)b_ * 512u + (unsigned)F.tid; i < (unsigned)S_ * 4 * 256; i += (unsigned)F.G * 512u) { const int j = i & 255, t = i >> 10, cur = t >> 6; if (cur >= 16 && j >= 1 && j <= cur - 2) { const float d = fabsf(i1[i] - i2[i]) / (MK_CMP_ATT == 8 ? fmaxf(fabsf(i1[i]), 1e-12f) : 1.f); if (d > mx) { mx = d; mi = i; } } } }
                if (MK_CMP_ATT == 12 || MK_CMP_ATT == 13) { unsigned cnt = 0u; const GAS unsigned* sm = (const GAS unsigned*)(w_ + WS_END + (MK_CMP_ATT == 12 ? 400 : 404) * MiB); const GAS float* im = (const GAS float*)(w_ + WS_END + 16 * MiB);
                    for (unsigned i = (unsigned)b_ * 512u + (unsigned)F.tid; i < (unsigned)S_ * 4; i += (unsigned)F.G * 512u) { const int t = i >> 2, cur = t >> 6; if (cur < 16) continue;
                        float mins = 1e30f, maxu = -1.f;
                        for (int j = 1; j <= cur - 2; ++j) { const float v = im[(size_t)i * 256 + j]; const bool s = (sm[i * 8 + (j >> 5)] >> (j & 31)) & 1u; if (s) mins = fminf(mins, v); else maxu = fmaxf(maxu, v); }
                        if (mins < maxu) ++cnt; }
                    (void)__hip_atomic_fetch_add(dbg + 192, cnt, __ATOMIC_RELAXED, __HIP_MEMORY_SCOPE_AGENT); }
                if (MK_CMP_ATT == 9 || MK_CMP_ATT == 10 || MK_CMP_ATT == 11) { unsigned cnt = 0u; const GAS unsigned* s1 = (const GAS unsigned*)(w_ + WS_END + 400 * MiB); const GAS unsigned* s2 = (const GAS unsigned*)(w_ + WS_END + 404 * MiB);
                    for (unsigned i = (unsigned)b_ * 512u + (unsigned)F.tid; i < (unsigned)S_ * 4; i += (unsigned)F.G * 512u) { unsigned x = 0u; bool df = false; for (int w = 0; w < 8; ++w) { df |= (s1[i * 8 + w] != s2[i * 8 + w]); x += __builtin_popcount(MK_CMP_ATT == 10 ? s1[i * 8 + w] : s2[i * 8 + w]); } cnt += (MK_CMP_ATT == 9) ? (df ? 1u : 0u) : x; }
                    (void)__hip_atomic_fetch_add(dbg + 192, cnt, __ATOMIC_RELAXED, __HIP_MEMORY_SCOPE_AGENT); }
                if (MK_CMP_ATT == 5) { unsigned cnt = 0u; const GAS unsigned* s1 = (const GAS unsigned*)(w_ + WS_END + 400 * MiB); const GAS unsigned* s2 = (const GAS unsigned*)(w_ + WS_END + 404 * MiB);
                    for (unsigned i = (unsigned)b_ * 512u + (unsigned)F.tid; i < (unsigned)S_ * 4; i += (unsigned)F.G * 512u) { bool df = false; for (int w = 0; w < 8; ++w) df |= (s1[i * 8 + w] != s2[i * 8 + w]); if (df) ++cnt; }
                    (void)__hip_atomic_fetch_add(dbg + 128, cnt, __ATOMIC_RELAXED, __HIP_MEMORY_SCOPE_AGENT); }
                if (MK_CMP_ATT == 6) { unsigned cnt = 0u; const GAS unsigned* s1 = (const GAS unsigned*)(w_ + WS_END + 400 * MiB); const GAS unsigned* s2 = (const GAS unsigned*)(w_ + WS_END + 404 * MiB);
                    for (unsigned i = (unsigned)b_ * 512u + (unsigned)F.tid; i < (unsigned)S_ * 4; i += (unsigned)F.G * 512u) { for (int w = 0; w < 8; ++w) cnt += __builtin_popcount(s1[i * 8 + w] ^ s2[i * 8 + w]); }
                    (void)__hip_atomic_fetch_add(dbg + 128, cnt, __ATOMIC_RELAXED, __HIP_MEMORY_SCOPE_AGENT); }
                if (MK_CMP_ATT >= 4) { unsigned cnt = 0u; for (unsigned i = (unsigned)b_ * 512u + (unsigned)F.tid; i < (unsigned)S_ * NSAW; i += (unsigned)F.G * 512u) { const float d = fabsf(bf2f(P.A[i]) - bf2f(A2[i])); if (d > 0.02f) ++cnt; } (void)__hip_atomic_fetch_add(dbg + 128, cnt, __ATOMIC_RELAXED, __HIP_MEMORY_SCOPE_AGENT); }
                (void)__hip_atomic_fetch_max(dbg, __builtin_bit_cast(unsigned, mx), __ATOMIC_RELAXED, __HIP_MEMORY_SCOPE_AGENT);
                SEAM();
                const unsigned gm = __hip_atomic_load(dbg, __ATOMIC_RELAXED, __HIP_MEMORY_SCOPE_AGENT);
                if (__builtin_bit_cast(unsigned, mx) == gm && mx > 0.f) __hip_atomic_store(dbg + 64, mi, __ATOMIC_RELAXED, __HIP_MEMORY_SCOPE_AGENT);
                SEAM();
                const unsigned gi = __hip_atomic_load(dbg + 64, __ATOMIC_RELAXED, __HIP_MEMORY_SCOPE_AGENT);
                const float val = (MK_CMP_ATT >= 9) ? 1000.f + (float)__hip_atomic_load(dbg + 192, __ATOMIC_RELAXED, __HIP_MEMORY_SCOPE_AGENT) : (MK_CMP_ATT == 7 || MK_CMP_ATT == 8) ? 1e5f * __builtin_bit_cast(float, gm) : (MK_CMP_ATT >= 4) ? 1000.f + (float)__hip_atomic_load(dbg + 128, __ATOMIC_RELAXED, __HIP_MEMORY_SCOPE_AGENT) : (MK_CMP_ATT == 1) ? 1e5f * __builtin_bit_cast(float, gm) : (MK_CMP_ATT == 2) ? 1000.f + (float)(gi / NSAW) : 1000.f + (float)(gi % NSAW);
                for (size_t i = (size_t)b_ * 512 + F.tid; i < (size_t)S_ * DM; i += (size_t)F.G * 512) X[i] = val;
                return;
            }
#endif
            {
                GAS unsigned* ctr = (GAS unsigned*)(w_ + WS_CTL) + 8192 + 64 * l;
                volatile LAS unsigned* bw = (volatile LAS unsigned*)(F.lds + MISC_OFF) + 4;
#pragma unroll 1
                for (;;) {
                    if (F.tid == 0) bw[0] = __hip_atomic_fetch_add(ctr, 1u, __ATOMIC_RELAXED, __HIP_MEMORY_SCOPE_AGENT);
                    __syncthreads();
                    const int u = __builtin_amdgcn_readfirstlane((int)bw[0]);
                    __syncthreads();
                    if (u >= (S_ / 64) * NGRP) break;
                    nsa_unit_v2(F, P, 255 - (u >> 2), u & 3);
                }
            }
            __syncthreads();
            SEAM(); TS1(6);
        }
        if (IN(7)) { PHASE_BEGIN(); TS0();
            pg8::Sched<S_ / 256, DM / 256, 2, true> S; S.init(F.G, b_);
            EpiMerge E{(gbf*)(w_ + WS_Y1), (const gbf*)(w_ + WS_MG)};
            pg8::gemm_phase<NSAW, NSAW, NSAW, (long)(WS_P - WS_A) / 2, (long)(WS_WBRP - WS_WBRA) / 2>(F.lds, F.tid, (const gbf*)(w_ + WS_A), (const gbf*)(w_ + WS_WBRA), S, E);
            SEAM(); TS1(7);
        }
        if (IN(8)) { PHASE_BEGIN(); TS0();
            pg8::SchedPanel<S_ / 256> S; S.init(F.G, b_);
            EpiBf16 E{(gbf*)(w_ + WS_Y2), DM, 0, 1.f};
            pg8::gemm_phase<DM, DM, DM, 0, 0>(F.lds, F.tid, (const gbf*)(w_ + WS_Y1), (const gbf*)(w_ + WS_WMIX), S, E);
            SEAM(); TS1(8);
        }
        if (IN(9)) { PHASE_BEGIN(); TS0();
#pragma unroll 1
            for (int m = F.gw; m < S_; m += F.NGW) resid_row((const gbf*)(w_ + WS_XB) + (size_t)m * DM, (gbf*)(w_ + WS_XB) + (size_t)m * DM, (gfl*)nullptr, (const gbf*)(w_ + WS_Y2) + (size_t)m * DM, INP(I_LN_MIX_POST) + (size_t)l * DM, (gfl*)(w_ + WS_R) + m, F.lane);
            SEAM(); TS1(9);
        }
        if (IN(10)) { PHASE_BEGIN(); TS0();
            pg8::Sched<S_ / 256, XW / 256, 1, false> S; S.init(F.G, b_);
            EpiBf16 E{(gbf*)(w_ + WS_Q2), XW, 0, 1.f, (const gfl*)(w_ + WS_R)};
            pg8::gemm_phase<DM, DM, DM, 0, 0>(F.lds, F.tid, (const gbf*)(w_ + WS_XB), (const gbf*)(w_ + WS_WXQ), S, E);
            if (l == 0 && b_ >= 128) {
                pg8::Sched<1, 4, 4, false> S2; S2.init(F.G - 128, b_ - 128);
                EpiKVmem E2{(gbf*)(w_ + WS_KM), (gbf*)(w_ + WS_VMT)};
                pg8::gemm_phase<DM, DM, DM, (long)NMEM * DM, (long)1024 * DM>(F.lds, F.tid, (const gbf*)(w_ + WS_MEMN2), (const gbf*)(w_ + WS_WXKV2), S2, E2);
            }
            const int c10 = F.G > 144 ? (l == 0 ? 144 : 128) : 0;
            if (b_ >= c10) {
                __syncthreads();
                if (F.tid == 0) { LAS TrDesc* tab = (LAS TrDesc*)(F.lds + TR_TAB_OFF); int nd = launder_int(0), total = launder_int(0); const gfl* nul = nullptr;
                    TR_PUT(INP(I_W_GATE) + (size_t)l * DM * DFF, DM, DFF, (gbf*)(w_ + WS_WGU), DM, 2 | 8, 0, INP(I_LN_FFN_PRE) + (size_t)l * DM);
                    TR_PUT(INP(I_W_UP) + (size_t)l * DM * DFF, DM, DFF, (gbf*)(w_ + WS_WGU), DM, 2 | 8, 128, INP(I_LN_FFN_PRE) + (size_t)l * DM);
                    TR_PUT(INP(I_W_DOWN) + (size_t)l * DFF * DM, (F.G > 64) ? DFF / 2 : DFF, DM, (gbf*)(w_ + WS_WDN), DFF, 0, 0, nul);
                    trn[0] = nd; trn[1] = total; }
                LDS_WAIT(); __syncthreads();
                Frame F2 = F; F2.gw = (b_ - c10) * NWAVES + F.wave; F2.NGW = (F.G - c10) * NWAVES;
                tr_run(F2, trn[0], trn[1]);
                __syncthreads();
            }
            SEAM(); TS1(10);
        }
        if (IN(11)) { PHASE_BEGIN(); TS0();
#pragma unroll 1
            for (int u = b_; u < (S_ / 256) * 4; u += F.G) xattn_unit_v2(F, (const gbf*)(w_ + WS_Q2), (const gbf*)(w_ + WS_KM) + (size_t)l * NMEM * XW, (const gbf*)(w_ + WS_VMT) + (size_t)l * XW * NMEM, (gbf*)(w_ + WS_O2), u >> 2, u & 3);
            SEAM(); TS1(11);
        }
        if (IN(12)) { PHASE_BEGIN(); TS0();
            pg8::SchedPanel<S_ / 256> S; S.init(F.G, b_);
            EpiBf16 E{(gbf*)(w_ + WS_Y2), DM, 0, 1.f};
            pg8::gemm_phase<XW, XW, XW, 0, 0>(F.lds, F.tid, (const gbf*)(w_ + WS_O2), (const gbf*)(w_ + WS_WXO), S, E);
            SEAM(); TS1(12);
        }
        if (IN(13)) { PHASE_BEGIN(); TS0();
#pragma unroll 1
            for (int m = F.gw; m < S_; m += F.NGW) resid_row((const gbf*)(w_ + WS_XB) + (size_t)m * DM, (gbf*)(w_ + WS_XB) + (size_t)m * DM, (gfl*)nullptr, (const gbf*)(w_ + WS_Y2) + (size_t)m * DM, INP(I_LN_X_POST) + (size_t)l * DM, (gfl*)(w_ + WS_R) + m, F.lane);
            SEAM(); TS1(13);
        }
        if (IN(14)) { PHASE_BEGIN(); TS0();
            pg8::Sched<S_ / 256, 2 * DFF / 256, 1, false> S; S.init(F.G, b_);
            EpiSwiGLU E{(gbf*)(w_ + WS_HID), (const gfl*)(w_ + WS_R)};
            pg8::gemm_phase<DM, DM, DM, 0, 0>(F.lds, F.tid, (const gbf*)(w_ + WS_XB), (const gbf*)(w_ + WS_WGU), S, E);
            SEAM(); TS1(14);
        }
        if (IN(15)) { PHASE_BEGIN(); TS0();
            pg8::SchedPanel<S_ / 256> S; S.init(F.G, b_);
            EpiBf16 E{(gbf*)(w_ + WS_Y2), DM, 0, 1.f};
            pg8::gemm_phase<DFF, DFF, DFF, 0, 0>(F.lds, F.tid, (const gbf*)(w_ + WS_HID), (const gbf*)(w_ + WS_WDN), S, E);
            SEAM(); TS1(15);
        }
        if (IN(16)) { PHASE_BEGIN(); TS0();
#pragma unroll 1
            for (int m = F.gw; m < S_; m += F.NGW) resid_row((const gbf*)(w_ + WS_XB) + (size_t)m * DM, (gbf*)(w_ + WS_XB) + (size_t)m * DM, (l + 1 < NL) ? (gfl*)nullptr : X + (size_t)m * DM, (const gbf*)(w_ + WS_Y2) + (size_t)m * DM, INP(I_LN_FFN_POST) + (size_t)l * DM, (l + 1 < NL) ? (gfl*)(w_ + WS_R) + m : (gfl*)nullptr, F.lane);
            if (l + 1 < NL) {
                __syncthreads();
            if (F.tid == 0) { LAS TrDesc* tab = (LAS TrDesc*)(F.lds + TR_TAB_OFF); int nd = launder_int(0), total = launder_int(0); const gfl* nul = nullptr;
                TR_PUT(INP(I_W_IN) + (size_t)(l + 1) * DM * INW, DM, INW, (gbf*)(w_ + WS_WIN), DM, 1 | 8, 0, INP(I_LN_MIX_PRE) + (size_t)(l + 1) * DM);
                for (int q = 0; q < 4; ++q) { const int kv = q >> 1, half = q & 1;
                    TR_PUT(INP(I_CMP_W1) + (((size_t)(l + 1) * 2 + kv) * 2048 + half * 1024) * 128, 1024, 128, (gbf*)(w_ + WS_WC1) + (size_t)kv * 256 * 1024, 1024, 0, half * 128, nul); }
                for (int gi = 0; gi < 4; ++gi)
                    TR_PUT(INP(I_W_POOL) + ((size_t)(l + 1) * 4 + gi) * 65536, 256, 256, (gbf*)(w_ + WS_WPOOL) + (size_t)gi * 65536, 256, 0, 0, INP(I_POOL_SCALE) + (size_t)(l + 1) * POOLW + gi * 256);
                trn[0] = nd; trn[1] = total; }
            LDS_WAIT(); __syncthreads();
            if (F.gw < 32) {
                const int p = F.gw >> 2, kv = (F.gw >> 1) & 1, j = (F.gw & 1) * 64 + F.lane;
                const gfl* pe = INP(I_CMP_PE) + ((size_t)(l + 1) * 2 + kv) * 2048 + p * 256; const gfl* w1 = INP(I_CMP_W1) + (((size_t)(l + 1) * 2 + kv) * 2048 + p * 256) * 128 + j;
                float a = 0.f;
#pragma unroll 32
                for (int k = 0; k < 256; ++k) a += pe[k] * w1[(size_t)k * 128];
                ((gfl*)(w_ + WS_PEB))[p * 256 + kv * 128 + j] = a;
            }
            tr_run(F, trn[0], trn[1]);
            __syncthreads();
            }
            if (l + 1 < launder_int(l_hi)) SEAM(); TS1(16);
        }
    }

    if (launder_int(l_lo) <= 1 && 1 < launder_int(l_hi)) { constexpr int l = 1;
        if (l == 0 && IN(2)) { PHASE_BEGIN(); TS0();
            if (F.tid == 0) { LAS TrDesc* tab = (LAS TrDesc*)(F.lds + TR_TAB_OFF); int nd = launder_int(0), total = launder_int(0); const gfl* nul = nullptr;
                TR_PUT(INP(I_W_IN) + (size_t)l * DM * INW, DM, INW, (gbf*)(w_ + WS_WIN), DM, 1 | 8, 0, INP(I_LN_MIX_PRE) + (size_t)l * DM);
                for (int q = 0; q < 4; ++q) { const int kv = q >> 1, half = q & 1;
                    TR_PUT(INP(I_CMP_W1) + (((size_t)l * 2 + kv) * 2048 + half * 1024) * 128, 1024, 128, (gbf*)(w_ + WS_WC1) + (size_t)kv * 256 * 1024, 1024, 0, half * 128, nul); }
                for (int gi = 0; gi < 4; ++gi)
                    TR_PUT(INP(I_W_POOL) + ((size_t)l * 4 + gi) * 65536, 256, 256, (gbf*)(w_ + WS_WPOOL) + (size_t)gi * 65536, 256, 0, 0, INP(I_POOL_SCALE) + (size_t)l * POOLW + gi * 256);
                trn[0] = nd; trn[1] = total; }
            LDS_WAIT(); __syncthreads();
            if (F.gw < 32) {
                const int p = F.gw >> 2, kv = (F.gw >> 1) & 1, j = (F.gw & 1) * 64 + F.lane;
                const gfl* pe = INP(I_CMP_PE) + ((size_t)l * 2 + kv) * 2048 + p * 256; const gfl* w1 = INP(I_CMP_W1) + (((size_t)l * 2 + kv) * 2048 + p * 256) * 128 + j;
                float a = 0.f;
#pragma unroll 32
                for (int k = 0; k < 256; ++k) a += pe[k] * w1[(size_t)k * 128];
                ((gfl*)(w_ + WS_PEB))[p * 256 + kv * 128 + j] = a;
            }
            tr_run(F, trn[0], trn[1]);
            __syncthreads();
            SEAM(); TS1(2);
        }
        if (IN(3)) { PHASE_BEGIN(); TS0();
            pg8::Sched<S_ / 256, ZN / 256, 1, false> S; S.init(F.G, b_);
            EpiZ E{w_};
            pg8::gemm_phase<DM, DM, DM, 0, 0>(F.lds, F.tid, (const gbf*)(w_ + WS_XB), (const gbf*)(w_ + WS_WIN), S, E);
            const int c3 = ((S_ / 256) * (ZN / 256)) % F.G;
            if (b_ >= c3) {
                __syncthreads();
                if (F.tid == 0) { LAS TrDesc* tab = (LAS TrDesc*)(F.lds + TR_TAB_OFF); int nd = launder_int(0), total = launder_int(0); const gfl* nul = nullptr;
                    TR_PUT(INP(I_W_BR_ATTN) + (size_t)l * NSAW * DM, NSAW, DM, (gbf*)(w_ + WS_WBRA), NSAW, 0, 0, nul);
                    TR_PUT(INP(I_W_BR_POOL) + (size_t)l * POOLW * DM, POOLW, DM, (gbf*)(w_ + WS_WBRP), POOLW, 0, 0, nul);
                    TR_PUT(INP(I_W_MIX_OUT) + (size_t)l * DM * DM, DM, DM, (gbf*)(w_ + WS_WMIX), DM, 0, 0, nul);
                    TR_PUT(INP(I_W_XQ) + (size_t)l * DM * XW, DM, XW, (gbf*)(w_ + WS_WXQ), DM, 0 | 8, 0, INP(I_LN_X_PRE) + (size_t)l * DM);
                    TR_PUT(INP(I_W_XO) + (size_t)l * XW * DM, XW, DM, (gbf*)(w_ + WS_WXO), XW, 0, 0, nul);
                    trn[0] = nd; trn[1] = total; }
                LDS_WAIT(); __syncthreads();
                Frame F2 = F; F2.gw = (b_ - c3) * NWAVES + F.wave; F2.NGW = (F.G - c3) * NWAVES;
                tr_run(F2, trn[0], trn[1]);
                __syncthreads();
            }
            SEAM(); TS1(3);
        }
        if (IN(4)) { PHASE_BEGIN(); TS0();
            if (F.G <= 64) {
#pragma unroll 1
                for (int it = F.gw; it < 2 * S_; it += F.NGW) pool_item((const gbf*)(w_ + WS_U), (gbf*)(w_ + WS_YP), it, F.lane);
                __syncthreads();
            } else if (b_ >= 32) {
#pragma unroll 1
                for (int it = (b_ - 32) * NWAVES + F.wave; it < 2 * S_; it += (F.G - 32) * NWAVES) pool_item((const gbf*)(w_ + WS_U), (gbf*)(w_ + WS_YP), it, F.lane);
                if (F.tid == 0) { LAS TrDesc* tab = (LAS TrDesc*)(F.lds + TR_TAB_OFF); int nd = launder_int(0), total = launder_int(0); const gfl* nul = nullptr;
                    TR_PUT(INP(I_W_DOWN) + ((size_t)l * DFF + DFF / 2) * DM, DFF / 2, DM, (gbf*)(w_ + WS_WDN) + DFF / 2, DFF, 0, 0, nul);
                    trn[0] = nd; trn[1] = total; }
                LDS_WAIT(); __syncthreads();
                Frame F2 = F; F2.gw = (b_ - 32) * NWAVES + F.wave; F2.NGW = (F.G - 32) * NWAVES;
                tr_run(F2, trn[0], trn[1]);
                __syncthreads();
            }
            pg8::Sched<16, 1, 2, false> S; S.init(F.G, b_);
            EpiF32 E{(gfl*)(w_ + WS_PQ), 256, (size_t)4096 * 256};
            pg8::gemm_phase<1024, 1024, 1024, (long)(WS_VCR - WS_KCR) / 2, (long)256 * 1024>(F.lds, F.tid, (const gbf*)(w_ + WS_KCR), (const gbf*)(w_ + WS_WC1), S, E);
            SEAM(); TS1(4);
        }
        if (IN(5)) { PHASE_BEGIN(); TS0();
            LAS float* hid = (LAS float*)(F.lds + F.wave * 2048);
#pragma unroll 1
            for (int it = F.gw; it < 2048; it += F.NGW) cmp_final_item4((const gfl*)(w_ + WS_PQ), (const gfl*)(w_ + WS_PEB), INP(I_CMP_W2) + (size_t)l * 2 * 128 * 64, (gbf*)(w_ + WS_KC), (gbf*)(w_ + WS_VCT), hid, it, F.lane);
            __syncthreads();
            pg8::Sched<S_ / 256, 1, 4, false> S; S.init(F.G, b_);
            EpiBf16 E{(gbf*)(w_ + WS_P), POOLW, 256, 1.f};
            pg8::gemm_phase<POOLW, 256, 256, 256, 65536>(F.lds, F.tid, (const gbf*)(w_ + WS_YP), (const gbf*)(w_ + WS_WPOOL), S, E);
            SEAM(); TS1(5);
        }
        if (IN(6)) { PHASE_BEGIN(); TS0();
            attn_setup_tables(F, INP(I_RELB));
            const AttnPtrs P{(const gbf*)(w_ + WS_Q), (const gbf*)(w_ + WS_KC), (const gbf*)(w_ + WS_VCT), (const gbf*)(w_ + WS_KSEL), (const gbf*)(w_ + WS_VSELT), (const gbf*)(w_ + WS_KWIN), (const gbf*)(w_ + WS_VWINT),
                             (const gfl*)(w_ + WS_GL), (gbf*)(w_ + WS_A)};
#ifdef MK_CMP_ATT
            {
                gbf* A2 = (gbf*)(w_ + WS_YP);
#pragma unroll 1
                for (int it = F.gw; it < (S_ / 4) * NGRP; it += F.NGW) nsa_unit_v1(F, P, it >> 2, it & 3);
                __syncthreads();
                const AttnPtrs P2{P.Q, P.KC, P.VCT, P.KSEL, P.VSELT, P.KWIN, P.VWINT, P.GL, A2};
#pragma unroll 1
                for (int u = b_; u < (S_ / 64) * NGRP; u += F.G) { const int c = u & 255, r = u >> 8; nsa_unit_v2(F, P2, (r < 2) ? 255 - (c >> 1) : (c >> 1), (c & 1) * 2 + (r & 1)); }
                __syncthreads();
                SEAM();
                GAS unsigned* dbg = (GAS unsigned*)(w_ + WS_CTL) + 64;
                float mx = 0.f; unsigned mi = 0u;
                for (unsigned i = (unsigned)b_ * 512u + (unsigned)F.tid; i < (unsigned)S_ * NSAW; i += (unsigned)F.G * 512u) { const float d = fabsf(bf2f(P.A[i]) - bf2f(A2[i])); if (d > mx) { mx = d; mi = i; } }
                if (MK_CMP_ATT == 7 || MK_CMP_ATT == 8) { mx = 0.f; mi = 0u; const GAS float* i1 = (const GAS float*)(w_ + WS_END + 16 * MiB); const GAS float* i2 = (const GAS float*)(w_ + WS_END + 96 * MiB);
                    for (unsigned i = (unsigned)b_ * 512u + (unsigned)F.tid; i < (unsigned)S_ * 4 * 256; i += (unsigned)F.G * 512u) { const int j = i & 255, t = i >> 10, cur = t >> 6; if (cur >= 16 && j >= 1 && j <= cur - 2) { const float d = fabsf(i1[i] - i2[i]) / (MK_CMP_ATT == 8 ? fmaxf(fabsf(i1[i]), 1e-12f) : 1.f); if (d > mx) { mx = d; mi = i; } } } }
                if (MK_CMP_ATT == 12 || MK_CMP_ATT == 13) { unsigned cnt = 0u; const GAS unsigned* sm = (const GAS unsigned*)(w_ + WS_END + (MK_CMP_ATT == 12 ? 400 : 404) * MiB); const GAS float* im = (const GAS float*)(w_ + WS_END + 16 * MiB);
                    for (unsigned i = (unsigned)b_ * 512u + (unsigned)F.tid; i < (unsigned)S_ * 4; i += (unsigned)F.G * 512u) { const int t = i >> 2, cur = t >> 6; if (cur < 16) continue;
                        float mins = 1e30f, maxu = -1.f;
                        for (int j = 1; j <= cur - 2; ++j) { const float v = im[(size_t)i * 256 + j]; const bool s = (sm[i * 8 + (j >> 5)] >> (j & 31)) & 1u; if (s) mins = fminf(mins, v); else maxu = fmaxf(maxu, v); }
                        if (mins < maxu) ++cnt; }
                    (void)__hip_atomic_fetch_add(dbg + 192, cnt, __ATOMIC_RELAXED, __HIP_MEMORY_SCOPE_AGENT); }
                if (MK_CMP_ATT == 9 || MK_CMP_ATT == 10 || MK_CMP_ATT == 11) { unsigned cnt = 0u; const GAS unsigned* s1 = (const GAS unsigned*)(w_ + WS_END + 400 * MiB); const GAS unsigned* s2 = (const GAS unsigned*)(w_ + WS_END + 404 * MiB);
                    for (unsigned i = (unsigned)b_ * 512u + (unsigned)F.tid; i < (unsigned)S_ * 4; i += (unsigned)F.G * 512u) { unsigned x = 0u; bool df = false; for (int w = 0; w < 8; ++w) { df |= (s1[i * 8 + w] != s2[i * 8 + w]); x += __builtin_popcount(MK_CMP_ATT == 10 ? s1[i * 8 + w] : s2[i * 8 + w]); } cnt += (MK_CMP_ATT == 9) ? (df ? 1u : 0u) : x; }
                    (void)__hip_atomic_fetch_add(dbg + 192, cnt, __ATOMIC_RELAXED, __HIP_MEMORY_SCOPE_AGENT); }
                if (MK_CMP_ATT == 5) { unsigned cnt = 0u; const GAS unsigned* s1 = (const GAS unsigned*)(w_ + WS_END + 400 * MiB); const GAS unsigned* s2 = (const GAS unsigned*)(w_ + WS_END + 404 * MiB);
                    for (unsigned i = (unsigned)b_ * 512u + (unsigned)F.tid; i < (unsigned)S_ * 4; i += (unsigned)F.G * 512u) { bool df = false; for (int w = 0; w < 8; ++w) df |= (s1[i * 8 + w] != s2[i * 8 + w]); if (df) ++cnt; }
                    (void)__hip_atomic_fetch_add(dbg + 128, cnt, __ATOMIC_RELAXED, __HIP_MEMORY_SCOPE_AGENT); }
                if (MK_CMP_ATT == 6) { unsigned cnt = 0u; const GAS unsigned* s1 = (const GAS unsigned*)(w_ + WS_END + 400 * MiB); const GAS unsigned* s2 = (const GAS unsigned*)(w_ + WS_END + 404 * MiB);
                    for (unsigned i = (unsigned)b_ * 512u + (unsigned)F.tid; i < (unsigned)S_ * 4; i += (unsigned)F.G * 512u) { for (int w = 0; w < 8; ++w) cnt += __builtin_popcount(s1[i * 8 + w] ^ s2[i * 8 + w]); }
                    (void)__hip_atomic_fetch_add(dbg + 128, cnt, __ATOMIC_RELAXED, __HIP_MEMORY_SCOPE_AGENT); }
                if (MK_CMP_ATT >= 4) { unsigned cnt = 0u; for (unsigned i = (unsigned)b_ * 512u + (unsigned)F.tid; i < (unsigned)S_ * NSAW; i += (unsigned)F.G * 512u) { const float d = fabsf(bf2f(P.A[i]) - bf2f(A2[i])); if (d > 0.02f) ++cnt; } (void)__hip_atomic_fetch_add(dbg + 128, cnt, __ATOMIC_RELAXED, __HIP_MEMORY_SCOPE_AGENT); }
                (void)__hip_atomic_fetch_max(dbg, __builtin_bit_cast(unsigned, mx), __ATOMIC_RELAXED, __HIP_MEMORY_SCOPE_AGENT);
                SEAM();
                const unsigned gm = __hip_atomic_load(dbg, __ATOMIC_RELAXED, __HIP_MEMORY_SCOPE_AGENT);
                if (__builtin_bit_cast(unsigned, mx) == gm && mx > 0.f) __hip_atomic_store(dbg + 64, mi, __ATOMIC_RELAXED, __HIP_MEMORY_SCOPE_AGENT);
                SEAM();
                const unsigned gi = __hip_atomic_load(dbg + 64, __ATOMIC_RELAXED, __HIP_MEMORY_SCOPE_AGENT);
                const float val = (MK_CMP_ATT >= 9) ? 1000.f + (float)__hip_atomic_load(dbg + 192, __ATOMIC_RELAXED, __HIP_MEMORY_SCOPE_AGENT) : (MK_CMP_ATT == 7 || MK_CMP_ATT == 8) ? 1e5f * __builtin_bit_cast(float, gm) : (MK_CMP_ATT >= 4) ? 1000.f + (float)__hip_atomic_load(dbg + 128, __ATOMIC_RELAXED, __HIP_MEMORY_SCOPE_AGENT) : (MK_CMP_ATT == 1) ? 1e5f * __builtin_bit_cast(float, gm) : (MK_CMP_ATT == 2) ? 1000.f + (float)(gi / NSAW) : 1000.f + (float)(gi % NSAW);
                for (size_t i = (size_t)b_ * 512 + F.tid; i < (size_t)S_ * DM; i += (size_t)F.G * 512) X[i] = val;
                return;
            }
#endif
            {
                GAS unsigned* ctr = (GAS unsigned*)(w_ + WS_CTL) + 8192 + 64 * l;
                volatile LAS unsigned* bw = (volatile LAS unsigned*)(F.lds + MISC_OFF) + 4;
#pragma unroll 1
                for (;;) {
                    if (F.tid == 0) bw[0] = __hip_atomic_fetch_add(ctr, 1u, __ATOMIC_RELAXED, __HIP_MEMORY_SCOPE_AGENT);
                    __syncthreads();
                    const int u = __builtin_amdgcn_readfirstlane((int)bw[0]);
                    __syncthreads();
                    if (u >= (S_ / 64) * NGRP) break;
                    nsa_unit_v2(F, P, 255 - (u >> 2), u & 3);
                }
            }
            __syncthreads();
            SEAM(); TS1(6);
        }
        if (IN(7)) { PHASE_BEGIN(); TS0();
            pg8::Sched<S_ / 256, DM / 256, 2, true> S; S.init(F.G, b_);
            EpiMerge E{(gbf*)(w_ + WS_Y1), (const gbf*)(w_ + WS_MG)};
            pg8::gemm_phase<NSAW, NSAW, NSAW, (long)(WS_P - WS_A) / 2, (long)(WS_WBRP - WS_WBRA) / 2>(F.lds, F.tid, (const gbf*)(w_ + WS_A), (const gbf*)(w_ + WS_WBRA), S, E);
            SEAM(); TS1(7);
        }
        if (IN(8)) { PHASE_BEGIN(); TS0();
            pg8::SchedPanel<S_ / 256> S; S.init(F.G, b_);
            EpiBf16 E{(gbf*)(w_ + WS_Y2), DM, 0, 1.f};
            pg8::gemm_phase<DM, DM, DM, 0, 0>(F.lds, F.tid, (const gbf*)(w_ + WS_Y1), (const gbf*)(w_ + WS_WMIX), S, E);
            SEAM(); TS1(8);
        }
        if (IN(9)) { PHASE_BEGIN(); TS0();
#pragma unroll 1
            for (int m = F.gw; m < S_; m += F.NGW) resid_row((const gbf*)(w_ + WS_XB) + (size_t)m * DM, (gbf*)(w_ + WS_XB) + (size_t)m * DM, (gfl*)nullptr, (const gbf*)(w_ + WS_Y2) + (size_t)m * DM, INP(I_LN_MIX_POST) + (size_t)l * DM, (gfl*)(w_ + WS_R) + m, F.lane);
            SEAM(); TS1(9);
        }
        if (IN(10)) { PHASE_BEGIN(); TS0();
            pg8::Sched<S_ / 256, XW / 256, 1, false> S; S.init(F.G, b_);
            EpiBf16 E{(gbf*)(w_ + WS_Q2), XW, 0, 1.f, (const gfl*)(w_ + WS_R)};
            pg8::gemm_phase<DM, DM, DM, 0, 0>(F.lds, F.tid, (const gbf*)(w_ + WS_XB), (const gbf*)(w_ + WS_WXQ), S, E);
            if (l == 0 && b_ >= 128) {
                pg8::Sched<1, 4, 4, false> S2; S2.init(F.G - 128, b_ - 128);
                EpiKVmem E2{(gbf*)(w_ + WS_KM), (gbf*)(w_ + WS_VMT)};
                pg8::gemm_phase<DM, DM, DM, (long)NMEM * DM, (long)1024 * DM>(F.lds, F.tid, (const gbf*)(w_ + WS_MEMN2), (const gbf*)(w_ + WS_WXKV2), S2, E2);
            }
            const int c10 = F.G > 144 ? (l == 0 ? 144 : 128) : 0;
            if (b_ >= c10) {
                __syncthreads();
                if (F.tid == 0) { LAS TrDesc* tab = (LAS TrDesc*)(F.lds + TR_TAB_OFF); int nd = launder_int(0), total = launder_int(0); const gfl* nul = nullptr;
                    TR_PUT(INP(I_W_GATE) + (size_t)l * DM * DFF, DM, DFF, (gbf*)(w_ + WS_WGU), DM, 2 | 8, 0, INP(I_LN_FFN_PRE) + (size_t)l * DM);
                    TR_PUT(INP(I_W_UP) + (size_t)l * DM * DFF, DM, DFF, (gbf*)(w_ + WS_WGU), DM, 2 | 8, 128, INP(I_LN_FFN_PRE) + (size_t)l * DM);
                    TR_PUT(INP(I_W_DOWN) + (size_t)l * DFF * DM, (F.G > 64) ? DFF / 2 : DFF, DM, (gbf*)(w_ + WS_WDN), DFF, 0, 0, nul);
                    trn[0] = nd; trn[1] = total; }
                LDS_WAIT(); __syncthreads();
                Frame F2 = F; F2.gw = (b_ - c10) * NWAVES + F.wave; F2.NGW = (F.G - c10) * NWAVES;
                tr_run(F2, trn[0], trn[1]);
                __syncthreads();
            }
            SEAM(); TS1(10);
        }
        if (IN(11)) { PHASE_BEGIN(); TS0();
#pragma unroll 1
            for (int u = b_; u < (S_ / 256) * 4; u += F.G) xattn_unit_v2(F, (const gbf*)(w_ + WS_Q2), (const gbf*)(w_ + WS_KM) + (size_t)l * NMEM * XW, (const gbf*)(w_ + WS_VMT) + (size_t)l * XW * NMEM, (gbf*)(w_ + WS_O2), u >> 2, u & 3);
            SEAM(); TS1(11);
        }
        if (IN(12)) { PHASE_BEGIN(); TS0();
            pg8::SchedPanel<S_ / 256> S; S.init(F.G, b_);
            EpiBf16 E{(gbf*)(w_ + WS_Y2), DM, 0, 1.f};
            pg8::gemm_phase<XW, XW, XW, 0, 0>(F.lds, F.tid, (const gbf*)(w_ + WS_O2), (const gbf*)(w_ + WS_WXO), S, E);
            SEAM(); TS1(12);
        }
        if (IN(13)) { PHASE_BEGIN(); TS0();
#pragma unroll 1
            for (int m = F.gw; m < S_; m += F.NGW) resid_row((const gbf*)(w_ + WS_XB) + (size_t)m * DM, (gbf*)(w_ + WS_XB) + (size_t)m * DM, (gfl*)nullptr, (const gbf*)(w_ + WS_Y2) + (size_t)m * DM, INP(I_LN_X_POST) + (size_t)l * DM, (gfl*)(w_ + WS_R) + m, F.lane);
            SEAM(); TS1(13);
        }
        if (IN(14)) { PHASE_BEGIN(); TS0();
            pg8::Sched<S_ / 256, 2 * DFF / 256, 1, false> S; S.init(F.G, b_);
            EpiSwiGLU E{(gbf*)(w_ + WS_HID), (const gfl*)(w_ + WS_R)};
            pg8::gemm_phase<DM, DM, DM, 0, 0>(F.lds, F.tid, (const gbf*)(w_ + WS_XB), (const gbf*)(w_ + WS_WGU), S, E);
            SEAM(); TS1(14);
        }
        if (IN(15)) { PHASE_BEGIN(); TS0();
            pg8::SchedPanel<S_ / 256> S; S.init(F.G, b_);
            EpiBf16 E{(gbf*)(w_ + WS_Y2), DM, 0, 1.f};
            pg8::gemm_phase<DFF, DFF, DFF, 0, 0>(F.lds, F.tid, (const gbf*)(w_ + WS_HID), (const gbf*)(w_ + WS_WDN), S, E);
            SEAM(); TS1(15);
        }
        if (IN(16)) { PHASE_BEGIN(); TS0();
#pragma unroll 1
            for (int m = F.gw; m < S_; m += F.NGW) resid_row((const gbf*)(w_ + WS_XB) + (size_t)m * DM, (gbf*)(w_ + WS_XB) + (size_t)m * DM, (l + 1 < NL) ? (gfl*)nullptr : X + (size_t)m * DM, (const gbf*)(w_ + WS_Y2) + (size_t)m * DM, INP(I_LN_FFN_POST) + (size_t)l * DM, (l + 1 < NL) ? (gfl*)(w_ + WS_R) + m : (gfl*)nullptr, F.lane);
            if (l + 1 < NL) {
                __syncthreads();
            if (F.tid == 0) { LAS TrDesc* tab = (LAS TrDesc*)(F.lds + TR_TAB_OFF); int nd = launder_int(0), total = launder_int(0); const gfl* nul = nullptr;
                TR_PUT(INP(I_W_IN) + (size_t)(l + 1) * DM * INW, DM, INW, (gbf*)(w_ + WS_WIN), DM, 1 | 8, 0, INP(I_LN_MIX_PRE) + (size_t)(l + 1) * DM);
                for (int q = 0; q < 4; ++q) { const int kv = q >> 1, half = q & 1;
                    TR_PUT(INP(I_CMP_W1) + (((size_t)(l + 1) * 2 + kv) * 2048 + half * 1024) * 128, 1024, 128, (gbf*)(w_ + WS_WC1) + (size_t)kv * 256 * 1024, 1024, 0, half * 128, nul); }
                for (int gi = 0; gi < 4; ++gi)
                    TR_PUT(INP(I_W_POOL) + ((size_t)(l + 1) * 4 + gi) * 65536, 256, 256, (gbf*)(w_ + WS_WPOOL) + (size_t)gi * 65536, 256, 0, 0, INP(I_POOL_SCALE) + (size_t)(l + 1) * POOLW + gi * 256);
                trn[0] = nd; trn[1] = total; }
            LDS_WAIT(); __syncthreads();
            if (F.gw < 32) {
                const int p = F.gw >> 2, kv = (F.gw >> 1) & 1, j = (F.gw & 1) * 64 + F.lane;
                const gfl* pe = INP(I_CMP_PE) + ((size_t)(l + 1) * 2 + kv) * 2048 + p * 256; const gfl* w1 = INP(I_CMP_W1) + (((size_t)(l + 1) * 2 + kv) * 2048 + p * 256) * 128 + j;
                float a = 0.f;
#pragma unroll 32
                for (int k = 0; k < 256; ++k) a += pe[k] * w1[(size_t)k * 128];
                ((gfl*)(w_ + WS_PEB))[p * 256 + kv * 128 + j] = a;
            }
            tr_run(F, trn[0], trn[1]);
            __syncthreads();
            }
            if (l + 1 < launder_int(l_hi)) SEAM(); TS1(16);
        }
    }

    if (launder_int(l_lo) <= 2 && 2 < launder_int(l_hi)) { constexpr int l = 2;
        if (l == 0 && IN(2)) { PHASE_BEGIN(); TS0();
            if (F.tid == 0) { LAS TrDesc* tab = (LAS TrDesc*)(F.lds + TR_TAB_OFF); int nd = launder_int(0), total = launder_int(0); const gfl* nul = nullptr;
                TR_PUT(INP(I_W_IN) + (size_t)l * DM * INW, DM, INW, (gbf*)(w_ + WS_WIN), DM, 1 | 8, 0, INP(I_LN_MIX_PRE) + (size_t)l * DM);
                for (int q = 0; q < 4; ++q) { const int kv = q >> 1, half = q & 1;
                    TR_PUT(INP(I_CMP_W1) + (((size_t)l * 2 + kv) * 2048 + half * 1024) * 128, 1024, 128, (gbf*)(w_ + WS_WC1) + (size_t)kv * 256 * 1024, 1024, 0, half * 128, nul); }
                for (int gi = 0; gi < 4; ++gi)
                    TR_PUT(INP(I_W_POOL) + ((size_t)l * 4 + gi) * 65536, 256, 256, (gbf*)(w_ + WS_WPOOL) + (size_t)gi * 65536, 256, 0, 0, INP(I_POOL_SCALE) + (size_t)l * POOLW + gi * 256);
                trn[0] = nd; trn[1] = total; }
            LDS_WAIT(); __syncthreads();
            if (F.gw < 32) {
                const int p = F.gw >> 2, kv = (F.gw >> 1) & 1, j = (F.gw & 1) * 64 + F.lane;
                const gfl* pe = INP(I_CMP_PE) + ((size_t)l * 2 + kv) * 2048 + p * 256; const gfl* w1 = INP(I_CMP_W1) + (((size_t)l * 2 + kv) * 2048 + p * 256) * 128 + j;
                float a = 0.f;
#pragma unroll 32
                for (int k = 0; k < 256; ++k) a += pe[k] * w1[(size_t)k * 128];
                ((gfl*)(w_ + WS_PEB))[p * 256 + kv * 128 + j] = a;
            }
            tr_run(F, trn[0], trn[1]);
            __syncthreads();
            SEAM(); TS1(2);
        }
        if (IN(3)) { PHASE_BEGIN(); TS0();
            pg8::Sched<S_ / 256, ZN / 256, 1, false> S; S.init(F.G, b_);
            EpiZ E{w_};
            pg8::gemm_phase<DM, DM, DM, 0, 0>(F.lds, F.tid, (const gbf*)(w_ + WS_XB), (const gbf*)(w_ + WS_WIN), S, E);
            const int c3 = ((S_ / 256) * (ZN / 256)) % F.G;
            if (b_ >= c3) {
                __syncthreads();
                if (F.tid == 0) { LAS TrDesc* tab = (LAS TrDesc*)(F.lds + TR_TAB_OFF); int nd = launder_int(0), total = launder_int(0); const gfl* nul = nullptr;
                    TR_PUT(INP(I_W_BR_ATTN) + (size_t)l * NSAW * DM, NSAW, DM, (gbf*)(w_ + WS_WBRA), NSAW, 0, 0, nul);
                    TR_PUT(INP(I_W_BR_POOL) + (size_t)l * POOLW * DM, POOLW, DM, (gbf*)(w_ + WS_WBRP), POOLW, 0, 0, nul);
                    TR_PUT(INP(I_W_MIX_OUT) + (size_t)l * DM * DM, DM, DM, (gbf*)(w_ + WS_WMIX), DM, 0, 0, nul);
                    TR_PUT(INP(I_W_XQ) + (size_t)l * DM * XW, DM, XW, (gbf*)(w_ + WS_WXQ), DM, 0 | 8, 0, INP(I_LN_X_PRE) + (size_t)l * DM);
                    TR_PUT(INP(I_W_XO) + (size_t)l * XW * DM, XW, DM, (gbf*)(w_ + WS_WXO), XW, 0, 0, nul);
                    trn[0] = nd; trn[1] = total; }
                LDS_WAIT(); __syncthreads();
                Frame F2 = F; F2.gw = (b_ - c3) * NWAVES + F.wave; F2.NGW = (F.G - c3) * NWAVES;
                tr_run(F2, trn[0], trn[1]);
                __syncthreads();
            }
            SEAM(); TS1(3);
        }
        if (IN(4)) { PHASE_BEGIN(); TS0();
            if (F.G <= 64) {
#pragma unroll 1
                for (int it = F.gw; it < 2 * S_; it += F.NGW) pool_item((const gbf*)(w_ + WS_U), (gbf*)(w_ + WS_YP), it, F.lane);
                __syncthreads();
            } else if (b_ >= 32) {
#pragma unroll 1
                for (int it = (b_ - 32) * NWAVES + F.wave; it < 2 * S_; it += (F.G - 32) * NWAVES) pool_item((const gbf*)(w_ + WS_U), (gbf*)(w_ + WS_YP), it, F.lane);
                if (F.tid == 0) { LAS TrDesc* tab = (LAS TrDesc*)(F.lds + TR_TAB_OFF); int nd = launder_int(0), total = launder_int(0); const gfl* nul = nullptr;
                    TR_PUT(INP(I_W_DOWN) + ((size_t)l * DFF + DFF / 2) * DM, DFF / 2, DM, (gbf*)(w_ + WS_WDN) + DFF / 2, DFF, 0, 0, nul);
                    trn[0] = nd; trn[1] = total; }
                LDS_WAIT(); __syncthreads();
                Frame F2 = F; F2.gw = (b_ - 32) * NWAVES + F.wave; F2.NGW = (F.G - 32) * NWAVES;
                tr_run(F2, trn[0], trn[1]);
                __syncthreads();
            }
            pg8::Sched<16, 1, 2, false> S; S.init(F.G, b_);
            EpiF32 E{(gfl*)(w_ + WS_PQ), 256, (size_t)4096 * 256};
            pg8::gemm_phase<1024, 1024, 1024, (long)(WS_VCR - WS_KCR) / 2, (long)256 * 1024>(F.lds, F.tid, (const gbf*)(w_ + WS_KCR), (const gbf*)(w_ + WS_WC1), S, E);
            SEAM(); TS1(4);
        }
        if (IN(5)) { PHASE_BEGIN(); TS0();
            LAS float* hid = (LAS float*)(F.lds + F.wave * 2048);
#pragma unroll 1
            for (int it = F.gw; it < 2048; it += F.NGW) cmp_final_item4((const gfl*)(w_ + WS_PQ), (const gfl*)(w_ + WS_PEB), INP(I_CMP_W2) + (size_t)l * 2 * 128 * 64, (gbf*)(w_ + WS_KC), (gbf*)(w_ + WS_VCT), hid, it, F.lane);
            __syncthreads();
            pg8::Sched<S_ / 256, 1, 4, false> S; S.init(F.G, b_);
            EpiBf16 E{(gbf*)(w_ + WS_P), POOLW, 256, 1.f};
            pg8::gemm_phase<POOLW, 256, 256, 256, 65536>(F.lds, F.tid, (const gbf*)(w_ + WS_YP), (const gbf*)(w_ + WS_WPOOL), S, E);
            SEAM(); TS1(5);
        }
        if (IN(6)) { PHASE_BEGIN(); TS0();
            attn_setup_tables(F, INP(I_RELB));
            const AttnPtrs P{(const gbf*)(w_ + WS_Q), (const gbf*)(w_ + WS_KC), (const gbf*)(w_ + WS_VCT), (const gbf*)(w_ + WS_KSEL), (const gbf*)(w_ + WS_VSELT), (const gbf*)(w_ + WS_KWIN), (const gbf*)(w_ + WS_VWINT),
                             (const gfl*)(w_ + WS_GL), (gbf*)(w_ + WS_A)};
#ifdef MK_CMP_ATT
            {
                gbf* A2 = (gbf*)(w_ + WS_YP);
#pragma unroll 1
                for (int it = F.gw; it < (S_ / 4) * NGRP; it += F.NGW) nsa_unit_v1(F, P, it >> 2, it & 3);
                __syncthreads();
                const AttnPtrs P2{P.Q, P.KC, P.VCT, P.KSEL, P.VSELT, P.KWIN, P.VWINT, P.GL, A2};
#pragma unroll 1
                for (int u = b_; u < (S_ / 64) * NGRP; u += F.G) { const int c = u & 255, r = u >> 8; nsa_unit_v2(F, P2, (r < 2) ? 255 - (c >> 1) : (c >> 1), (c & 1) * 2 + (r & 1)); }
                __syncthreads();
                SEAM();
                GAS unsigned* dbg = (GAS unsigned*)(w_ + WS_CTL) + 64;
                float mx = 0.f; unsigned mi = 0u;
                for (unsigned i = (unsigned)b_ * 512u + (unsigned)F.tid; i < (unsigned)S_ * NSAW; i += (unsigned)F.G * 512u) { const float d = fabsf(bf2f(P.A[i]) - bf2f(A2[i])); if (d > mx) { mx = d; mi = i; } }
                if (MK_CMP_ATT == 7 || MK_CMP_ATT == 8) { mx = 0.f; mi = 0u; const GAS float* i1 = (const GAS float*)(w_ + WS_END + 16 * MiB); const GAS float* i2 = (const GAS float*)(w_ + WS_END + 96 * MiB);
                    for (unsigned i = (unsigned)b_ * 512u + (unsigned)F.tid; i < (unsigned)S_ * 4 * 256; i += (unsigned)F.G * 512u) { const int j = i & 255, t = i >> 10, cur = t >> 6; if (cur >= 16 && j >= 1 && j <= cur - 2) { const float d = fabsf(i1[i] - i2[i]) / (MK_CMP_ATT == 8 ? fmaxf(fabsf(i1[i]), 1e-12f) : 1.f); if (d > mx) { mx = d; mi = i; } } } }
                if (MK_CMP_ATT == 12 || MK_CMP_ATT == 13) { unsigned cnt = 0u; const GAS unsigned* sm = (const GAS unsigned*)(w_ + WS_END + (MK_CMP_ATT == 12 ? 400 : 404) * MiB); const GAS float* im = (const GAS float*)(w_ + WS_END + 16 * MiB);
                    for (unsigned i = (unsigned)b_ * 512u + (unsigned)F.tid; i < (unsigned)S_ * 4; i += (unsigned)F.G * 512u) { const int t = i >> 2, cur = t >> 6; if (cur < 16) continue;
                        float mins = 1e30f, maxu = -1.f;
                        for (int j = 1; j <= cur - 2; ++j) { const float v = im[(size_t)i * 256 + j]; const bool s = (sm[i * 8 + (j >> 5)] >> (j & 31)) & 1u; if (s) mins = fminf(mins, v); else maxu = fmaxf(maxu, v); }
                        if (mins < maxu) ++cnt; }
                    (void)__hip_atomic_fetch_add(dbg + 192, cnt, __ATOMIC_RELAXED, __HIP_MEMORY_SCOPE_AGENT); }
                if (MK_CMP_ATT == 9 || MK_CMP_ATT == 10 || MK_CMP_ATT == 11) { unsigned cnt = 0u; const GAS unsigned* s1 = (const GAS unsigned*)(w_ + WS_END + 400 * MiB); const GAS unsigned* s2 = (const GAS unsigned*)(w_ + WS_END + 404 * MiB);
                    for (unsigned i = (unsigned)b_ * 512u + (unsigned)F.tid; i < (unsigned)S_ * 4; i += (unsigned)F.G * 512u) { unsigned x = 0u; bool df = false; for (int w = 0; w < 8; ++w) { df |= (s1[i * 8 + w] != s2[i * 8 + w]); x += __builtin_popcount(MK_CMP_ATT == 10 ? s1[i * 8 + w] : s2[i * 8 + w]); } cnt += (MK_CMP_ATT == 9) ? (df ? 1u : 0u) : x; }
                    (void)__hip_atomic_fetch_add(dbg + 192, cnt, __ATOMIC_RELAXED, __HIP_MEMORY_SCOPE_AGENT); }
                if (MK_CMP_ATT == 5) { unsigned cnt = 0u; const GAS unsigned* s1 = (const GAS unsigned*)(w_ + WS_END + 400 * MiB); const GAS unsigned* s2 = (const GAS unsigned*)(w_ + WS_END + 404 * MiB);
                    for (unsigned i = (unsigned)b_ * 512u + (unsigned)F.tid; i < (unsigned)S_ * 4; i += (unsigned)F.G * 512u) { bool df = false; for (int w = 0; w < 8; ++w) df |= (s1[i * 8 + w] != s2[i * 8 + w]); if (df) ++cnt; }
                    (void)__hip_atomic_fetch_add(dbg + 128, cnt, __ATOMIC_RELAXED, __HIP_MEMORY_SCOPE_AGENT); }
                if (MK_CMP_ATT == 6) { unsigned cnt = 0u; const GAS unsigned* s1 = (const GAS unsigned*)(w_ + WS_END + 400 * MiB); const GAS unsigned* s2 = (const GAS unsigned*)(w_ + WS_END + 404 * MiB);
                    for (unsigned i = (unsigned)b_ * 512u + (unsigned)F.tid; i < (unsigned)S_ * 4; i += (unsigned)F.G * 512u) { for (int w = 0; w < 8; ++w) cnt += __builtin_popcount(s1[i * 8 + w] ^ s2[i * 8 + w]); }
                    (void)__hip_atomic_fetch_add(dbg + 128, cnt, __ATOMIC_RELAXED, __HIP_MEMORY_SCOPE_AGENT); }
                if (MK_CMP_ATT >= 4) { unsigned cnt = 0u; for (unsigned i = (unsigned)b_ * 512u + (unsigned)F.tid; i < (unsigned)S_ * NSAW; i += (unsigned)F.G * 512u) { const float d = fabsf(bf2f(P.A[i]) - bf2f(A2[i])); if (d > 0.02f) ++cnt; } (void)__hip_atomic_fetch_add(dbg + 128, cnt, __ATOMIC_RELAXED, __HIP_MEMORY_SCOPE_AGENT); }
                (void)__hip_atomic_fetch_max(dbg, __builtin_bit_cast(unsigned, mx), __ATOMIC_RELAXED, __HIP_MEMORY_SCOPE_AGENT);
                SEAM();
                const unsigned gm = __hip_atomic_load(dbg, __ATOMIC_RELAXED, __HIP_MEMORY_SCOPE_AGENT);
                if (__builtin_bit_cast(unsigned, mx) == gm && mx > 0.f) __hip_atomic_store(dbg + 64, mi, __ATOMIC_RELAXED, __HIP_MEMORY_SCOPE_AGENT);
                SEAM();
                const unsigned gi = __hip_atomic_load(dbg + 64, __ATOMIC_RELAXED, __HIP_MEMORY_SCOPE_AGENT);
                const float val = (MK_CMP_ATT >= 9) ? 1000.f + (float)__hip_atomic_load(dbg + 192, __ATOMIC_RELAXED, __HIP_MEMORY_SCOPE_AGENT) : (MK_CMP_ATT == 7 || MK_CMP_ATT == 8) ? 1e5f * __builtin_bit_cast(float, gm) : (MK_CMP_ATT >= 4) ? 1000.f + (float)__hip_atomic_load(dbg + 128, __ATOMIC_RELAXED, __HIP_MEMORY_SCOPE_AGENT) : (MK_CMP_ATT == 1) ? 1e5f * __builtin_bit_cast(float, gm) : (MK_CMP_ATT == 2) ? 1000.f + (float)(gi / NSAW) : 1000.f + (float)(gi % NSAW);
                for (size_t i = (size_t)b_ * 512 + F.tid; i < (size_t)S_ * DM; i += (size_t)F.G * 512) X[i] = val;
                return;
            }
#endif
            {
                GAS unsigned* ctr = (GAS unsigned*)(w_ + WS_CTL) + 8192 + 64 * l;
                volatile LAS unsigned* bw = (volatile LAS unsigned*)(F.lds + MISC_OFF) + 4;
#pragma unroll 1
                for (;;) {
                    if (F.tid == 0) bw[0] = __hip_atomic_fetch_add(ctr, 1u, __ATOMIC_RELAXED, __HIP_MEMORY_SCOPE_AGENT);
                    __syncthreads();
                    const int u = __builtin_amdgcn_readfirstlane((int)bw[0]);
                    __syncthreads();
                    if (u >= (S_ / 64) * NGRP) break;
                    nsa_unit_v2(F, P, 255 - (u >> 2), u & 3);
                }
            }
            __syncthreads();
            SEAM(); TS1(6);
        }
        if (IN(7)) { PHASE_BEGIN(); TS0();
            pg8::Sched<S_ / 256, DM / 256, 2, true> S; S.init(F.G, b_);
            EpiMerge E{(gbf*)(w_ + WS_Y1), (const gbf*)(w_ + WS_MG)};
            pg8::gemm_phase<NSAW, NSAW, NSAW, (long)(WS_P - WS_A) / 2, (long)(WS_WBRP - WS_WBRA) / 2>(F.lds, F.tid, (const gbf*)(w_ + WS_A), (const gbf*)(w_ + WS_WBRA), S, E);
            SEAM(); TS1(7);
        }
        if (IN(8)) { PHASE_BEGIN(); TS0();
            pg8::SchedPanel<S_ / 256> S; S.init(F.G, b_);
            EpiBf16 E{(gbf*)(w_ + WS_Y2), DM, 0, 1.f};
            pg8::gemm_phase<DM, DM, DM, 0, 0>(F.lds, F.tid, (const gbf*)(w_ + WS_Y1), (const gbf*)(w_ + WS_WMIX), S, E);
            SEAM(); TS1(8);
        }
        if (IN(9)) { PHASE_BEGIN(); TS0();
#pragma unroll 1
            for (int m = F.gw; m < S_; m += F.NGW) resid_row((const gbf*)(w_ + WS_XB) + (size_t)m * DM, (gbf*)(w_ + WS_XB) + (size_t)m * DM, (gfl*)nullptr, (const gbf*)(w_ + WS_Y2) + (size_t)m * DM, INP(I_LN_MIX_POST) + (size_t)l * DM, (gfl*)(w_ + WS_R) + m, F.lane);
            SEAM(); TS1(9);
        }
        if (IN(10)) { PHASE_BEGIN(); TS0();
            pg8::Sched<S_ / 256, XW / 256, 1, false> S; S.init(F.G, b_);
            EpiBf16 E{(gbf*)(w_ + WS_Q2), XW, 0, 1.f, (const gfl*)(w_ + WS_R)};
            pg8::gemm_phase<DM, DM, DM, 0, 0>(F.lds, F.tid, (const gbf*)(w_ + WS_XB), (const gbf*)(w_ + WS_WXQ), S, E);
            if (l == 0 && b_ >= 128) {
                pg8::Sched<1, 4, 4, false> S2; S2.init(F.G - 128, b_ - 128);
                EpiKVmem E2{(gbf*)(w_ + WS_KM), (gbf*)(w_ + WS_VMT)};
                pg8::gemm_phase<DM, DM, DM, (long)NMEM * DM, (long)1024 * DM>(F.lds, F.tid, (const gbf*)(w_ + WS_MEMN2), (const gbf*)(w_ + WS_WXKV2), S2, E2);
            }
            const int c10 = F.G > 144 ? (l == 0 ? 144 : 128) : 0;
            if (b_ >= c10) {
                __syncthreads();
                if (F.tid == 0) { LAS TrDesc* tab = (LAS TrDesc*)(F.lds + TR_TAB_OFF); int nd = launder_int(0), total = launder_int(0); const gfl* nul = nullptr;
                    TR_PUT(INP(I_W_GATE) + (size_t)l * DM * DFF, DM, DFF, (gbf*)(w_ + WS_WGU), DM, 2 | 8, 0, INP(I_LN_FFN_PRE) + (size_t)l * DM);
                    TR_PUT(INP(I_W_UP) + (size_t)l * DM * DFF, DM, DFF, (gbf*)(w_ + WS_WGU), DM, 2 | 8, 128, INP(I_LN_FFN_PRE) + (size_t)l * DM);
                    TR_PUT(INP(I_W_DOWN) + (size_t)l * DFF * DM, (F.G > 64) ? DFF / 2 : DFF, DM, (gbf*)(w_ + WS_WDN), DFF, 0, 0, nul);
                    trn[0] = nd; trn[1] = total; }
                LDS_WAIT(); __syncthreads();
                Frame F2 = F; F2.gw = (b_ - c10) * NWAVES + F.wave; F2.NGW = (F.G - c10) * NWAVES;
                tr_run(F2, trn[0], trn[1]);
                __syncthreads();
            }
            SEAM(); TS1(10);
        }
        if (IN(11)) { PHASE_BEGIN(); TS0();
#pragma unroll 1
            for (int u = b_; u < (S_ / 256) * 4; u += F.G) xattn_unit_v2(F, (const gbf*)(w_ + WS_Q2), (const gbf*)(w_ + WS_KM) + (size_t)l * NMEM * XW, (const gbf*)(w_ + WS_VMT) + (size_t)l * XW * NMEM, (gbf*)(w_ + WS_O2), u >> 2, u & 3);
            SEAM(); TS1(11);
        }
        if (IN(12)) { PHASE_BEGIN(); TS0();
            pg8::SchedPanel<S_ / 256> S; S.init(F.G, b_);
            EpiBf16 E{(gbf*)(w_ + WS_Y2), DM, 0, 1.f};
            pg8::gemm_phase<XW, XW, XW, 0, 0>(F.lds, F.tid, (const gbf*)(w_ + WS_O2), (const gbf*)(w_ + WS_WXO), S, E);
            SEAM(); TS1(12);
        }
        if (IN(13)) { PHASE_BEGIN(); TS0();
#pragma unroll 1
            for (int m = F.gw; m < S_; m += F.NGW) resid_row((const gbf*)(w_ + WS_XB) + (size_t)m * DM, (gbf*)(w_ + WS_XB) + (size_t)m * DM, (gfl*)nullptr, (const gbf*)(w_ + WS_Y2) + (size_t)m * DM, INP(I_LN_X_POST) + (size_t)l * DM, (gfl*)(w_ + WS_R) + m, F.lane);
            SEAM(); TS1(13);
        }
        if (IN(14)) { PHASE_BEGIN(); TS0();
            pg8::Sched<S_ / 256, 2 * DFF / 256, 1, false> S; S.init(F.G, b_);
            EpiSwiGLU E{(gbf*)(w_ + WS_HID), (const gfl*)(w_ + WS_R)};
            pg8::gemm_phase<DM, DM, DM, 0, 0>(F.lds, F.tid, (const gbf*)(w_ + WS_XB), (const gbf*)(w_ + WS_WGU), S, E);
            SEAM(); TS1(14);
        }
        if (IN(15)) { PHASE_BEGIN(); TS0();
            pg8::SchedPanel<S_ / 256> S; S.init(F.G, b_);
            EpiBf16 E{(gbf*)(w_ + WS_Y2), DM, 0, 1.f};
            pg8::gemm_phase<DFF, DFF, DFF, 0, 0>(F.lds, F.tid, (const gbf*)(w_ + WS_HID), (const gbf*)(w_ + WS_WDN), S, E);
            SEAM(); TS1(15);
        }
        if (IN(16)) { PHASE_BEGIN(); TS0();
#pragma unroll 1
            for (int m = F.gw; m < S_; m += F.NGW) resid_row((const gbf*)(w_ + WS_XB) + (size_t)m * DM, (gbf*)(w_ + WS_XB) + (size_t)m * DM, (l + 1 < NL) ? (gfl*)nullptr : X + (size_t)m * DM, (const gbf*)(w_ + WS_Y2) + (size_t)m * DM, INP(I_LN_FFN_POST) + (size_t)l * DM, (l + 1 < NL) ? (gfl*)(w_ + WS_R) + m : (gfl*)nullptr, F.lane);
            if (l + 1 < NL) {
                __syncthreads();
            if (F.tid == 0) { LAS TrDesc* tab = (LAS TrDesc*)(F.lds + TR_TAB_OFF); int nd = launder_int(0), total = launder_int(0); const gfl* nul = nullptr;
                TR_PUT(INP(I_W_IN) + (size_t)(l + 1) * DM * INW, DM, INW, (gbf*)(w_ + WS_WIN), DM, 1 | 8, 0, INP(I_LN_MIX_PRE) + (size_t)(l + 1) * DM);
                for (int q = 0; q < 4; ++q) { const int kv = q >> 1, half = q & 1;
                    TR_PUT(INP(I_CMP_W1) + (((size_t)(l + 1) * 2 + kv) * 2048 + half * 1024) * 128, 1024, 128, (gbf*)(w_ + WS_WC1) + (size_t)kv * 256 * 1024, 1024, 0, half * 128, nul); }
                for (int gi = 0; gi < 4; ++gi)
                    TR_PUT(INP(I_W_POOL) + ((size_t)(l + 1) * 4 + gi) * 65536, 256, 256, (gbf*)(w_ + WS_WPOOL) + (size_t)gi * 65536, 256, 0, 0, INP(I_POOL_SCALE) + (size_t)(l + 1) * POOLW + gi * 256);
                trn[0] = nd; trn[1] = total; }
            LDS_WAIT(); __syncthreads();
            if (F.gw < 32) {
                const int p = F.gw >> 2, kv = (F.gw >> 1) & 1, j = (F.gw & 1) * 64 + F.lane;
                const gfl* pe = INP(I_CMP_PE) + ((size_t)(l + 1) * 2 + kv) * 2048 + p * 256; const gfl* w1 = INP(I_CMP_W1) + (((size_t)(l + 1) * 2 + kv) * 2048 + p * 256) * 128 + j;
                float a = 0.f;
#pragma unroll 32
                for (int k = 0; k < 256; ++k) a += pe[k] * w1[(size_t)k * 128];
                ((gfl*)(w_ + WS_PEB))[p * 256 + kv * 128 + j] = a;
            }
            tr_run(F, trn[0], trn[1]);
            __syncthreads();
            }
            if (l + 1 < launder_int(l_hi)) SEAM(); TS1(16);
        }
    }

    if (launder_int(l_lo) <= 3 && 3 < launder_int(l_hi)) { constexpr int l = 3;
        if (l == 0 && IN(2)) { PHASE_BEGIN(); TS0();
            if (F.tid == 0) { LAS TrDesc* tab = (LAS TrDesc*)(F.lds + TR_TAB_OFF); int nd = launder_int(0), total = launder_int(0); const gfl* nul = nullptr;
                TR_PUT(INP(I_W_IN) + (size_t)l * DM * INW, DM, INW, (gbf*)(w_ + WS_WIN), DM, 1 | 8, 0, INP(I_LN_MIX_PRE) + (size_t)l * DM);
                for (int q = 0; q < 4; ++q) { const int kv = q >> 1, half = q & 1;
                    TR_PUT(INP(I_CMP_W1) + (((size_t)l * 2 + kv) * 2048 + half * 1024) * 128, 1024, 128, (gbf*)(w_ + WS_WC1) + (size_t)kv * 256 * 1024, 1024, 0, half * 128, nul); }
                for (int gi = 0; gi < 4; ++gi)
                    TR_PUT(INP(I_W_POOL) + ((size_t)l * 4 + gi) * 65536, 256, 256, (gbf*)(w_ + WS_WPOOL) + (size_t)gi * 65536, 256, 0, 0, INP(I_POOL_SCALE) + (size_t)l * POOLW + gi * 256);
                trn[0] = nd; trn[1] = total; }
            LDS_WAIT(); __syncthreads();
            if (F.gw < 32) {
                const int p = F.gw >> 2, kv = (F.gw >> 1) & 1, j = (F.gw & 1) * 64 + F.lane;
                const gfl* pe = INP(I_CMP_PE) + ((size_t)l * 2 + kv) * 2048 + p * 256; const gfl* w1 = INP(I_CMP_W1) + (((size_t)l * 2 + kv) * 2048 + p * 256) * 128 + j;
                float a = 0.f;
#pragma unroll 32
                for (int k = 0; k < 256; ++k) a += pe[k] * w1[(size_t)k * 128];
                ((gfl*)(w_ + WS_PEB))[p * 256 + kv * 128 + j] = a;
            }
            tr_run(F, trn[0], trn[1]);
            __syncthreads();
            SEAM(); TS1(2);
        }
        if (IN(3)) { PHASE_BEGIN(); TS0();
            pg8::Sched<S_ / 256, ZN / 256, 1, false> S; S.init(F.G, b_);
            EpiZ E{w_};
            pg8::gemm_phase<DM, DM, DM, 0, 0>(F.lds, F.tid, (const gbf*)(w_ + WS_XB), (const gbf*)(w_ + WS_WIN), S, E);
            const int c3 = ((S_ / 256) * (ZN / 256)) % F.G;
            if (b_ >= c3) {
                __syncthreads();
                if (F.tid == 0) { LAS TrDesc* tab = (LAS TrDesc*)(F.lds + TR_TAB_OFF); int nd = launder_int(0), total = launder_int(0); const gfl* nul = nullptr;
                    TR_PUT(INP(I_W_BR_ATTN) + (size_t)l * NSAW * DM, NSAW, DM, (gbf*)(w_ + WS_WBRA), NSAW, 0, 0, nul);
                    TR_PUT(INP(I_W_BR_POOL) + (size_t)l * POOLW * DM, POOLW, DM, (gbf*)(w_ + WS_WBRP), POOLW, 0, 0, nul);
                    TR_PUT(INP(I_W_MIX_OUT) + (size_t)l * DM * DM, DM, DM, (gbf*)(w_ + WS_WMIX), DM, 0, 0, nul);
                    TR_PUT(INP(I_W_XQ) + (size_t)l * DM * XW, DM, XW, (gbf*)(w_ + WS_WXQ), DM, 0 | 8, 0, INP(I_LN_X_PRE) + (size_t)l * DM);
                    TR_PUT(INP(I_W_XO) + (size_t)l * XW * DM, XW, DM, (gbf*)(w_ + WS_WXO), XW, 0, 0, nul);
                    trn[0] = nd; trn[1] = total; }
                LDS_WAIT(); __syncthreads();
                Frame F2 = F; F2.gw = (b_ - c3) * NWAVES + F.wave; F2.NGW = (F.G - c3) * NWAVES;
                tr_run(F2, trn[0], trn[1]);
                __syncthreads();
            }
            SEAM(); TS1(3);
        }
        if (IN(4)) { PHASE_BEGIN(); TS0();
            if (F.G <= 64) {
#pragma unroll 1
                for (int it = F.gw; it < 2 * S_; it += F.NGW) pool_item((const gbf*)(w_ + WS_U), (gbf*)(w_ + WS_YP), it, F.lane);
                __syncthreads();
            } else if (b_ >= 32) {
#pragma unroll 1
                for (int it = (b_ - 32) * NWAVES + F.wave; it < 2 * S_; it += (F.G - 32) * NWAVES) pool_item((const gbf*)(w_ + WS_U), (gbf*)(w_ + WS_YP), it, F.lane);
                if (F.tid == 0) { LAS TrDesc* tab = (LAS TrDesc*)(F.lds + TR_TAB_OFF); int nd = launder_int(0), total = launder_int(0); const gfl* nul = nullptr;
                    TR_PUT(INP(I_W_DOWN) + ((size_t)l * DFF + DFF / 2) * DM, DFF / 2, DM, (gbf*)(w_ + WS_WDN) + DFF / 2, DFF, 0, 0, nul);
                    trn[0] = nd; trn[1] = total; }
                LDS_WAIT(); __syncthreads();
                Frame F2 = F; F2.gw = (b_ - 32) * NWAVES + F.wave; F2.NGW = (F.G - 32) * NWAVES;
                tr_run(F2, trn[0], trn[1]);
                __syncthreads();
            }
            pg8::Sched<16, 1, 2, false> S; S.init(F.G, b_);
            EpiF32 E{(gfl*)(w_ + WS_PQ), 256, (size_t)4096 * 256};
            pg8::gemm_phase<1024, 1024, 1024, (long)(WS_VCR - WS_KCR) / 2, (long)256 * 1024>(F.lds, F.tid, (const gbf*)(w_ + WS_KCR), (const gbf*)(w_ + WS_WC1), S, E);
            SEAM(); TS1(4);
        }
        if (IN(5)) { PHASE_BEGIN(); TS0();
            LAS float* hid = (LAS float*)(F.lds + F.wave * 2048);
#pragma unroll 1
            for (int it = F.gw; it < 2048; it += F.NGW) cmp_final_item4((const gfl*)(w_ + WS_PQ), (const gfl*)(w_ + WS_PEB), INP(I_CMP_W2) + (size_t)l * 2 * 128 * 64, (gbf*)(w_ + WS_KC), (gbf*)(w_ + WS_VCT), hid, it, F.lane);
            __syncthreads();
            pg8::Sched<S_ / 256, 1, 4, false> S; S.init(F.G, b_);
            EpiBf16 E{(gbf*)(w_ + WS_P), POOLW, 256, 1.f};
            pg8::gemm_phase<POOLW, 256, 256, 256, 65536>(F.lds, F.tid, (const gbf*)(w_ + WS_YP), (const gbf*)(w_ + WS_WPOOL), S, E);
            SEAM(); TS1(5);
        }
        if (IN(6)) { PHASE_BEGIN(); TS0();
            attn_setup_tables(F, INP(I_RELB));
            const AttnPtrs P{(const gbf*)(w_ + WS_Q), (const gbf*)(w_ + WS_KC), (const gbf*)(w_ + WS_VCT), (const gbf*)(w_ + WS_KSEL), (const gbf*)(w_ + WS_VSELT), (const gbf*)(w_ + WS_KWIN), (const gbf*)(w_ + WS_VWINT),
                             (const gfl*)(w_ + WS_GL), (gbf*)(w_ + WS_A)};
#ifdef MK_CMP_ATT
            {
                gbf* A2 = (gbf*)(w_ + WS_YP);
#pragma unroll 1
                for (int it = F.gw; it < (S_ / 4) * NGRP; it += F.NGW) nsa_unit_v1(F, P, it >> 2, it & 3);
                __syncthreads();
                const AttnPtrs P2{P.Q, P.KC, P.VCT, P.KSEL, P.VSELT, P.KWIN, P.VWINT, P.GL, A2};
#pragma unroll 1
                for (int u = b_; u < (S_ / 64) * NGRP; u += F.G) { const int c = u & 255, r = u >> 8; nsa_unit_v2(F, P2, (r < 2) ? 255 - (c >> 1) : (c >> 1), (c & 1) * 2 + (r & 1)); }
                __syncthreads();
                SEAM();
                GAS unsigned* dbg = (GAS unsigned*)(w_ + WS_CTL) + 64;
                float mx = 0.f; unsigned mi = 0u;
                for (unsigned i = (unsigned)b_ * 512u + (unsigned)F.tid; i < (unsigned)S_ * NSAW; i += (unsigned)F.G * 512u) { const float d = fabsf(bf2f(P.A[i]) - bf2f(A2[i])); if (d > mx) { mx = d; mi = i; } }
                if (MK_CMP_ATT == 7 || MK_CMP_ATT == 8) { mx = 0.f; mi = 0u; const GAS float* i1 = (const GAS float*)(w_ + WS_END + 16 * MiB); const GAS float* i2 = (const GAS float*)(w_ + WS_END + 96 * MiB);
                    for (unsigned i = (unsigned)b_ * 512u + (unsigned)F.tid; i < (unsigned)S_ * 4 * 256; i += (unsigned)F.G * 512u) { const int j = i & 255, t = i >> 10, cur = t >> 6; if (cur >= 16 && j >= 1 && j <= cur - 2) { const float d = fabsf(i1[i] - i2[i]) / (MK_CMP_ATT == 8 ? fmaxf(fabsf(i1[i]), 1e-12f) : 1.f); if (d > mx) { mx = d; mi = i; } } } }
                if (MK_CMP_ATT == 12 || MK_CMP_ATT == 13) { unsigned cnt = 0u; const GAS unsigned* sm = (const GAS unsigned*)(w_ + WS_END + (MK_CMP_ATT == 12 ? 400 : 404) * MiB); const GAS float* im = (const GAS float*)(w_ + WS_END + 16 * MiB);
                    for (unsigned i = (unsigned)b_ * 512u + (unsigned)F.tid; i < (unsigned)S_ * 4; i += (unsigned)F.G * 512u) { const int t = i >> 2, cur = t >> 6; if (cur < 16) continue;
                        float mins = 1e30f, maxu = -1.f;
                        for (int j = 1; j <= cur - 2; ++j) { const float v = im[(size_t)i * 256 + j]; const bool s = (sm[i * 8 + (j >> 5)] >> (j & 31)) & 1u; if (s) mins = fminf(mins, v); else maxu = fmaxf(maxu, v); }
                        if (mins < maxu) ++cnt; }
                    (void)__hip_atomic_fetch_add(dbg + 192, cnt, __ATOMIC_RELAXED, __HIP_MEMORY_SCOPE_AGENT); }
                if (MK_CMP_ATT == 9 || MK_CMP_ATT == 10 || MK_CMP_ATT == 11) { unsigned cnt = 0u; const GAS unsigned* s1 = (const GAS unsigned*)(w_ + WS_END + 400 * MiB); const GAS unsigned* s2 = (const GAS unsigned*)(w_ + WS_END + 404 * MiB);
                    for (unsigned i = (unsigned)b_ * 512u + (unsigned)F.tid; i < (unsigned)S_ * 4; i += (unsigned)F.G * 512u) { unsigned x = 0u; bool df = false; for (int w = 0; w < 8; ++w) { df |= (s1[i * 8 + w] != s2[i * 8 + w]); x += __builtin_popcount(MK_CMP_ATT == 10 ? s1[i * 8 + w] : s2[i * 8 + w]); } cnt += (MK_CMP_ATT == 9) ? (df ? 1u : 0u) : x; }
                    (void)__hip_atomic_fetch_add(dbg + 192, cnt, __ATOMIC_RELAXED, __HIP_MEMORY_SCOPE_AGENT); }
                if (MK_CMP_ATT == 5) { unsigned cnt = 0u; const GAS unsigned* s1 = (const GAS unsigned*)(w_ + WS_END + 400 * MiB); const GAS unsigned* s2 = (const GAS unsigned*)(w_ + WS_END + 404 * MiB);
                    for (unsigned i = (unsigned)b_ * 512u + (unsigned)F.tid; i < (unsigned)S_ * 4; i += (unsigned)F.G * 512u) { bool df = false; for (int w = 0; w < 8; ++w) df |= (s1[i * 8 + w] != s2[i * 8 + w]); if (df) ++cnt; }
                    (void)__hip_atomic_fetch_add(dbg + 128, cnt, __ATOMIC_RELAXED, __HIP_MEMORY_SCOPE_AGENT); }
                if (MK_CMP_ATT == 6) { unsigned cnt = 0u; const GAS unsigned* s1 = (const GAS unsigned*)(w_ + WS_END + 400 * MiB); const GAS unsigned* s2 = (const GAS unsigned*)(w_ + WS_END + 404 * MiB);
                    for (unsigned i = (unsigned)b_ * 512u + (unsigned)F.tid; i < (unsigned)S_ * 4; i += (unsigned)F.G * 512u) { for (int w = 0; w < 8; ++w) cnt += __builtin_popcount(s1[i * 8 + w] ^ s2[i * 8 + w]); }
                    (void)__hip_atomic_fetch_add(dbg + 128, cnt, __ATOMIC_RELAXED, __HIP_MEMORY_SCOPE_AGENT); }
                if (MK_CMP_ATT >= 4) { unsigned cnt = 0u; for (unsigned i = (unsigned)b_ * 512u + (unsigned)F.tid; i < (unsigned)S_ * NSAW; i += (unsigned)F.G * 512u) { const float d = fabsf(bf2f(P.A[i]) - bf2f(A2[i])); if (d > 0.02f) ++cnt; } (void)__hip_atomic_fetch_add(dbg + 128, cnt, __ATOMIC_RELAXED, __HIP_MEMORY_SCOPE_AGENT); }
                (void)__hip_atomic_fetch_max(dbg, __builtin_bit_cast(unsigned, mx), __ATOMIC_RELAXED, __HIP_MEMORY_SCOPE_AGENT);
                SEAM();
                const unsigned gm = __hip_atomic_load(dbg, __ATOMIC_RELAXED, __HIP_MEMORY_SCOPE_AGENT);
                if (__builtin_bit_cast(unsigned, mx) == gm && mx > 0.f) __hip_atomic_store(dbg + 64, mi, __ATOMIC_RELAXED, __HIP_MEMORY_SCOPE_AGENT);
                SEAM();
                const unsigned gi = __hip_atomic_load(dbg + 64, __ATOMIC_RELAXED, __HIP_MEMORY_SCOPE_AGENT);
                const float val = (MK_CMP_ATT >= 9) ? 1000.f + (float)__hip_atomic_load(dbg + 192, __ATOMIC_RELAXED, __HIP_MEMORY_SCOPE_AGENT) : (MK_CMP_ATT == 7 || MK_CMP_ATT == 8) ? 1e5f * __builtin_bit_cast(float, gm) : (MK_CMP_ATT >= 4) ? 1000.f + (float)__hip_atomic_load(dbg + 128, __ATOMIC_RELAXED, __HIP_MEMORY_SCOPE_AGENT) : (MK_CMP_ATT == 1) ? 1e5f * __builtin_bit_cast(float, gm) : (MK_CMP_ATT == 2) ? 1000.f + (float)(gi / NSAW) : 1000.f + (float)(gi % NSAW);
                for (size_t i = (size_t)b_ * 512 + F.tid; i < (size_t)S_ * DM; i += (size_t)F.G * 512) X[i] = val;
                return;
            }
#endif
            {
                GAS unsigned* ctr = (GAS unsigned*)(w_ + WS_CTL) + 8192 + 64 * l;
                volatile LAS unsigned* bw = (volatile LAS unsigned*)(F.lds + MISC_OFF) + 4;
#pragma unroll 1
                for (;;) {
                    if (F.tid == 0) bw[0] = __hip_atomic_fetch_add(ctr, 1u, __ATOMIC_RELAXED, __HIP_MEMORY_SCOPE_AGENT);
                    __syncthreads();
                    const int u = __builtin_amdgcn_readfirstlane((int)bw[0]);
                    __syncthreads();
                    if (u >= (S_ / 64) * NGRP) break;
                    nsa_unit_v2(F, P, 255 - (u >> 2), u & 3);
                }
            }
            __syncthreads();
            SEAM(); TS1(6);
        }
        if (IN(7)) { PHASE_BEGIN(); TS0();
            pg8::Sched<S_ / 256, DM / 256, 2, true> S; S.init(F.G, b_);
            EpiMerge E{(gbf*)(w_ + WS_Y1), (const gbf*)(w_ + WS_MG)};
            pg8::gemm_phase<NSAW, NSAW, NSAW, (long)(WS_P - WS_A) / 2, (long)(WS_WBRP - WS_WBRA) / 2>(F.lds, F.tid, (const gbf*)(w_ + WS_A), (const gbf*)(w_ + WS_WBRA), S, E);
            SEAM(); TS1(7);
        }
        if (IN(8)) { PHASE_BEGIN(); TS0();
            pg8::SchedPanel<S_ / 256> S; S.init(F.G, b_);
            EpiBf16 E{(gbf*)(w_ + WS_Y2), DM, 0, 1.f};
            pg8::gemm_phase<DM, DM, DM, 0, 0>(F.lds, F.tid, (const gbf*)(w_ + WS_Y1), (const gbf*)(w_ + WS_WMIX), S, E);
            SEAM(); TS1(8);
        }
        if (IN(9)) { PHASE_BEGIN(); TS0();
#pragma unroll 1
            for (int m = F.gw; m < S_; m += F.NGW) resid_row((const gbf*)(w_ + WS_XB) + (size_t)m * DM, (gbf*)(w_ + WS_XB) + (size_t)m * DM, (gfl*)nullptr, (const gbf*)(w_ + WS_Y2) + (size_t)m * DM, INP(I_LN_MIX_POST) + (size_t)l * DM, (gfl*)(w_ + WS_R) + m, F.lane);
            SEAM(); TS1(9);
        }
        if (IN(10)) { PHASE_BEGIN(); TS0();
            pg8::Sched<S_ / 256, XW / 256, 1, false> S; S.init(F.G, b_);
            EpiBf16 E{(gbf*)(w_ + WS_Q2), XW, 0, 1.f, (const gfl*)(w_ + WS_R)};
            pg8::gemm_phase<DM, DM, DM, 0, 0>(F.lds, F.tid, (const gbf*)(w_ + WS_XB), (const gbf*)(w_ + WS_WXQ), S, E);
            if (l == 0 && b_ >= 128) {
                pg8::Sched<1, 4, 4, false> S2; S2.init(F.G - 128, b_ - 128);
                EpiKVmem E2{(gbf*)(w_ + WS_KM), (gbf*)(w_ + WS_VMT)};
                pg8::gemm_phase<DM, DM, DM, (long)NMEM * DM, (long)1024 * DM>(F.lds, F.tid, (const gbf*)(w_ + WS_MEMN2), (const gbf*)(w_ + WS_WXKV2), S2, E2);
            }
            const int c10 = F.G > 144 ? (l == 0 ? 144 : 128) : 0;
            if (b_ >= c10) {
                __syncthreads();
                if (F.tid == 0) { LAS TrDesc* tab = (LAS TrDesc*)(F.lds + TR_TAB_OFF); int nd = launder_int(0), total = launder_int(0); const gfl* nul = nullptr;
                    TR_PUT(INP(I_W_GATE) + (size_t)l * DM * DFF, DM, DFF, (gbf*)(w_ + WS_WGU), DM, 2 | 8, 0, INP(I_LN_FFN_PRE) + (size_t)l * DM);
                    TR_PUT(INP(I_W_UP) + (size_t)l * DM * DFF, DM, DFF, (gbf*)(w_ + WS_WGU), DM, 2 | 8, 128, INP(I_LN_FFN_PRE) + (size_t)l * DM);
                    TR_PUT(INP(I_W_DOWN) + (size_t)l * DFF * DM, (F.G > 64) ? DFF / 2 : DFF, DM, (gbf*)(w_ + WS_WDN), DFF, 0, 0, nul);
                    trn[0] = nd; trn[1] = total; }
                LDS_WAIT(); __syncthreads();
                Frame F2 = F; F2.gw = (b_ - c10) * NWAVES + F.wave; F2.NGW = (F.G - c10) * NWAVES;
                tr_run(F2, trn[0], trn[1]);
                __syncthreads();
            }
            SEAM(); TS1(10);
        }
        if (IN(11)) { PHASE_BEGIN(); TS0();
#pragma unroll 1
            for (int u = b_; u < (S_ / 256) * 4; u += F.G) xattn_unit_v2(F, (const gbf*)(w_ + WS_Q2), (const gbf*)(w_ + WS_KM) + (size_t)l * NMEM * XW, (const gbf*)(w_ + WS_VMT) + (size_t)l * XW * NMEM, (gbf*)(w_ + WS_O2), u >> 2, u & 3);
            SEAM(); TS1(11);
        }
        if (IN(12)) { PHASE_BEGIN(); TS0();
            pg8::SchedPanel<S_ / 256> S; S.init(F.G, b_);
            EpiBf16 E{(gbf*)(w_ + WS_Y2), DM, 0, 1.f};
            pg8::gemm_phase<XW, XW, XW, 0, 0>(F.lds, F.tid, (const gbf*)(w_ + WS_O2), (const gbf*)(w_ + WS_WXO), S, E);
            SEAM(); TS1(12);
        }
        if (IN(13)) { PHASE_BEGIN(); TS0();
#pragma unroll 1
            for (int m = F.gw; m < S_; m += F.NGW) resid_row((const gbf*)(w_ + WS_XB) + (size_t)m * DM, (gbf*)(w_ + WS_XB) + (size_t)m * DM, (gfl*)nullptr, (const gbf*)(w_ + WS_Y2) + (size_t)m * DM, INP(I_LN_X_POST) + (size_t)l * DM, (gfl*)(w_ + WS_R) + m, F.lane);
            SEAM(); TS1(13);
        }
        if (IN(14)) { PHASE_BEGIN(); TS0();
            pg8::Sched<S_ / 256, 2 * DFF / 256, 1, false> S; S.init(F.G, b_);
            EpiSwiGLU E{(gbf*)(w_ + WS_HID), (const gfl*)(w_ + WS_R)};
            pg8::gemm_phase<DM, DM, DM, 0, 0>(F.lds, F.tid, (const gbf*)(w_ + WS_XB), (const gbf*)(w_ + WS_WGU), S, E);
            SEAM(); TS1(14);
        }
        if (IN(15)) { PHASE_BEGIN(); TS0();
            pg8::SchedPanel<S_ / 256> S; S.init(F.G, b_);
            EpiBf16 E{(gbf*)(w_ + WS_Y2), DM, 0, 1.f};
            pg8::gemm_phase<DFF, DFF, DFF, 0, 0>(F.lds, F.tid, (const gbf*)(w_ + WS_HID), (const gbf*)(w_ + WS_WDN), S, E);
            SEAM(); TS1(15);
        }
        if (IN(16)) { PHASE_BEGIN(); TS0();
#pragma unroll 1
            for (int m = F.gw; m < S_; m += F.NGW) resid_row((const gbf*)(w_ + WS_XB) + (size_t)m * DM, (gbf*)(w_ + WS_XB) + (size_t)m * DM, (l + 1 < NL) ? (gfl*)nullptr : X + (size_t)m * DM, (const gbf*)(w_ + WS_Y2) + (size_t)m * DM, INP(I_LN_FFN_POST) + (size_t)l * DM, (l + 1 < NL) ? (gfl*)(w_ + WS_R) + m : (gfl*)nullptr, F.lane);
            if (l + 1 < NL) {
                __syncthreads();
            if (F.tid == 0) { LAS TrDesc* tab = (LAS TrDesc*)(F.lds + TR_TAB_OFF); int nd = launder_int(0), total = launder_int(0); const gfl* nul = nullptr;
                TR_PUT(INP(I_W_IN) + (size_t)(l + 1) * DM * INW, DM, INW, (gbf*)(w_ + WS_WIN), DM, 1 | 8, 0, INP(I_LN_MIX_PRE) + (size_t)(l + 1) * DM);
                for (int q = 0; q < 4; ++q) { const int kv = q >> 1, half = q & 1;
                    TR_PUT(INP(I_CMP_W1) + (((size_t)(l + 1) * 2 + kv) * 2048 + half * 1024) * 128, 1024, 128, (gbf*)(w_ + WS_WC1) + (size_t)kv * 256 * 1024, 1024, 0, half * 128, nul); }
                for (int gi = 0; gi < 4; ++gi)
                    TR_PUT(INP(I_W_POOL) + ((size_t)(l + 1) * 4 + gi) * 65536, 256, 256, (gbf*)(w_ + WS_WPOOL) + (size_t)gi * 65536, 256, 0, 0, INP(I_POOL_SCALE) + (size_t)(l + 1) * POOLW + gi * 256);
                trn[0] = nd; trn[1] = total; }
            LDS_WAIT(); __syncthreads();
            if (F.gw < 32) {
                const int p = F.gw >> 2, kv = (F.gw >> 1) & 1, j = (F.gw & 1) * 64 + F.lane;
                const gfl* pe = INP(I_CMP_PE) + ((size_t)(l + 1) * 2 + kv) * 2048 + p * 256; const gfl* w1 = INP(I_CMP_W1) + (((size_t)(l + 1) * 2 + kv) * 2048 + p * 256) * 128 + j;
                float a = 0.f;
#pragma unroll 32
                for (int k = 0; k < 256; ++k) a += pe[k] * w1[(size_t)k * 128];
                ((gfl*)(w_ + WS_PEB))[p * 256 + kv * 128 + j] = a;
            }
            tr_run(F, trn[0], trn[1]);
            __syncthreads();
            }
            if (l + 1 < launder_int(l_hi)) SEAM(); TS1(16);
        }
    }

#ifdef MK_COUNT
    SEAM();
    { const unsigned cv = __hip_atomic_load((GAS unsigned*)(ws + WS_CTL) + 9000, __ATOMIC_RELAXED, __HIP_MEMORY_SCOPE_AGENT);
      const float val = 100.f * (float)cv / (MK_COUNT == 1 ? 4096.f : 32768.f);
      for (size_t i = (size_t)blockIdx.x * 512 + threadIdx.x; i < (size_t)S_ * DM; i += (size_t)gridDim.x * 512) X[i] = val; }
#endif
#ifdef MK_TIMING
    SEAM();
    if (blockIdx.x == 0) { const float a_ = (float)tacc1 * 1e-4f, b_ = (float)tacc2 * 1e-5f;
        if (threadIdx.x == 0) X[0] += a_;
        for (int i = threadIdx.x; i < (1 << 20); i += NWAVES * 64) X[(1 << 20) + i] += b_; }
#endif
#ifdef MK_DEBUG_DUMP
    if (args.pad > 0) {
        const gbf* src = (const gbf*)(ws + (size_t)args.pad * MiB);
        for (size_t i = (size_t)blockIdx.x * 512 + threadIdx.x; i < (size_t)S_ * DM; i += (size_t)gridDim.x * 512) X[i] = bf2f(src[i]);
    }
#endif
#undef IN
#undef SEAM
}

#ifndef MK_PER_PHASE
#define MK_PER_PHASE 0
#endif
extern "C" void kernel_launch(void* const* d_in, const int* in_sizes, int n_in, void* d_out, int out_size, void* d_ws, size_t ws_size, hipStream_t stream) {
    static int grid = 0;
    if (grid == 0) {
        if (n_in != 25 || out_size != S_ * DM || ws_size < WS_END) { fprintf(stderr, "kernel_launch: unexpected shapes (n_in %d, out %d, ws %zu, need %zu)\n", n_in, out_size, ws_size, (size_t)WS_END); grid = -1; return; }
        int dev = 0, cus = 0, per_cu = 0;
        if (hipGetDevice(&dev) != hipSuccess || hipDeviceGetAttribute(&cus, hipDeviceAttributeMultiprocessorCount, dev) != hipSuccess) { grid = -1; return; }
        if (hipFuncSetAttribute((const void*)mega_fwd, hipFuncAttributeMaxDynamicSharedMemorySize, LDS_BYTES) != hipSuccess) { fprintf(stderr, "kernel_launch: hipFuncSetAttribute failed\n"); grid = -1; return; }
        if (hipOccupancyMaxActiveBlocksPerMultiprocessor(&per_cu, (const void*)mega_fwd, NWAVES * 64, LDS_BYTES) != hipSuccess || per_cu < 1) { fprintf(stderr, "kernel_launch: occupancy query says %d\n", per_cu); (void)hipGetLastError(); grid = -1; return; }
        grid = cus;
    }
    if (grid < 0) return;
#ifdef MK_DEBUG_DUMP
    (void)hipMemsetAsync((char*)d_ws, 0xAA, WS_END, stream);
    (void)hipMemsetAsync((char*)d_out, 0xAA, (size_t)out_size * 4, stream);
#endif
    (void)hipMemsetAsync((char*)d_ws + WS_CTL, 0, CTL_ZERO_BYTES, stream);
    Args a{};
    for (int i = 0; i < 25; ++i) a.in[i] = (const float*)d_in[i];
    a.out = (float*)d_out; a.ws = (unsigned char*)d_ws; a.pad = 0;
#ifdef MK_DEBUG_DUMP
    a.use_bar = 0;
    for (int ph = 0; ph < 2; ++ph) { a.l_lo = 0; a.l_hi = 1; a.ph_lo = ph; a.ph_hi = ph + 1; hipLaunchKernelGGL(mega_fwd, dim3(grid), dim3(NWAVES * 64), LDS_BYTES, stream, a); }
    for (int ph = 2; ph <= MK_DEBUG_LASTPH; ++ph) { if (ph == 6) continue; a.l_lo = 0; a.l_hi = 1; a.ph_lo = ph; a.ph_hi = ph + 1; hipLaunchKernelGGL(mega_fwd, dim3(grid), dim3(NWAVES * 64), LDS_BYTES, stream, a); }
    a.l_lo = 0; a.l_hi = 0; a.ph_lo = 30; a.ph_hi = 31; a.pad = MK_DEBUG_DUMP; hipLaunchKernelGGL(mega_fwd, dim3(grid), dim3(NWAVES * 64), LDS_BYTES, stream, a);
#elif MK_PER_PHASE
    a.use_bar = 0;
    for (int ph = 0; ph < 2; ++ph) { a.l_lo = 0; a.l_hi = 1; a.ph_lo = ph; a.ph_hi = ph + 1; hipLaunchKernelGGL(mega_fwd, dim3(grid), dim3(NWAVES * 64), LDS_BYTES, stream, a); }
    for (int l = 0; l < NL; ++l)
        for (int ph = 2; ph < NPHASE; ++ph) { a.l_lo = l; a.l_hi = l + 1; a.ph_lo = ph; a.ph_hi = ph + 1; hipLaunchKernelGGL(mega_fwd, dim3(grid), dim3(NWAVES * 64), LDS_BYTES, stream, a); }
#else
    a.use_bar = 1; a.l_lo = 0; a.l_hi = NL; a.ph_lo = 0; a.ph_hi = NPHASE;
    hipLaunchKernelGGL(mega_fwd, dim3(grid), dim3(NWAVES * 64), LDS_BYTES, stream, a);
#endif
}
```
